# Optimizing an MI355X kernel written in HIP

```python
import functools
import jax, jax.numpy as jnp
from jax import lax
import numpy as np

D_MODEL = 1024
BATCH = 4
SEQ = 4096
DEPTH = 2

GRID_W = 64
CTX_LEN = 256
HEAD_DIM = 64
N_CONV_GROUPS = D_MODEL // 256
N_RET_HEADS = (D_MODEL // HEAD_DIM - N_CONV_GROUPS) // 2
N_NA_HEADS = D_MODEL // HEAD_DIM - N_CONV_GROUPS - N_RET_HEADS
D_RET = N_RET_HEADS * HEAD_DIM
D_CONV = N_CONV_GROUPS * HEAD_DIM
D_NA = N_NA_HEADS * HEAD_DIM
D_MIX = D_RET + D_CONV + D_NA
D_IN_PROJ = 4 * D_RET + 3 * D_CONV + 3 * D_NA
RET_CHUNK = 128
CONV_WIDTH = 3
NA_ROWS = 8
NA_COLS = 16
D_FF = 2816
N_EXPERTS = 8
TOP_K = 2
D_FF_EXPERT = 2816
N_DENSE = (DEPTH + 1) // 2
N_MOE = DEPTH // 2
ROPE_BASE = 10000.0
NORM_EPS = 1e-6

kernel_name = 'hybrid_retention_shortconv_natten_moe_dit'


def rms_norm(x, g):
    xf = x.astype(jnp.float32)
    y = xf * lax.rsqrt(jnp.mean(xf * xf, axis=-1, keepdims=True) + NORM_EPS)
    return (y * g.astype(jnp.float32)).astype(x.dtype)


def modulate(h, shift, scale):
    return h * (1.0 + scale) + shift


def split_heads(t, n_heads):
    b, n, _ = t.shape
    return t.reshape(b, n, n_heads, HEAD_DIM).transpose(0, 2, 1, 3)


def merge_heads(t):
    b, h, n, d = t.shape
    return t.transpose(0, 2, 1, 3).reshape(b, n, h * d)


def flip_seq(t):
    return jnp.flip(t, axis=2)


def split_in_proj(t):
    sizes = (D_RET,) * 4 + (D_CONV,) * 3 + (D_NA,) * 3
    points = np.cumsum(sizes)[:-1].tolist()
    return jnp.split(t, points, axis=-1)


def axial_rope_tables(n_tok):
    t = jnp.arange(n_tok, dtype=jnp.int32)
    row = (t // GRID_W).astype(jnp.float32)
    col = (t % GRID_W).astype(jnp.float32)
    n_freq = HEAD_DIM // 4
    inv_freq = ROPE_BASE ** (-jnp.arange(n_freq, dtype=jnp.float32) / n_freq)
    ang_r = row[:, None] * inv_freq
    ang_c = col[:, None] * inv_freq
    return (jnp.cos(ang_r), jnp.sin(ang_r), jnp.cos(ang_c), jnp.sin(ang_c))


def _rotate(x, cos, sin):
    x1, x2 = jnp.split(x, 2, axis=-1)
    return jnp.concatenate([x1 * cos - x2 * sin, x1 * sin + x2 * cos], axis=-1)


def apply_axial_rope(x, rope):
    cos_r, sin_r, cos_c, sin_c = (r.astype(x.dtype) for r in rope)
    xr, xc = jnp.split(x, 2, axis=-1)
    return jnp.concatenate([_rotate(xr, cos_r, sin_r), _rotate(xc, cos_c, sin_c)], axis=-1)


def retention_final_state(k, v, log_gamma):
    n_tok = k.shape[2]
    w = jnp.exp(log_gamma[:, None] * (n_tok - 1.0 - jnp.arange(n_tok, dtype=jnp.float32)))
    return jnp.einsum('bhnd,bhne->bhde', k.astype(jnp.float32) * w[:, :, None], v.astype(jnp.float32))


def retention_chunkwise(q, k, v, log_gamma, s0):
    b, h, n_tok, dh = q.shape
    n = n_tok // RET_CHUNK
    qc, kc, vc = (t.astype(jnp.float32).reshape(b, h, n, RET_CHUNK, dh) for t in (q, k, v))
    pos = jnp.arange(RET_CHUNK, dtype=jnp.float32)
    lg = log_gamma[:, None]
    diff = pos[:, None] - pos[None, :]
    intra_decay = jnp.where(diff >= 0, jnp.exp(lg[:, :, None] * jnp.maximum(diff, 0.0)), 0.0)
    q_decay = jnp.exp(lg * (pos + 1.0))
    k_decay = jnp.exp(lg * (RET_CHUNK - 1.0 - pos))
    chunk_decay = jnp.exp(log_gamma * RET_CHUNK)[None, :, None, None]
    scores = jnp.einsum('bhnid,bhnjd->bhnij', qc, kc) * intra_decay[:, None]
    o_intra = jnp.einsum('bhnij,bhnjd->bhnid', scores, vc)
    u = jnp.einsum('bhnjd,bhnje->nbhde', kc * k_decay[:, None, :, None], vc)

    def step(state, u_n):
        return chunk_decay * state + u_n, state

    _, s_before = lax.scan(step, s0, u)
    o_inter = jnp.einsum('bhnid,nbhde->bhnie', qc * q_decay[:, None, :, None], s_before)
    return (o_intra + o_inter).reshape(b, h, n_tok, dh)


def bidir_retention(q, k, v, log_gamma, s_fwd0, s_bwd0):
    o_f = retention_chunkwise(q, k, v, log_gamma[0], s_fwd0)
    o_b = retention_chunkwise(flip_seq(q), flip_seq(k), flip_seq(v), log_gamma[1], s_bwd0)
    return o_f + flip_seq(o_b)


def retention_output(o, gate, gn_g):
    mu = jnp.mean(o, axis=-1, keepdims=True)
    var = jnp.mean(jnp.square(o - mu), axis=-1, keepdims=True)
    o = merge_heads((o - mu) * lax.rsqrt(var + NORM_EPS)) * gn_g.astype(jnp.float32)
    return (jax.nn.silu(gate.astype(jnp.float32)) * o).astype(gate.dtype)


def short_gated_conv(b_gate, c_gate, x_in, conv_w):
    u = c_gate * x_in
    w = conv_w[:, None, :].astype(u.dtype)
    y = lax.conv_general_dilated(u, w, window_strides=(1,), padding=((CONV_WIDTH // 2, CONV_WIDTH // 2),),
                                 dimension_numbers=('NWC', 'WIO', 'NWC'), feature_group_count=u.shape[-1])
    return b_gate * y


def neighbourhood_attention(q, k, v, k_ctx, v_ctx, rpb):
    b, h, n_tok, dh = q.shape
    rows = n_tok // GRID_W
    kr = min(NA_ROWS, rows)
    scale = dh ** -0.5
    r = jnp.arange(rows)
    cidx = jnp.arange(GRID_W)
    r0 = jnp.clip(r - kr // 2, 0, rows - kr)
    key_rows = r0[:, None] + jnp.arange(kr)[None, :]
    c0 = jnp.clip(cidx - NA_COLS // 2, 0, GRID_W - NA_COLS)
    col_in = (cidx[None, :] >= c0[:, None]) & (cidx[None, :] < c0[:, None] + NA_COLS)
    qg = q.reshape(b, h, rows, GRID_W, dh)
    kg = k.reshape(b, h, rows, GRID_W, dh)[:, :, key_rows]
    vg = v.reshape(b, h, rows, GRID_W, dh)[:, :, key_rows]
    s_loc = jnp.einsum('bhrqd,bhrikd->bhrqik', qg, kg).astype(jnp.float32) * scale
    dr = key_rows - r[:, None] + (NA_ROWS - 1)
    dc = jnp.clip(cidx[None, :] - cidx[:, None], -(NA_COLS - 1), NA_COLS - 1) + (NA_COLS - 1)
    bias = rpb[:, dr[:, None, :, None], dc[None, :, None, :]].astype(jnp.float32)
    s_loc = jnp.where(col_in[None, None, None, :, None, :], s_loc + bias[None], -jnp.inf)
    s_loc = s_loc.reshape(b, h, rows, GRID_W, kr * GRID_W)
    s_ctx = jnp.einsum('bhrqd,bhld->bhrql', qg, k_ctx).astype(jnp.float32) * scale
    p = jax.nn.softmax(jnp.concatenate([s_loc, s_ctx], axis=-1), axis=-1)
    p_loc = p[..., :kr * GRID_W].reshape(b, h, rows, GRID_W, kr, GRID_W).astype(v.dtype)
    p_ctx = p[..., kr * GRID_W:].astype(v.dtype)
    o = jnp.einsum('bhrqik,bhrikd->bhrqd', p_loc, vg) + jnp.einsum('bhrql,bhld->bhrqd', p_ctx, v_ctx)
    return o.reshape(b, h, n_tok, dh)


def context_attention(q, k, v):
    s = jnp.einsum('bhqd,bhkd->bhqk', q, k).astype(jnp.float32) * (q.shape[-1] ** -0.5)
    p = jax.nn.softmax(s, axis=-1).astype(v.dtype)
    return jnp.einsum('bhqk,bhkd->bhqd', p, v)


def mixer_block(a_lat, a_ctx, w_in, w_out, ret_decay_logit, ret_gn_g, conv_w, na_rpb, rope, with_ctx_out):
    rq, rk, rv, rg, cb, cc, cx, nq, nk, nv = split_in_proj(a_lat @ w_in)
    crq, crk, crv, crg, ccb, ccc, ccx, cnq, cnk, cnv = split_in_proj(a_ctx @ w_in)
    log_gamma = jax.nn.log_sigmoid(ret_decay_logit.astype(jnp.float32))
    k_scale = HEAD_DIM ** -0.5
    rk_c = split_heads(crk, N_RET_HEADS) * k_scale
    rv_c = split_heads(crv, N_RET_HEADS)
    s_fwd = retention_final_state(rk_c, rv_c, log_gamma[0])
    s_bwd = retention_final_state(flip_seq(rk_c), flip_seq(rv_c), log_gamma[1])
    nk_c = split_heads(cnk, N_NA_HEADS)
    nv_c = split_heads(cnv, N_NA_HEADS)
    rq_l = apply_axial_rope(split_heads(rq, N_RET_HEADS), rope)
    rk_l = apply_axial_rope(split_heads(rk, N_RET_HEADS), rope) * k_scale
    rv_l = split_heads(rv, N_RET_HEADS)
    y_ret = retention_output(bidir_retention(rq_l, rk_l, rv_l, log_gamma, s_fwd, s_bwd), rg, ret_gn_g)
    y_conv = short_gated_conv(cb, cc, cx, conv_w)
    y_na = merge_heads(neighbourhood_attention(split_heads(nq, N_NA_HEADS), split_heads(nk, N_NA_HEADS),
                                               split_heads(nv, N_NA_HEADS), nk_c, nv_c, na_rpb))
    y_lat = jnp.concatenate([y_ret, y_conv, y_na], axis=-1) @ w_out
    if not with_ctx_out:
        return y_lat, None
    zero = jnp.zeros_like(s_fwd)
    y_ret_c = retention_output(bidir_retention(split_heads(crq, N_RET_HEADS), rk_c, rv_c, log_gamma, zero, zero),
                               crg, ret_gn_g)
    y_conv_c = short_gated_conv(ccb, ccc, ccx, conv_w)
    y_na_c = merge_heads(context_attention(split_heads(cnq, N_NA_HEADS), nk_c, nv_c))
    y_ctx = jnp.concatenate([y_ret_c, y_conv_c, y_na_c], axis=-1) @ w_out
    return y_lat, y_ctx


def swiglu(h, w_in, w_out):
    gate, up = jnp.split(h @ w_in, 2, axis=-1)
    return (jax.nn.silu(gate) * up) @ w_out


def moe_swiglu(h, router_w, router_b, w_in, w_out):
    logits = (h @ router_w).astype(jnp.float32) + router_b.astype(jnp.float32)
    top_v, top_i = lax.top_k(logits, TOP_K)
    wts = jax.nn.softmax(top_v, axis=-1)
    gates = jnp.sum(jax.nn.one_hot(top_i, N_EXPERTS, dtype=jnp.float32) * wts[..., None], axis=-2)
    y = jnp.zeros_like(h)
    for e in range(N_EXPERTS):
        y = y + gates[..., e:e + 1].astype(h.dtype) * swiglu(h, w_in[e], w_out[e])
    return y


def setup_inputs(seed: int = 0) -> dict:
    key = jax.random.key(seed)
    ks = jax.random.split(key, 24)
    f32 = jnp.float32

    def nrm(k, shape, scale):
        return scale * jax.random.normal(k, shape, f32)

    base_logit = jnp.log(2.0 ** (5.0 + jnp.arange(N_RET_HEADS, dtype=f32)) - 1.0)
    return {
        'x': nrm(ks[0], (BATCH, SEQ, D_MODEL), 1.0),
        'c': nrm(ks[1], (BATCH, D_MODEL), 1.0),
        'ctx': nrm(ks[2], (BATCH, CTX_LEN, D_MODEL), 1.0),
        'c_ctx': nrm(ks[3], (D_MODEL,), 1.0),
        'ada_w': nrm(ks[4], (DEPTH, D_MODEL, 6 * D_MODEL), 0.5 * D_MODEL ** -0.5),
        'ada_b': nrm(ks[5], (DEPTH, 6 * D_MODEL), 0.02),
        'norm1_g': 1.0 + nrm(ks[6], (DEPTH, D_MODEL), 0.02),
        'norm2_g': 1.0 + nrm(ks[7], (DEPTH, D_MODEL), 0.02),
        'w_in': nrm(ks[8], (DEPTH, D_MODEL, D_IN_PROJ), D_MODEL ** -0.5),
        'w_out': nrm(ks[9], (DEPTH, D_MIX, D_MODEL), D_MIX ** -0.5),
        'ret_decay_logit': base_logit + nrm(ks[10], (DEPTH, 2, N_RET_HEADS), 0.1),
        'ret_gn_g': 1.0 + nrm(ks[11], (DEPTH, D_RET), 0.02),
        'conv_w': nrm(ks[12], (DEPTH, CONV_WIDTH, D_CONV), CONV_WIDTH ** -0.5),
        'na_rpb': nrm(ks[13], (DEPTH, N_NA_HEADS, 2 * NA_ROWS - 1, 2 * NA_COLS - 1), 0.1),
        'ffn_w_in': nrm(ks[14], (N_DENSE, D_MODEL, 2 * D_FF), D_MODEL ** -0.5),
        'ffn_w_out': nrm(ks[15], (N_DENSE, D_FF, D_MODEL), D_FF ** -0.5),
        'moe_router_w': nrm(ks[16], (N_MOE, D_MODEL, N_EXPERTS), D_MODEL ** -0.5),
        'moe_router_b': nrm(ks[17], (N_MOE, N_EXPERTS), 0.01),
        'moe_w_in': nrm(ks[18], (N_MOE, N_EXPERTS, D_MODEL, 2 * D_FF_EXPERT), D_MODEL ** -0.5),
        'moe_w_out': nrm(ks[19], (N_MOE, N_EXPERTS, D_FF_EXPERT, D_MODEL), D_FF_EXPERT ** -0.5),
        'final_g': 1.0 + nrm(ks[20], (D_MODEL,), 0.02),
    }


def reference(x, c, ctx, c_ctx, ada_w, ada_b, norm1_g, norm2_g, w_in, w_out, ret_decay_logit, ret_gn_g,
              conv_w, na_rpb, ffn_w_in, ffn_w_out, moe_router_w, moe_router_b, moe_w_in, moe_w_out, final_g):
    rope = axial_rope_tables(x.shape[1])
    c_act = jax.nn.silu(c)
    cctx_act = jax.nn.silu(c_ctx)
    h, hc = x, ctx
    for layer in range(DEPTH):
        update_ctx = layer < DEPTH - 1
        sh1, sc1, g1, sh2, sc2, g2 = jnp.split((c_act @ ada_w[layer] + ada_b[layer])[:, None, :], 6, axis=-1)
        csh1, csc1, cg1, csh2, csc2, cg2 = jnp.split(cctx_act @ ada_w[layer] + ada_b[layer], 6, axis=-1)
        a_lat = modulate(rms_norm(h, norm1_g[layer]), sh1, sc1)
        a_ctx = modulate(rms_norm(hc, norm1_g[layer]), csh1, csc1)
        y_lat, y_ctx = mixer_block(a_lat, a_ctx, w_in[layer], w_out[layer], ret_decay_logit[layer], ret_gn_g[layer],
                                   conv_w[layer], na_rpb[layer], rope, update_ctx)
        h = h + g1 * y_lat
        if layer % 2 == 0:
            ffn = functools.partial(swiglu, w_in=ffn_w_in[layer // 2], w_out=ffn_w_out[layer // 2])
        else:
            e = layer // 2
            ffn = functools.partial(moe_swiglu, router_w=moe_router_w[e], router_b=moe_router_b[e],
                                    w_in=moe_w_in[e], w_out=moe_w_out[e])
        h = h + g2 * ffn(modulate(rms_norm(h, norm2_g[layer]), sh2, sc2))
        if update_ctx:
            hc = hc + cg1 * y_ctx
            hc = hc + cg2 * ffn(modulate(rms_norm(hc, norm2_g[layer]), csh2, csc2))
    return rms_norm(h, final_g)
```

```cpp
#include <hip/hip_runtime.h>
#include <cstdio>
#include <cstdint>
namespace pg8 {
#define PG8_LAS __attribute__((address_space(3)))
typedef unsigned short bf16_t;
typedef short bf16x8 __attribute__((ext_vector_type(8)));
typedef float f32x4 __attribute__((ext_vector_type(4)));
typedef unsigned u32x4 __attribute__((ext_vector_type(4)));
constexpr int BM = 256, BK = 64, HALF = 128, HTB = HALF * BK * 2  , STAGE_BYTES = 8 * HTB, NXCD = 8, WGM = 8;

__host__ __device__ __forceinline__ int lds_byte(int r, int c) { const int st = (r >> 4) * 2 + (c >> 5), rr = r & 15, cc = c & 31, ob = rr * 64 + cc * 2; return st * 1024 + (ob ^ (((ob >> 9) & 1) << 5)); }
__host__ __device__ __forceinline__ void stage_rc(int b, int& R, int& C) { const int st = b / 1024, sb = b % 1024, swz = sb ^ (((sb >> 9) & 1) << 5); R = (st >> 1) * 16 + swz / 64; C = (st & 1) * 32 + (swz % 64) / 2; }
__host__ __device__ __forceinline__ int perm32(int rho) { const int n = rho >> 4, i = rho & 15; return 8 * (i >> 2) + 4 * n + (i & 3); }

struct Unit { int pm, pn; };
struct Gemm { const bf16_t* A; const bf16_t* Bt; int M, N, K; };

struct StaticOrder {
    int nM, nN, nwg, G, c;
    __host__ __device__ void init(int M, int N, int G_, int c_) { nM = M / BM; nN = N / BM; nwg = nM * nN; G = G_; c = c_; }
    __host__ __device__ bool next(int i, Unit& u) const {
        const long L = (long)i * G + c; if (L >= nwg) return false;
        int wgid = (int)L; { const int q = nwg / NXCD, r = nwg % NXCD, xcd = wgid % NXCD, off = wgid / NXCD; wgid = (xcd < r ? xcd * (q + 1) : r * (q + 1) + (xcd - r) * q) + off; }
        const int nig = WGM * nN, gid = wgid / nig, fm = gid * WGM, gsz = (nM - fm) < WGM ? (nM - fm) : WGM;
        u.pm = fm + ((wgid % nig) % gsz); u.pn = (wgid % nig) / gsz; return true;
    }
    __device__ __forceinline__ void a_ready(const Unit&) const {}
    __device__ __forceinline__ void done(const Unit&) const {}
    __device__ __forceinline__ const bf16_t* bt(const Gemm& g, const Unit&) const { return g.Bt; }
};

__device__ __forceinline__ unsigned cvt_pk_bf16(float lo, float hi) { unsigned r; asm volatile("v_cvt_pk_bf16_f32 %0, %1, %2" : "=v"(r) : "v"(lo), "v"(hi)); return r; }
typedef float f32x2 __attribute__((ext_vector_type(2)));

template <class Epi, class Sched, bool ALIGN_EPI = false, bool SP2 = false>
__device__ __forceinline__ void gemm_phase(PG8_LAS unsigned char* lds, const Gemm g, const Sched& S, const Epi& E) {
    const int tid = threadIdx.x, wid = __builtin_amdgcn_readfirstlane(tid >> 6), lane = tid & 63, wr = wid >> 2, wc = wid & 3, fr = lane & 15, fq = lane >> 4;
    const int K = g.K, nt = K / BK;
    unsigned voffA[2], voffB[2];
#pragma unroll
    for (int i = 0; i < 2; ++i) { int R, C; stage_rc(tid * 16 + i * 8192, R, C); const int Rb = Epi::PERM ? ((R & ~31) + perm32(R & 31)) : R;
        voffA[i] = (unsigned)(R * K + C) * 2u; voffB[i] = (unsigned)(Rb * K + C) * 2u; }
    const size_t kstep = (size_t)(BK * 2);
    const size_t hstep = (size_t)HALF * K * 2;
    const size_t tstep = 2 * hstep;
    const unsigned ldsw = (unsigned)wid * 1024u;
    const int aoff = lds_byte(wr * 64 + fr, fq * 8), boff = lds_byte(wc * 32 + fr, fq * 8);
#define PG8_SA(b, h) (((b) * 2 + (h)) * HTB)
#define PG8_SB(b, h) ((4 + (b) * 2 + (h)) * HTB)
#define PG8_STAGE(bufoff, gbase, voff) do { _Pragma("unroll") for (int _i = 0; _i < 2; ++_i) \
        __builtin_amdgcn_global_load_lds((const unsigned*)((const char*)(gbase) + (voff)[_i]), (PG8_LAS unsigned*)(lds + (bufoff) + ldsw + _i * 8192), 16, 0, 0); } while (0)
#define PG8_LDA(dst, b, h) do { _Pragma("unroll") for (int m = 0; m < 4; ++m) _Pragma("unroll") for (int k = 0; k < 2; ++k) dst[m][k] = *(const PG8_LAS bf16x8*)(lds + PG8_SA(b, h) + aoff + m * 2048 + k * 1024); } while (0)
#define PG8_LDB(dst, b, h) do { _Pragma("unroll") for (int n = 0; n < 2; ++n) _Pragma("unroll") for (int k = 0; k < 2; ++k) dst[n][k] = *(const PG8_LAS bf16x8*)(lds + PG8_SB(b, h) + boff + n * 2048 + k * 1024); } while (0)
#define PG8_MMA(ai, bj, At, Bt) do { __builtin_amdgcn_s_setprio(1); _Pragma("unroll") for (int m = 0; m < 4; ++m) _Pragma("unroll") for (int n = 0; n < 2; ++n) _Pragma("unroll") for (int k = 0; k < 2; ++k) \
        acc[ai][bj][m][n] = __builtin_amdgcn_mfma_f32_16x16x32_bf16(Bt[n][k], At[m][k], acc[ai][bj][m][n], 0, 0, 0); __builtin_amdgcn_s_setprio(0); } while (0)
#define PG8_WAIT_V(n) asm volatile("s_waitcnt vmcnt(" #n ")" ::: "memory")
#define PG8_WAIT_L(n) asm volatile("s_waitcnt lgkmcnt(" #n ")" ::: "memory")
#define PG8_BAR __builtin_amdgcn_s_barrier()
#define PG8_SCHED __builtin_amdgcn_sched_barrier(0)
    Unit cur, nxt; int ui = 0;
    if (!S.next(0, cur)) return;
    f32x4 acc[2][2][4][2];
#pragma unroll
    for (int a = 0; a < 2; ++a)
#pragma unroll
        for (int b = 0; b < 2; ++b)
#pragma unroll
            for (int m = 0; m < 4; ++m)
#pragma unroll
                for (int n = 0; n < 2; ++n) acc[a][b][m][n] = (f32x4){0.f, 0.f, 0.f, 0.f};
    bf16x8 At[4][2], B0[2][2], B1[2][2];
    const char* cA = (const char*)g.A + (size_t)cur.pm * tstep; const char* cB = (const char*)S.bt(g, cur) + (size_t)cur.pn * tstep;
    S.a_ready(cur);
    if constexpr (SP2) {
        PG8_STAGE(PG8_SB(0, 0), cB, voffB); PG8_STAGE(PG8_SB(0, 1), cB + hstep, voffB); PG8_STAGE(PG8_SA(0, 0), cA, voffA); PG8_STAGE(PG8_SA(0, 1), cA + hstep, voffA);
        if (wr == 1) PG8_BAR;
        PG8_WAIT_V(2); PG8_BAR;
        PG8_STAGE(PG8_SB(1, 0), cB + kstep, voffB); PG8_STAGE(PG8_SA(1, 0), cA + kstep, voffA); PG8_STAGE(PG8_SB(1, 1), cB + hstep + kstep, voffB);
        PG8_WAIT_V(6); PG8_BAR;
    } else {
        PG8_STAGE(PG8_SB(0, 0), cB, voffB); PG8_STAGE(PG8_SA(0, 0), cA, voffA); PG8_STAGE(PG8_SB(0, 1), cB + hstep, voffB); PG8_STAGE(PG8_SA(0, 1), cA + hstep, voffA);
        if (wr == 1) PG8_BAR;
        PG8_WAIT_V(4); PG8_BAR;
        PG8_STAGE(PG8_SB(1, 0), cB + kstep, voffB); PG8_STAGE(PG8_SA(1, 0), cA + kstep, voffA); PG8_STAGE(PG8_SB(1, 1), cB + hstep + kstep, voffB);
        PG8_WAIT_V(6); PG8_BAR;
    }
    for (;;) {
        const bool has_next = S.next(ui + 1, nxt);
        const char* nA = has_next ? (const char*)g.A + (size_t)nxt.pm * tstep : cA; const char* nB = has_next ? (const char*)S.bt(g, nxt) + (size_t)nxt.pn * tstep : cB;
        for (int t = 0; t < nt; t += 2) {
            const bool last = (t == nt - 2);
            const char* a1 = cA + (size_t)(t + 1) * kstep;
            const char* a2 = last ? nA : cA + (size_t)(t + 2) * kstep; const char* b2 = last ? nB : cB + (size_t)(t + 2) * kstep;
            const char* a3 = a2 + kstep; const char* b3 = b2 + kstep;
            if (last && has_next) S.a_ready(nxt);
            if constexpr (SP2) {
            PG8_LDB(B0, 0, 0); PG8_LDB(B1, 0, 1); PG8_SCHED; PG8_LDA(At, 0, 0); PG8_STAGE(PG8_SA(1, 1), a1 + hstep, voffA);
            PG8_WAIT_V(8); PG8_WAIT_L(0); PG8_BAR; PG8_MMA(0, 0, At, B0); PG8_MMA(0, 1, At, B1); PG8_BAR; PG8_SCHED;
            PG8_LDA(At, 0, 1); PG8_STAGE(PG8_SB(0, 0), b2, voffB); PG8_STAGE(PG8_SB(0, 1), b2 + hstep, voffB); PG8_STAGE(PG8_SA(0, 0), a2, voffA);
            PG8_WAIT_V(8); PG8_WAIT_L(0); PG8_BAR; PG8_MMA(1, 0, At, B0); PG8_MMA(1, 1, At, B1); PG8_BAR; PG8_SCHED;
            PG8_LDB(B0, 1, 0); PG8_LDB(B1, 1, 1); PG8_SCHED; PG8_LDA(At, 1, 0); PG8_STAGE(PG8_SA(0, 1), a2 + hstep, voffA);
            PG8_WAIT_V(8); PG8_WAIT_L(0); PG8_BAR; PG8_MMA(0, 0, At, B0); PG8_MMA(0, 1, At, B1); PG8_BAR; PG8_SCHED;
            PG8_LDA(At, 1, 1); PG8_STAGE(PG8_SB(1, 0), b3, voffB); PG8_STAGE(PG8_SB(1, 1), b3 + hstep, voffB); PG8_STAGE(PG8_SA(1, 0), a3, voffA);
            PG8_WAIT_V(8); PG8_WAIT_L(0); PG8_BAR; PG8_MMA(1, 0, At, B0); PG8_MMA(1, 1, At, B1); PG8_BAR; PG8_SCHED;
            } else {
            PG8_LDB(B0, 0, 0); PG8_SCHED; PG8_LDA(At, 0, 0); PG8_STAGE(PG8_SA(1, 1), a1 + hstep, voffA);
            PG8_WAIT_L(8); PG8_BAR; PG8_WAIT_L(0); PG8_MMA(0, 0, At, B0); PG8_BAR; PG8_SCHED;
            PG8_LDB(B1, 0, 1); PG8_STAGE(PG8_SB(0, 0), b2, voffB);
            PG8_BAR; PG8_WAIT_L(0); PG8_MMA(0, 1, At, B1); PG8_BAR;
            PG8_LDA(At, 0, 1); PG8_STAGE(PG8_SA(0, 0), a2, voffA);
            PG8_BAR; PG8_WAIT_L(0); PG8_MMA(1, 0, At, B0); PG8_BAR; PG8_SCHED;
            PG8_STAGE(PG8_SB(0, 1), b2 + hstep, voffB);
            PG8_WAIT_V(6); PG8_BAR; PG8_MMA(1, 1, At, B1); PG8_BAR;
            PG8_LDB(B0, 1, 0); PG8_SCHED; PG8_LDA(At, 1, 0); PG8_STAGE(PG8_SA(0, 1), a2 + hstep, voffA);
            PG8_WAIT_L(8); PG8_BAR; PG8_WAIT_L(0); PG8_MMA(0, 0, At, B0); PG8_BAR; PG8_SCHED;
            PG8_LDB(B1, 1, 1); PG8_STAGE(PG8_SB(1, 0), b3, voffB);
            PG8_BAR; PG8_WAIT_L(0); PG8_MMA(0, 1, At, B1); PG8_BAR;
            PG8_LDA(At, 1, 1); PG8_STAGE(PG8_SA(1, 0), a3, voffA);
            PG8_BAR; PG8_WAIT_L(0); PG8_MMA(1, 0, At, B0); PG8_BAR; PG8_SCHED;
            PG8_STAGE(PG8_SB(1, 1), b3 + hstep, voffB);
            PG8_WAIT_V(6); PG8_BAR; PG8_MMA(1, 1, At, B1); PG8_BAR;
            }
        }
        if constexpr (ALIGN_EPI) { if (wr == 0) PG8_BAR; }
        if constexpr (!Epi::AFTER_DRAIN) { E(acc, cur, wr, wc, fr, fq); S.done(cur); }
        if (!has_next) break;
#pragma unroll
        for (int a = 0; a < 2; ++a)
#pragma unroll
            for (int b = 0; b < 2; ++b)
#pragma unroll
                for (int m = 0; m < 4; ++m)
#pragma unroll
                    for (int n = 0; n < 2; ++n) acc[a][b][m][n] = (f32x4){0.f, 0.f, 0.f, 0.f};
        cur = nxt; cA = nA; cB = nB; ++ui;
        if constexpr (ALIGN_EPI) { if (wr == 1) PG8_BAR; }
    }
    PG8_WAIT_V(0);
    if constexpr (!ALIGN_EPI) { if (wr == 0) PG8_BAR; }
    PG8_BAR;
    if constexpr (Epi::AFTER_DRAIN) { E.fused(acc, cur, wr, wc, fr, fq, lds, wid, lane); S.done(cur); }
#undef PG8_SA
#undef PG8_SB
#undef PG8_STAGE
#undef PG8_LDA
#undef PG8_LDB
#undef PG8_MMA
#undef PG8_WAIT_V
#undef PG8_WAIT_L
#undef PG8_BAR
#undef PG8_SCHED
}
}


constexpr int NWAVES = 8, NTHR = 512;
constexpr int D = 1024, NB = 4, SEQ = 4096, CTXL = 256, RLAT = NB * SEQ, RCTX = NB * CTXL, RALL = RLAT + RCTX;
constexpr int NPROJ = 3456, NPROJP = 3584, DFF = 2816, NE = 8;
constexpr int C_RQ = 0, C_RK = 384, C_RV = 768, C_RG = 1152, C_CB = 1536, C_CC = 1792, C_CX = 2048, C_NQ = 2304, C_NK = 2688, C_NV = 3072;
constexpr int MOE_ROWS = 2 * RLAT + NE * 256;
constexpr float EPS = 1e-6f;

constexpr size_t MiB = 1u << 20, KiB = 1u << 10;
constexpr size_t WS_CTL = 0, CTL_ZERO_BYTES = 1 * MiB;
constexpr size_t WS_MODP = 1 * MiB;
constexpr size_t WS_MOD = 3 * MiB;
constexpr size_t WS_ROWW = 3 * MiB + 256 * KiB;
constexpr size_t WS_ROPE = 3 * MiB + 512 * KiB;
constexpr size_t WS_CNT = WS_ROPE + 16 * KiB;
constexpr size_t WS_TILE = WS_ROPE + 32 * KiB;
constexpr size_t WS_TOKE = WS_ROPE + 64 * KiB;
constexpr size_t WS_TOKW = WS_ROPE + 128 * KiB;
constexpr size_t WS_TOKP = WS_ROPE + 256 * KiB;
constexpr size_t WS_WIN = 4 * MiB;
constexpr size_t WS_WOUT = 18 * MiB;
constexpr size_t WS_FIN = 22 * MiB;
constexpr size_t WS_FOUT = 33 * MiB;
constexpr size_t WS_MIN = 39 * MiB;
constexpr size_t WS_MOUT = 127 * MiB;
constexpr size_t WS_H = 171 * MiB;
constexpr size_t WS_A = 239 * MiB;
constexpr size_t WS_PROJ = 273 * MiB;
constexpr size_t WS_YMIX = 392 * MiB;
constexpr size_t WS_HID = 273 * MiB;
constexpr size_t WS_OBUF = 474 * MiB;
constexpr size_t WS_SORT = 526 * MiB;
constexpr size_t WS_SLOT = 474 * MiB;
constexpr size_t WS_END = 610 * MiB;
constexpr int CW_BAR = 4096;

constexpr int RING_OFF = 0, RING_BYTES = 131072;
constexpr int LDSCTL_OFF = RING_BYTES, MISC_OFF = LDSCTL_OFF + 320;
constexpr int LDS_BYTES = 147456;

#define GAS __attribute__((address_space(1)))
#define LAS __attribute__((address_space(3)))
typedef unsigned short bf16;
typedef unsigned v4u __attribute__((ext_vector_type(4)));
typedef unsigned v2u __attribute__((ext_vector_type(2)));
typedef float f32x4 __attribute__((ext_vector_type(4)));
typedef GAS unsigned gu32;
#define RLX_AGENT __ATOMIC_RELAXED, __HIP_MEMORY_SCOPE_AGENT
#define LDS_WAIT() asm volatile("s_waitcnt lgkmcnt(0)" ::: "memory")
__device__ __forceinline__ unsigned f2bf(float f) { unsigned u = __builtin_bit_cast(unsigned, f); return (u + 0x7fffu + ((u >> 16) & 1u)) >> 16; }
__device__ __forceinline__ unsigned pk2(float lo, float hi) { return f2bf(lo) | (f2bf(hi) << 16); }
__device__ __forceinline__ float bf2f(unsigned short b) { return __builtin_bit_cast(float, (unsigned)b << 16); }
__device__ __forceinline__ float bflo(unsigned u) { return __builtin_bit_cast(float, u << 16); }
__device__ __forceinline__ float bfhi(unsigned u) { return __builtin_bit_cast(float, u & 0xffff0000u); }
__device__ __forceinline__ float siluf(float x) { return x * __builtin_amdgcn_rcpf(1.f + __expf(-x)); }
__device__ __forceinline__ float wave_sum(float v) {
#pragma unroll
    for (int o = 1; o < 64; o <<= 1) v += __shfl_xor(v, o);
    return v;
}
__device__ __forceinline__ float wave_max(float v) {
#pragma unroll
    for (int o = 1; o < 64; o <<= 1) v = fmaxf(v, __shfl_xor(v, o));
    return v;
}

#define XB_TMO      128
#define XB_XCNT(j)  (256  + 64 * (j))
#define XB_XSUB(j)  (1280 + 64 * (j))
#define XB_XGEN(j)  (2304 + 64 * (j))
#define XB_TOP      3328
#define XB_TOPGEN   3392
#define XCD_BAR_WORDS 3456
#define XB_SPIN_CAP (1u << 18)

__device__ __forceinline__ unsigned xb_ld(unsigned* p)              { return __hip_atomic_load(p, __ATOMIC_RELAXED, __HIP_MEMORY_SCOPE_AGENT); }
__device__ __forceinline__ unsigned xb_add(unsigned* p, unsigned v) { return __hip_atomic_fetch_add(p, v, __ATOMIC_RELAXED, __HIP_MEMORY_SCOPE_AGENT); }
__device__ __forceinline__ unsigned xb_xcc_id() { return (unsigned)__builtin_amdgcn_s_getreg((3 << 11) | 20) & 0xFu; }
#define XB_SPIN(cond, bar) do { unsigned _sp = 0; while (cond) { __builtin_amdgcn_s_sleep(1); \
    if ((++_sp & 255u) == 0u) { if (xb_ld(&(bar)[XB_TMO])) break; if (_sp > XB_SPIN_CAP) { atomicAdd(&(bar)[XB_TMO], 1u); break; } } } } while (0)

struct XcdBarrier {
    unsigned* bar; unsigned x;
    volatile LAS unsigned* st;
};

__device__ __forceinline__ XcdBarrier xcd_barrier_post(unsigned* bar, volatile LAS unsigned* st) {
    XcdBarrier b; b.bar = bar; b.x = xb_xcc_id(); b.st = st;
    if (threadIdx.x == 0) (void)xb_add(&bar[XB_XCNT(b.x)], 1u);
    return b;
}
__device__ __forceinline__ void xcd_barrier_complete(unsigned* bar, unsigned x, unsigned& nloc, unsigned& nx) {
    const unsigned G = gridDim.x * gridDim.y * gridDim.z;
    unsigned sum, cnt, mine, sp = 0u;
    for (;;) {
        sum = 0u; cnt = 0u; mine = 0u;
#pragma unroll
        for (unsigned j = 0; j < 16; ++j) { const unsigned c = xb_ld(&bar[XB_XCNT(j)]); sum += c; cnt += (c > 0u) ? 1u : 0u; mine = (j == x) ? c : mine; }
        if (sum == G) break;
        __builtin_amdgcn_s_sleep(1);
        if ((++sp & 255u) == 0u) { if (xb_ld(&bar[XB_TMO])) break; if (sp > XB_SPIN_CAP) { atomicAdd(&bar[XB_TMO], 1u); break; } }
    }
    nloc = mine > 0u ? mine : 1u; nx = cnt > 0u ? cnt : 1u;
}

__device__ __forceinline__ void xcd_barrier(const XcdBarrier& b) {
    asm volatile("s_waitcnt vmcnt(0)" ::: "memory");
    __syncthreads();
    if (threadIdx.x == 0) {
        unsigned* bar = b.bar;
        __builtin_amdgcn_s_waitcnt(0);
        unsigned nloc = b.st[0], nx = b.st[1];
        if (nloc == 0u) { xcd_barrier_complete(bar, b.x, nloc, nx); b.st[0] = nloc; b.st[1] = nx; }
        const unsigned old = xb_add(&bar[XB_XSUB(b.x)], 1u);
        const unsigned gen = old / nloc;
        if (old + 1u == (gen + 1u) * nloc) {
            __builtin_amdgcn_fence(__ATOMIC_RELEASE, "agent");
            asm volatile("s_waitcnt vmcnt(0)" ::: "memory");
            const unsigned og = xb_add(&bar[XB_TOP], 1u);
            const unsigned tg = og / nx;
            if (og + 1u == (tg + 1u) * nx) xb_add(&bar[XB_TOPGEN], 1u);
            else XB_SPIN(xb_ld(&bar[XB_TOPGEN]) == tg, bar);
            __builtin_amdgcn_fence(__ATOMIC_ACQUIRE, "agent");
            xb_add(&bar[XB_XGEN(b.x)], 1u);
            asm volatile("s_waitcnt vmcnt(0)" ::: "memory");
        } else {
            XB_SPIN(xb_ld(&bar[XB_XGEN(b.x)]) == gen, bar);
            __builtin_amdgcn_fence(__ATOMIC_ACQUIRE, "agent");
            asm volatile("s_waitcnt vmcnt(0)" ::: "memory");
        }
    }
    __syncthreads();
}


namespace pg8 {
struct EpiInProj {
    static constexpr bool PERM = true, AFTER_DRAIN = false;
    bf16_t* O; const float* cosT; const float* sinT;
    __device__ __forceinline__ void operator()(const f32x4 (&acc)[2][2][4][2], const Unit& u, int wr, int wc, int fr, int fq) const {
        const bool rope = (u.pn <= 2) && (u.pm < 64);
        const int row0 = u.pm * BM + wr * 64 + fr, col0 = u.pn * BM + wc * 32 + 8 * fq;
        const float sgn = (fq < 2) ? -1.f : 1.f;
#pragma unroll
        for (int ai = 0; ai < 2; ++ai)
#pragma unroll
            for (int m = 0; m < 4; ++m) {
                const int row = row0 + ai * HALF + m * 16;
                f32x4 cs0 = {1.f, 1.f, 1.f, 1.f}, cs1 = cs0, sn0 = {0.f, 0.f, 0.f, 0.f}, sn1 = sn0;
                if (rope) { const int t = row & 4095, pos = (wc & 1) ? (t & 63) : (t >> 6); const float* cp = cosT + pos * 16 + 8 * (fq & 1); const float* sp = sinT + pos * 16 + 8 * (fq & 1);
                    cs0 = *(const f32x4*)cp; cs1 = *(const f32x4*)(cp + 4); sn0 = *(const f32x4*)sp; sn1 = *(const f32x4*)(sp + 4); }
#pragma unroll
                for (int bj = 0; bj < 2; ++bj) {
                    f32x4 v0 = acc[ai][bj][m][0], v1 = acc[ai][bj][m][1];
                    if (rope) {
                        f32x4 p0, p1;
#pragma unroll
                        for (int j = 0; j < 4; ++j) { p0[j] = __shfl_xor(v0[j], 32); p1[j] = __shfl_xor(v1[j], 32); }
                        v0 = v0 * cs0 + (p0 * sn0) * sgn; v1 = v1 * cs1 + (p1 * sn1) * sgn;
                    }
                    const float sc = (u.pn == 2 || (u.pn == 1 && bj == 1)) ? 0.125f : 1.f;
                    v0 = v0 * sc; v1 = v1 * sc;
                    u32x4 w; w.x = cvt_pk_bf16(v0[0], v0[1]); w.y = cvt_pk_bf16(v0[2], v0[3]); w.z = cvt_pk_bf16(v1[0], v1[1]); w.w = cvt_pk_bf16(v1[2], v1[3]);
                    *(u32x4*)(O + (size_t)row * 3584 + col0 + bj * HALF) = w;
                }
            }
    }
};
struct EpiResid {
    static constexpr bool PERM = false, AFTER_DRAIN = false;
    float* H; const float* gmod; int goff;
    __device__ __forceinline__ void operator()(const f32x4 (&acc)[2][2][4][2], const Unit& u, int wr, int wc, int fr, int fq) const {
        const int row0 = u.pm * BM + wr * 64 + fr, col0 = u.pn * BM + wc * 32 + 4 * fq;
        const int bi = (u.pm < 64) ? (u.pm >> 4) : 4;
        f32x4 gv[2][2];
#pragma unroll
        for (int bj = 0; bj < 2; ++bj)
#pragma unroll
            for (int n = 0; n < 2; ++n) gv[bj][n] = *(const f32x4*)(gmod + bi * 6144 + goff + col0 + bj * HALF + n * 16);
#pragma unroll
        for (int ai = 0; ai < 2; ++ai)
#pragma unroll
            for (int m = 0; m < 4; ++m) { float* rowp = H + (size_t)(row0 + ai * HALF + m * 16) * 1024 + col0;
#pragma unroll
                for (int bj = 0; bj < 2; ++bj)
#pragma unroll
                    for (int n = 0; n < 2; ++n) { f32x4* p = (f32x4*)(rowp + bj * HALF + n * 16); *p = *p + gv[bj][n] * acc[ai][bj][m][n]; } }
    }
};
struct EpiSwiglu {
    static constexpr bool PERM = true, AFTER_DRAIN = false;
    bf16_t* O;
    __device__ __forceinline__ void operator()(const f32x4 (&acc)[2][2][4][2], const Unit& u, int wr, int wc, int fr, int fq) const {
        const int row0 = u.pm * BM + wr * 64 + fr, col0 = u.pn * HALF + wc * 32 + 8 * fq;
#pragma unroll
        for (int ai = 0; ai < 2; ++ai)
#pragma unroll
            for (int m = 0; m < 4; ++m) {
                float hv[8];
#pragma unroll
                for (int n = 0; n < 2; ++n)
#pragma unroll
                    for (int j = 0; j < 4; ++j) { const float g = acc[ai][0][m][n][j], up = acc[ai][1][m][n][j]; hv[n * 4 + j] = g * __builtin_amdgcn_rcpf(1.f + __expf(-g)) * up; }
                u32x4 w; w.x = cvt_pk_bf16(hv[0], hv[1]); w.y = cvt_pk_bf16(hv[2], hv[3]); w.z = cvt_pk_bf16(hv[4], hv[5]); w.w = cvt_pk_bf16(hv[6], hv[7]);
                *(u32x4*)(O + (size_t)(row0 + ai * HALF + m * 16) * 2816 + col0) = w;
            }
    }
};
struct EpiSlots {
    static constexpr bool PERM = false, AFTER_DRAIN = false;
    float* S; const float* roww;
    __device__ __forceinline__ void operator()(const f32x4 (&acc)[2][2][4][2], const Unit& u, int wr, int wc, int fr, int fq) const {
        const int row0 = u.pm * BM + wr * 64 + fr, col0 = u.pn * BM + wc * 32 + 4 * fq;
#pragma unroll
        for (int ai = 0; ai < 2; ++ai)
#pragma unroll
            for (int m = 0; m < 4; ++m) { const int row = row0 + ai * HALF + m * 16; const float w = roww[row]; float* rowp = S + (size_t)row * 1024 + col0;
#pragma unroll
                for (int bj = 0; bj < 2; ++bj)
#pragma unroll
                    for (int n = 0; n < 2; ++n) *(f32x4*)(rowp + bj * HALF + n * 16) = acc[ai][bj][m][n] * w; }
    }
};
struct MoeOrder {
    StaticOrder so; const int* tile_e; size_t estride;
    __device__ void init(int T, int N, int G, int c, const int* te, size_t es) { so.init(T * BM, N, G, c); tile_e = te; estride = es; }
    __device__ bool next(int i, Unit& u) const { return so.next(i, u); }
    __device__ __forceinline__ void a_ready(const Unit&) const {}
    __device__ __forceinline__ void done(const Unit&) const {}
    __device__ __forceinline__ const bf16_t* bt(const Gemm& g, const Unit& u) const { const int e = __builtin_amdgcn_readfirstlane(tile_e[u.pm]); return g.Bt + (size_t)e * estride; }
};
}

struct Ctx {
    LAS unsigned char* lds;
    int tid, lane, wave, G, bx, gw, NGW, gtid, NT;
    unsigned char* ws;
    const float* in[21];
};
#define WSP(T, off) ((T*)(C.ws + (off)))

template <bool ILV>
__device__ __forceinline__ void transpose_item(const float* W, int K, int N, bf16* WT, LAS float* scr, int item, int lane) {
    const int nblk = N / 32, kb = item / nblk, nb = item % nblk, k0 = 64 * kb, n0 = 32 * nb;
    int drow = n0;
    if (ILV) drow = (n0 < DFF) ? (n0 / 128) * 256 + (n0 % 128) : ((n0 - DFF) / 128) * 256 + 128 + ((n0 - DFF) % 128);
#pragma unroll 8
    for (int i = 0; i < 32; ++i) { const int kk = 2 * i + (lane >> 5); scr[kk * 33 + (lane & 31)] = W[(size_t)(k0 + kk) * N + n0 + (lane & 31)]; }
    LDS_WAIT(); asm volatile("" ::: "memory");
    const int c = lane & 7;
#pragma unroll
    for (int j = 0; j < 4; ++j) { const int n = (lane >> 3) + 8 * j; const LAS float* s = scr + (8 * c) * 33 + n;
        v4u o; o.x = pk2(s[0 * 33], s[1 * 33]); o.y = pk2(s[2 * 33], s[3 * 33]); o.z = pk2(s[4 * 33], s[5 * 33]); o.w = pk2(s[6 * 33], s[7 * 33]);
        *(v4u*)(WT + (size_t)(drow + n) * K + k0 + 8 * c) = o; }
    LDS_WAIT(); asm volatile("" ::: "memory");
}
__device__ __forceinline__ void p_prologue(const Ctx& C) {
    LAS float* scr = (LAS float*)(C.lds + RING_OFF + C.wave * 16384);
    const float* w_in = C.in[8]; const float* w_out = C.in[9]; const float* ffn_in = C.in[14]; const float* ffn_out = C.in[15]; const float* moe_in = C.in[18]; const float* moe_out = C.in[19];
    constexpr int I_WIN = 16 * (NPROJ / 32), I_WOUT = 16 * 32, I_FIN = 16 * (2 * DFF / 32), I_FOUT = (DFF / 64) * 32;
    constexpr int NITEMS = 2 * I_WIN + 2 * I_WOUT + I_FIN + I_FOUT + NE * (I_FIN + I_FOUT);
    for (int it = C.gw; it < NITEMS; it += C.NGW) {
        int r = it;
        if (r < 2 * I_WIN) { const int l = r / I_WIN; transpose_item<false>(w_in + (size_t)l * D * NPROJ, D, NPROJ, WSP(bf16, WS_WIN) + (size_t)l * NPROJP * D, scr, r % I_WIN, C.lane); continue; } r -= 2 * I_WIN;
        if (r < 2 * I_WOUT) { const int l = r / I_WOUT; transpose_item<false>(w_out + (size_t)l * D * D, D, D, WSP(bf16, WS_WOUT) + (size_t)l * D * D, scr, r % I_WOUT, C.lane); continue; } r -= 2 * I_WOUT;
        if (r < I_FIN) { transpose_item<true>(ffn_in, D, 2 * DFF, WSP(bf16, WS_FIN), scr, r, C.lane); continue; } r -= I_FIN;
        if (r < I_FOUT) { transpose_item<false>(ffn_out, DFF, D, WSP(bf16, WS_FOUT), scr, r, C.lane); continue; } r -= I_FOUT;
        if (r < NE * I_FIN) { const int e = r / I_FIN; transpose_item<true>(moe_in + (size_t)e * D * 2 * DFF, D, 2 * DFF, WSP(bf16, WS_MIN) + (size_t)e * 2 * DFF * D, scr, r % I_FIN, C.lane); continue; } r -= NE * I_FIN;
        { const int e = r / I_FOUT; transpose_item<false>(moe_out + (size_t)e * DFF * D, DFF, D, WSP(bf16, WS_MOUT) + (size_t)e * D * DFF, scr, r % I_FOUT, C.lane); }
    }
    const float* cvec = C.in[1]; const float* cctx = C.in[3]; const float* ada_w = C.in[4];
    for (int task = C.gw; task < 384; task += C.NGW) {
        const int layer = task / 192, rem = task % 192, cg = rem / 8, ks = rem % 8, col = 256 * cg + 4 * C.lane;
        f32x4 acc[5];
#pragma unroll
        for (int r = 0; r < 5; ++r) acc[r] = (f32x4){0.f, 0.f, 0.f, 0.f};
#pragma unroll 4
        for (int kk = 0; kk < 128; ++kk) {
            const int k = 128 * ks + kk;
            const f32x4 w = *(const f32x4*)(ada_w + ((size_t)layer * D + k) * 6144 + col);
#pragma unroll
            for (int r = 0; r < 5; ++r) { const float cv = (r < 4) ? cvec[r * D + k] : cctx[k]; acc[r] = acc[r] + w * siluf(cv); }
        }
#pragma unroll
        for (int r = 0; r < 5; ++r) *(f32x4*)(WSP(float, WS_MODP) + ((size_t)((ks * 2 + layer) * 5 + r)) * 6144 + col) = acc[r];
    }
    for (int idx = C.gtid; idx < 1024; idx += C.NT) {
        const int pos = idx >> 4, i = idx & 15;
        const float inv = powf(10000.0f, -(float)i / 16.0f), ang = (float)pos * inv;
        WSP(float, WS_ROPE)[idx] = cosf(ang); WSP(float, WS_ROPE)[1024 + idx] = sinf(ang);
    }
}
__device__ __forceinline__ void p_modfin_copy(const Ctx& C) {
    const float* ada_b = C.in[5];
    for (int idx = C.gtid; idx < 2 * 5 * 6144; idx += C.NT) {
        const int layer = idx / 30720, rem = idx % 30720, r = rem / 6144, col = rem % 6144;
        float s = ada_b[layer * 6144 + col];
#pragma unroll
        for (int ks = 0; ks < 8; ++ks) s += WSP(float, WS_MODP)[((size_t)((ks * 2 + layer) * 5 + r)) * 6144 + col];
        WSP(float, WS_MOD)[idx] = s;
    }
    const f32x4* x4 = (const f32x4*)C.in[0]; const f32x4* c4 = (const f32x4*)C.in[2]; f32x4* h4 = WSP(f32x4, WS_H);
    for (int i = C.gtid; i < RALL * 256; i += C.NT) h4[i] = (i < RLAT * 256) ? x4[i] : c4[i - RLAT * 256];
}
__device__ __forceinline__ void norm_row(const float* hrow, const float* gvec, const float* sh, const float* sc, bf16* orow, int lane, f32x4 (&a)[4]) {
    float ss = 0.f;
#pragma unroll
    for (int j = 0; j < 4; ++j) { a[j] = *(const f32x4*)(hrow + 4 * lane + 256 * j); ss += (a[j].x * a[j].x + a[j].y * a[j].y) + (a[j].z * a[j].z + a[j].w * a[j].w); }
    const float rstd = 1.0f / sqrtf(wave_sum(ss) * (1.0f / D) + EPS);
#pragma unroll
    for (int j = 0; j < 4; ++j) {
        const int c = 4 * lane + 256 * j;
        const f32x4 g = *(const f32x4*)(gvec + c), s1 = *(const f32x4*)(sc + c), s0 = *(const f32x4*)(sh + c);
        a[j] = (a[j] * rstd * g) * (s1 + 1.0f) + s0;
        v2u o; o.x = pk2(a[j].x, a[j].y); o.y = pk2(a[j].z, a[j].w);
        *(v2u*)(orow + c) = o;
    }
}
template <bool ROUTER>
__device__ __forceinline__ void p_norm(const Ctx& C, int layer, int which, bool do_ctx) {
    const float* gvec = (which ? C.in[7] : C.in[6]) + layer * D;
    const float* mod = WSP(float, WS_MOD) + layer * 30720;
    const int o_sh = which ? 3 * D : 0, o_sc = which ? 4 * D : D;
    LAS int* lcnt = (LAS int*)(C.lds + RING_OFF);
    for (int blk = C.bx; blk < 256; blk += C.G) {
        if (ROUTER) { if (C.tid < 8) lcnt[C.tid] = 0; __syncthreads(); }
        for (int j = 0; j < 8; ++j) {
            const int m = 64 * blk + 8 * C.wave + j, b = m >> 12;
            f32x4 a[4];
            norm_row(WSP(float, WS_H) + (size_t)m * D, gvec, mod + b * 6144 + o_sh, mod + b * 6144 + o_sc, WSP(bf16, WS_A) + (size_t)m * D, C.lane, a);
            if (ROUTER) {
                const float* rw = C.in[16]; const float* rb = C.in[17];
                float lg[8];
#pragma unroll
                for (int e = 0; e < 8; ++e) lg[e] = 0.f;
#pragma unroll
                for (int jj = 0; jj < 4; ++jj)
#pragma unroll
                    for (int i = 0; i < 4; ++i) {
                        const int k = 4 * C.lane + 256 * jj + i;
                        const f32x4 w0 = *(const f32x4*)(rw + k * 8), w1 = *(const f32x4*)(rw + k * 8 + 4);
                        const float av = a[jj][i];
                        lg[0] += av * w0.x; lg[1] += av * w0.y; lg[2] += av * w0.z; lg[3] += av * w0.w;
                        lg[4] += av * w1.x; lg[5] += av * w1.y; lg[6] += av * w1.z; lg[7] += av * w1.w;
                    }
#pragma unroll
                for (int e = 0; e < 8; ++e) lg[e] = wave_sum(lg[e]) + rb[e];
                int e1 = 0; float v1 = lg[0];
#pragma unroll
                for (int e = 1; e < 8; ++e) if (lg[e] > v1) { v1 = lg[e]; e1 = e; }
                int e2 = -1; float v2 = -3.0e38f;
#pragma unroll
                for (int e = 0; e < 8; ++e) if (e != e1 && lg[e] > v2) { v2 = lg[e]; e2 = e; }
                const float ex = __expf(v2 - v1), w1v = 1.0f / (1.0f + ex), w2v = ex * w1v;
                if (C.lane == 0) {
                    WSP(int, WS_TOKE)[m] = e1 | (e2 << 8);
                    WSP(float, WS_TOKW)[2 * m] = w1v; WSP(float, WS_TOKW)[2 * m + 1] = w2v;
                    atomicAdd((int*)(lcnt + e1), 1); atomicAdd((int*)(lcnt + e2), 1);
                }
            }
        }
        if (ROUTER) { __syncthreads(); if (C.tid < 8) WSP(int, WS_CNT)[blk * 8 + C.tid] = lcnt[C.tid]; __syncthreads(); }
    }
    if (do_ctx) {
        for (int cm = C.gw; cm < RCTX; cm += C.NGW) {
            const int m = RLAT + cm; f32x4 a[4];
            norm_row(WSP(float, WS_H) + (size_t)m * D, gvec, mod + 4 * 6144 + o_sh, mod + 4 * 6144 + o_sc, WSP(bf16, WS_A) + (size_t)m * D, C.lane, a);
        }
    }
}
__device__ __forceinline__ void ret_scan_unit(const Ctx& C, int layer, int u) {
    const int b = u / 12, h = (u % 12) >> 1, dir = u & 1;
    const float logit = C.in[10][(layer * 2 + dir) * 6 + h];
    const float gamma = 1.0f / (1.0f + expf(-logit));
    LAS float* qs = (LAS float*)(C.lds + RING_OFF); LAS float* ks = qs + 2048; LAS float* vs = ks + 2048; LAS float* part = vs + 2048;
    const bf16* PROJ = WSP(bf16, WS_PROJ); float* OBUF = WSP(float, WS_OBUF);
    float S[8];
#pragma unroll
    for (int i = 0; i < 8; ++i) S[i] = 0.f;
    const int w = C.wave, e = C.lane, ls = C.tid >> 4, d4 = (C.tid & 15) * 4;
    for (int seg = 0; seg < 2; ++seg) {
        const int len = seg ? SEQ : CTXL, rowbase = seg ? b * SEQ : RLAT + b * CTXL;
        const bool emit = seg || (layer == 0);
        for (int blk = 0; blk < len / 32; ++blk) {
            const int ti = blk * 32 + ls, tok = dir ? (len - 1 - ti) : ti, row = rowbase + tok;
            const bf16* pr = PROJ + (size_t)row * NPROJP + 64 * h + d4;
            const v2u q2 = *(const v2u*)(pr + C_RQ), k2 = *(const v2u*)(pr + C_RK), v2 = *(const v2u*)(pr + C_RV);
            *(LAS f32x4*)(qs + ls * 64 + d4) = (f32x4){bflo(q2.x), bfhi(q2.x), bflo(q2.y), bfhi(q2.y)};
            *(LAS f32x4*)(ks + ls * 64 + d4) = (f32x4){bflo(k2.x), bfhi(k2.x), bflo(k2.y), bfhi(k2.y)};
            *(LAS f32x4*)(vs + ls * 64 + d4) = (f32x4){bflo(v2.x), bfhi(v2.x), bflo(v2.y), bfhi(v2.y)};
            __syncthreads();
            for (int s2 = 0; s2 < 32; ++s2) {
                const f32x4 k0 = *(LAS f32x4*)(ks + s2 * 64 + 8 * w), k1 = *(LAS f32x4*)(ks + s2 * 64 + 8 * w + 4);
                const f32x4 q0 = *(LAS f32x4*)(qs + s2 * 64 + 8 * w), q1 = *(LAS f32x4*)(qs + s2 * 64 + 8 * w + 4);
                const float ve = vs[s2 * 64 + e];
                float p = 0.f;
                S[0] = gamma * S[0] + k0.x * ve; p += q0.x * S[0];
                S[1] = gamma * S[1] + k0.y * ve; p += q0.y * S[1];
                S[2] = gamma * S[2] + k0.z * ve; p += q0.z * S[2];
                S[3] = gamma * S[3] + k0.w * ve; p += q0.w * S[3];
                S[4] = gamma * S[4] + k1.x * ve; p += q1.x * S[4];
                S[5] = gamma * S[5] + k1.y * ve; p += q1.y * S[5];
                S[6] = gamma * S[6] + k1.z * ve; p += q1.z * S[6];
                S[7] = gamma * S[7] + k1.w * ve; p += q1.w * S[7];
                part[(s2 * 8 + w) * 64 + e] = p;
            }
            __syncthreads();
            if (emit) {
                f32x4 o = {0.f, 0.f, 0.f, 0.f};
#pragma unroll
                for (int ww = 0; ww < 8; ++ww) o = o + *(LAS f32x4*)(part + (ls * 8 + ww) * 64 + d4);
                *(f32x4*)(OBUF + (((size_t)dir * RALL + row) * 6 + h) * 64 + d4) = o;
            }
        }
    }
    __syncthreads();
}
__device__ __forceinline__ void na_task(const Ctx& C, int layer, int b, int h, int t, bool ctxq) {
    const bf16* PROJ = WSP(bf16, WS_PROJ);
    LAS float* pbuf = (LAS float*)(C.lds + RING_OFF + C.wave * 4096); LAS int* kbuf = (LAS int*)(pbuf + 512);
    const int qrow = ctxq ? RLAT + b * CTXL + t : b * SEQ + t;
    float q[64];
    { const v4u* qp = (const v4u*)(PROJ + (size_t)qrow * NPROJP + C_NQ + 64 * h);
#pragma unroll
      for (int i = 0; i < 8; ++i) { const v4u x = qp[i]; q[8 * i] = bflo(x.x); q[8 * i + 1] = bfhi(x.x); q[8 * i + 2] = bflo(x.y); q[8 * i + 3] = bfhi(x.y); q[8 * i + 4] = bflo(x.z); q[8 * i + 5] = bfhi(x.z); q[8 * i + 6] = bflo(x.w); q[8 * i + 7] = bfhi(x.w); } }
    const int r = t >> 6, qc = t & 63;
    const int r0 = min(max(r - 4, 0), 56), c0 = min(max(qc - 8, 0), 48);
    const float* rpb = C.in[13] + (size_t)(layer * 6 + h) * 15 * 31;
    float sc[6]; int kr[6];
    const int a0 = ctxq ? 2 : 0;
#pragma unroll
    for (int a = 0; a < 6; ++a) {
        sc[a] = -3.0e38f; kr[a] = 0;
        if (a >= a0) {
            int krow; float bias = 0.f;
            if (a < 2) { const int idx = C.lane + 64 * a, i = idx >> 4, cc = idx & 15; krow = b * SEQ + (r0 + i) * 64 + c0 + cc;
                const int dr = (r0 + i) - r + 7, dc = min(max(c0 + cc - qc, -15), 15) + 15; bias = rpb[dr * 31 + dc]; }
            else { krow = RLAT + b * CTXL + C.lane + 64 * (a - 2); }
            const v4u* kp = (const v4u*)(PROJ + (size_t)krow * NPROJP + C_NK + 64 * h);
            float s = 0.f;
#pragma unroll
            for (int i = 0; i < 8; ++i) { const v4u x = kp[i];
                s += q[8 * i] * bflo(x.x) + q[8 * i + 1] * bfhi(x.x) + q[8 * i + 2] * bflo(x.y) + q[8 * i + 3] * bfhi(x.y) + q[8 * i + 4] * bflo(x.z) + q[8 * i + 5] * bfhi(x.z) + q[8 * i + 6] * bflo(x.w) + q[8 * i + 7] * bfhi(x.w); }
            sc[a] = s * 0.125f + bias; kr[a] = krow;
        }
    }
    float mx = sc[0];
#pragma unroll
    for (int a = 1; a < 6; ++a) mx = fmaxf(mx, sc[a]);
    mx = wave_max(mx);
    float sum = 0.f;
#pragma unroll
    for (int a = 0; a < 6; ++a) { const float p = (a >= a0) ? __expf(sc[a] - mx) : 0.f; sum += p; pbuf[a * 64 + C.lane] = p; kbuf[a * 64 + C.lane] = kr[a]; }
    sum = wave_sum(sum);
    LDS_WAIT(); __builtin_amdgcn_wave_barrier(); asm volatile("" ::: "memory");
    float o = 0.f;
    const bf16* vb = PROJ + C_NV + 64 * h + C.lane;
#pragma unroll 8
    for (int j = a0 * 64; j < 384; ++j) o += pbuf[j] * bf2f(vb[(size_t)kbuf[j] * NPROJP]);
    WSP(bf16, WS_YMIX)[(size_t)qrow * D + 640 + 64 * h + C.lane] = (bf16)f2bf(o / sum);
    LDS_WAIT(); __builtin_amdgcn_wave_barrier(); asm volatile("" ::: "memory");
}
__device__ __forceinline__ void p_mix1(const Ctx& C, int layer) {
    for (int u = C.bx; u < 48; u += C.G) ret_scan_unit(C, layer, u);
    const int nlat = NB * 6 * SEQ, nctx = (layer == 0) ? NB * 6 * CTXL : 0;
    for (int task = C.gw; task < nlat + nctx; task += C.NGW) {
        if (task < nlat) { const int t = task & 4095, bh = task >> 12; na_task(C, layer, bh / 6, bh % 6, t, false); }
        else { const int tc = task - nlat, t = tc & 255, bh = tc >> 8; na_task(C, layer, bh / 6, bh % 6, t, true); }
    }
}
__device__ __forceinline__ void p_mix2(const Ctx& C, int layer) {
    const bf16* PROJ = WSP(bf16, WS_PROJ); const float* OBUF = WSP(float, WS_OBUF); bf16* Y = WSP(bf16, WS_YMIX);
    const float* gn = C.in[11] + layer * 384; const float* cw = C.in[12] + layer * 3 * 256;
    const int nrows = (layer == 0) ? RALL : RLAT;
    for (int task = C.gw; task < nrows * 6; task += C.NGW) {
        const int m = task / 6, h = task % 6;
        const float o = OBUF[((size_t)m * 6 + h) * 64 + C.lane] + OBUF[(((size_t)RALL + m) * 6 + h) * 64 + C.lane];
        const float mu = wave_sum(o) * (1.f / 64.f), dlt = o - mu, var = wave_sum(dlt * dlt) * (1.f / 64.f);
        const float gate = bf2f(PROJ[(size_t)m * NPROJP + C_RG + 64 * h + C.lane]);
        const float y = dlt * (1.0f / sqrtf(var + EPS)) * gn[64 * h + C.lane] * siluf(gate);
        Y[(size_t)m * D + 64 * h + C.lane] = (bf16)f2bf(y);
    }
    for (int idx = C.gtid; idx < nrows * 256; idx += C.NT) {
        const int m = idx >> 8, ch = idx & 255;
        int tpos, len; if (m < RLAT) { tpos = m & 4095; len = SEQ; } else { tpos = (m - RLAT) & 255; len = CTXL; }
        const bf16* p = PROJ + (size_t)m * NPROJP + ch;
        float acc = cw[256 + ch] * bf2f(p[C_CC]) * bf2f(p[C_CX]);
        if (tpos > 0) acc += cw[ch] * bf2f(p[C_CC - NPROJP]) * bf2f(p[C_CX - NPROJP]);
        if (tpos < len - 1) acc += cw[512 + ch] * bf2f(p[C_CC + NPROJP]) * bf2f(p[C_CX + NPROJP]);
        Y[(size_t)m * D + 384 + ch] = (bf16)f2bf(bf2f(p[C_CB]) * acc);
    }
}
__device__ __forceinline__ void p_moe_lists(const Ctx& C) {
    LAS int* L = (LAS int*)(C.lds + RING_OFF);
    const int* CNT = WSP(int, WS_CNT);
    for (int blk = C.bx; blk < 256; blk += C.G) {
        __syncthreads();
        for (int i = C.tid; i < 2048; i += NTHR) L[i] = CNT[i];
        if (C.tid < 64) L[2080 + C.tid] = WSP(int, WS_TOKE)[64 * blk + C.tid];
        __syncthreads();
        if (C.tid < 8) { int tot = 0, pre = 0; for (int k = 0; k < 256; ++k) { const int c = L[k * 8 + C.tid]; if (k < blk) pre += c; tot += c; } L[2048 + C.tid] = tot; L[2064 + C.tid] = pre; }
        __syncthreads();
        if (C.tid == 0) { int base = 0; for (int e = 0; e < 8; ++e) { L[2056 + e] = base; base += (L[2048 + e] + 255) & ~255; } }
        __syncthreads();
        if (C.tid < 8) {
            int pos = L[2056 + C.tid] + L[2064 + C.tid];
            for (int t = 0; t < 64; ++t) { const int ee = L[2080 + t], e1 = ee & 255, e2 = ee >> 8;
                if (e1 == C.tid) L[2144 + 2 * t] = pos++;
                if (e2 == C.tid) L[2144 + 2 * t + 1] = pos++; }
        }
        __syncthreads();
        if (C.tid < 128) { const int t = C.tid >> 1, k = C.tid & 1, m = 64 * blk + t, pos = L[2144 + C.tid];
            WSP(int, WS_TOKP)[2 * m + k] = pos; WSP(float, WS_ROWW)[pos] = WSP(float, WS_TOKW)[2 * m + k]; }
        for (int j = 0; j < 8; ++j) { const int t = 8 * C.wave + j, m = 64 * blk + t;
            const v4u* src = (const v4u*)(WSP(bf16, WS_A) + (size_t)m * D) + C.lane;
            const v4u x0 = src[0], x1 = src[64];
#pragma unroll
            for (int k = 0; k < 2; ++k) { v4u* dst = (v4u*)(WSP(bf16, WS_SORT) + (size_t)L[2144 + 2 * t + k] * D) + C.lane; dst[0] = x0; dst[64] = x1; } }
        if (blk == 0 && C.tid == 0) { int T = 0; int* TE = WSP(int, WS_TILE);
            for (int e = 0; e < 8; ++e) { const int nt = (L[2048 + e] + 255) >> 8; for (int k = 0; k < nt; ++k) TE[T + k] = e; T += nt; }
            TE[255] = T; }
    }
    __syncthreads();
}
__device__ __forceinline__ void p_final(const Ctx& C, float* out) {
    const float* fg = C.in[20]; const float* mod = WSP(float, WS_MOD) + 30720; const float* SL = WSP(float, WS_SLOT);
    for (int m = C.gw; m < RLAT; m += C.NGW) {
        const int b = m >> 12, p1 = WSP(int, WS_TOKP)[2 * m], p2 = WSP(int, WS_TOKP)[2 * m + 1];
        f32x4 v[4]; float ss = 0.f;
#pragma unroll
        for (int j = 0; j < 4; ++j) { const int c = 4 * C.lane + 256 * j;
            const f32x4 hv = *(const f32x4*)(WSP(float, WS_H) + (size_t)m * D + c), g2 = *(const f32x4*)(mod + b * 6144 + 5 * D + c);
            const f32x4 s1 = *(const f32x4*)(SL + (size_t)p1 * D + c), s2 = *(const f32x4*)(SL + (size_t)p2 * D + c);
            v[j] = hv + g2 * (s1 + s2); ss += (v[j].x * v[j].x + v[j].y * v[j].y) + (v[j].z * v[j].z + v[j].w * v[j].w); }
        const float rstd = 1.0f / sqrtf(wave_sum(ss) * (1.0f / D) + EPS);
#pragma unroll
        for (int j = 0; j < 4; ++j) { const int c = 4 * C.lane + 256 * j; *(f32x4*)(out + (size_t)m * D + c) = v[j] * rstd * *(const f32x4*)(fg + c); }
    }
}

#ifndef MK_ONE_LAUNCH
#define MK_ONE_LAUNCH 0
#endif
constexpr int NPHASES = 20;
struct Args { const float* in[21]; float* out; unsigned char* ws; int ph_lo, ph_hi; };
__global__ void __launch_bounds__(NTHR, 2) fwd(Args args) {
    extern __shared__ __attribute__((aligned(16))) unsigned char lds_raw[];
    Ctx C;
    C.lds = (LAS unsigned char*)lds_raw;
    C.tid = threadIdx.x; C.lane = C.tid & 63; C.wave = __builtin_amdgcn_readfirstlane(C.tid >> 6);
    C.G = gridDim.x; C.bx = blockIdx.x; C.gw = C.bx * NWAVES + C.wave; C.NGW = C.G * NWAVES; C.gtid = C.bx * NTHR + C.tid; C.NT = C.G * NTHR;
    C.ws = args.ws;
#pragma unroll
    for (int i = 0; i < 21; ++i) C.in[i] = args.in[i];
    volatile LAS unsigned* MISC = (volatile LAS unsigned*)(C.lds + MISC_OFF);
    for (int u = C.tid; u < (LDS_BYTES - LDSCTL_OFF) / 4; u += NTHR) ((LAS unsigned*)(C.lds + LDSCTL_OFF))[u] = 0u;
    __syncthreads();
    const int lo = args.ph_lo, hi = args.ph_hi;
    unsigned* barw = (unsigned*)(C.ws + WS_CTL) + CW_BAR;
    XcdBarrier bar; bar.bar = barw; bar.x = 0; bar.st = nullptr;
    if (hi - lo > 1) bar = xcd_barrier_post(barw, MISC + 8);
#define IN(k) (lo <= (k) && (k) < hi)
#define SEAM(k) do { if (IN(k) && IN((k) + 1)) xcd_barrier(bar); } while (0)
    LAS unsigned char* ring = C.lds + RING_OFF;
    const float* cosT = WSP(float, WS_ROPE); const float* sinT = cosT + 1024;

    if (IN(0)) { p_prologue(C); } SEAM(0);
    if (IN(1)) { p_modfin_copy(C); } SEAM(1);
    if (IN(2)) { p_norm<false>(C, 0, 0, true); } SEAM(2);
    if (IN(3)) { pg8::Gemm g{WSP(bf16, WS_A), WSP(bf16, WS_WIN), RALL, NPROJP, D}; pg8::StaticOrder S; S.init(RALL, NPROJP, C.G, C.bx);
        pg8::EpiInProj E{WSP(bf16, WS_PROJ), cosT, sinT};
        pg8::gemm_phase<pg8::EpiInProj, pg8::StaticOrder, true, true>(ring, g, S, E); } SEAM(3);
    if (IN(4)) { p_mix1(C, 0); } SEAM(4);
    if (IN(5)) { p_mix2(C, 0); } SEAM(5);
    if (IN(6)) { pg8::Gemm g{WSP(bf16, WS_YMIX), WSP(bf16, WS_WOUT), RALL, D, D}; pg8::StaticOrder S; S.init(RALL, D, C.G, C.bx);
        pg8::EpiResid E{WSP(float, WS_H), WSP(float, WS_MOD), 2 * D};
        pg8::gemm_phase<pg8::EpiResid, pg8::StaticOrder, true, true>(ring, g, S, E); } SEAM(6);
    if (IN(7)) { p_norm<false>(C, 0, 1, true); } SEAM(7);
    if (IN(8)) { pg8::Gemm g{WSP(bf16, WS_A), WSP(bf16, WS_FIN), RALL, 2 * DFF, D}; pg8::StaticOrder S; S.init(RALL, 2 * DFF, C.G, C.bx);
        pg8::EpiSwiglu E{WSP(bf16, WS_HID)};
        pg8::gemm_phase<pg8::EpiSwiglu, pg8::StaticOrder, true, true>(ring, g, S, E); } SEAM(8);
    if (IN(9)) { pg8::Gemm g{WSP(bf16, WS_HID), WSP(bf16, WS_FOUT), RALL, D, DFF}; pg8::StaticOrder S; S.init(RALL, D, C.G, C.bx);
        pg8::EpiResid E{WSP(float, WS_H), WSP(float, WS_MOD), 5 * D};
        pg8::gemm_phase<pg8::EpiResid, pg8::StaticOrder, true, true>(ring, g, S, E); } SEAM(9);
    if (IN(10)) { p_norm<false>(C, 1, 0, true); } SEAM(10);
    if (IN(11)) { pg8::Gemm g{WSP(bf16, WS_A), WSP(bf16, WS_WIN) + (size_t)NPROJP * D, RALL, NPROJP, D}; pg8::StaticOrder S; S.init(RALL, NPROJP, C.G, C.bx);
        pg8::EpiInProj E{WSP(bf16, WS_PROJ), cosT, sinT};
        pg8::gemm_phase<pg8::EpiInProj, pg8::StaticOrder, true, true>(ring, g, S, E); } SEAM(11);
    if (IN(12)) { p_mix1(C, 1); } SEAM(12);
    if (IN(13)) { p_mix2(C, 1); } SEAM(13);
    if (IN(14)) { pg8::Gemm g{WSP(bf16, WS_YMIX), WSP(bf16, WS_WOUT) + (size_t)D * D, RLAT, D, D}; pg8::StaticOrder S; S.init(RLAT, D, C.G, C.bx);
        pg8::EpiResid E{WSP(float, WS_H), WSP(float, WS_MOD) + 30720, 2 * D};
        pg8::gemm_phase<pg8::EpiResid, pg8::StaticOrder, true, true>(ring, g, S, E); } SEAM(14);
    if (IN(15)) { p_norm<true>(C, 1, 1, false); } SEAM(15);
    if (IN(16)) { p_moe_lists(C); } SEAM(16);
    if (IN(17)) { const int T = __builtin_amdgcn_readfirstlane(WSP(int, WS_TILE)[255]);
        pg8::Gemm g{WSP(bf16, WS_SORT), WSP(bf16, WS_MIN), T * 256, 2 * DFF, D}; pg8::MoeOrder S; S.init(T, 2 * DFF, C.G, C.bx, WSP(int, WS_TILE), (size_t)2 * DFF * D);
        pg8::EpiSwiglu E{WSP(bf16, WS_HID)};
        pg8::gemm_phase<pg8::EpiSwiglu, pg8::MoeOrder, true, true>(ring, g, S, E); } SEAM(17);
    if (IN(18)) { const int T = __builtin_amdgcn_readfirstlane(WSP(int, WS_TILE)[255]);
        pg8::Gemm g{WSP(bf16, WS_HID), WSP(bf16, WS_MOUT), T * 256, D, DFF}; pg8::MoeOrder S; S.init(T, D, C.G, C.bx, WSP(int, WS_TILE), (size_t)D * DFF);
        pg8::EpiSlots E{WSP(float, WS_SLOT), WSP(float, WS_ROWW)};
        pg8::gemm_phase<pg8::EpiSlots, pg8::MoeOrder, true, true>(ring, g, S, E); } SEAM(18);
    if (IN(19)) { p_final(C, args.out); }
#undef IN
#undef SEAM
}

extern "C" void kernel_launch(void* const* d_in, const int* in_sizes, int n_in, void* d_out, int out_size, void* d_ws, size_t ws_size, hipStream_t stream) {
    static int grid = 0;
    if (grid == 0) {
        if (n_in != 21 || ws_size < WS_END) { fprintf(stderr, "kernel_launch: unexpected n_in %d or ws_size %zu (need %zu)\n", n_in, ws_size, (size_t)WS_END); grid = -1; return; }
        int dev = 0, cus = 0, per_cu = 0;
        if (hipGetDevice(&dev) != hipSuccess || hipDeviceGetAttribute(&cus, hipDeviceAttributeMultiprocessorCount, dev) != hipSuccess) { grid = -1; return; }
        if (hipFuncSetAttribute((const void*)fwd, hipFuncAttributeMaxDynamicSharedMemorySize, LDS_BYTES) != hipSuccess) { fprintf(stderr, "kernel_launch: hipFuncSetAttribute failed\n"); grid = -1; return; }
        if (hipOccupancyMaxActiveBlocksPerMultiprocessor(&per_cu, (const void*)fwd, NTHR, LDS_BYTES) != hipSuccess || per_cu < 1) fprintf(stderr, "kernel_launch: occupancy query reports %d\n", per_cu);
        (void)hipGetLastError();
        grid = cus < 256 ? cus : 256;
    }
    if (grid < 0) return;
    (void)hipMemsetAsync((char*)d_ws + WS_CTL, 0, CTL_ZERO_BYTES, stream);
    Args a{};
    for (int i = 0; i < 21; ++i) a.in[i] = (const float*)d_in[i];
    a.out = (float*)d_out; a.ws = (unsigned char*)d_ws;
#if MK_ONE_LAUNCH
    a.ph_lo = 0; a.ph_hi = NPHASES;
    hipLaunchKernelGGL(fwd, dim3(grid), dim3(NTHR), LDS_BYTES, stream, a);
#else
    for (int p = 0; p < NPHASES; ++p) { a.ph_lo = p; a.ph_hi = p + 1; hipLaunchKernelGGL(fwd, dim3(grid), dim3(NTHR), LDS_BYTES, stream, a); }
#endif
}
```

```cpp
#include <hip/hip_runtime.h>
#include <cstdio>
#include <cstdint>
namespace pg8 {
#define PG8_LAS __attribute__((address_space(3)))
typedef unsigned short bf16_t;
typedef short bf16x8 __attribute__((ext_vector_type(8)));
typedef float f32x4 __attribute__((ext_vector_type(4)));
typedef unsigned u32x4 __attribute__((ext_vector_type(4)));
constexpr int BM = 256, BK = 64, HALF = 128, HTB = HALF * BK * 2  , STAGE_BYTES = 8 * HTB, NXCD = 8, WGM = 8;

__host__ __device__ __forceinline__ int lds_byte(int r, int c) { const int st = (r >> 4) * 2 + (c >> 5), rr = r & 15, cc = c & 31, ob = rr * 64 + cc * 2; return st * 1024 + (ob ^ (((ob >> 9) & 1) << 5)); }
__host__ __device__ __forceinline__ void stage_rc(int b, int& R, int& C) { const int st = b / 1024, sb = b % 1024, swz = sb ^ (((sb >> 9) & 1) << 5); R = (st >> 1) * 16 + swz / 64; C = (st & 1) * 32 + (swz % 64) / 2; }
__host__ __device__ __forceinline__ int perm32(int rho) { const int n = rho >> 4, i = rho & 15; return 8 * (i >> 2) + 4 * n + (i & 3); }

struct Unit { int pm, pn, ks; };
struct Gemm { const bf16_t* A; const bf16_t* Bt; int M, N, K, ld; };

struct StaticOrder {
    int nM, nN, nwg, G, c;
    __host__ __device__ void init(int M, int N, int G_, int c_) { nM = M / BM; nN = N / BM; nwg = nM * nN; G = G_; c = c_; }
    __host__ __device__ bool next(int i, Unit& u) const {
        const long L = (long)i * G + c; if (L >= nwg) return false;
        int wgid = (int)L; { const int q = nwg / NXCD, r = nwg % NXCD, xcd = wgid % NXCD, off = wgid / NXCD; wgid = (xcd < r ? xcd * (q + 1) : r * (q + 1) + (xcd - r) * q) + off; }
        const int nig = WGM * nN, gid = wgid / nig, fm = gid * WGM, gsz = (nM - fm) < WGM ? (nM - fm) : WGM;
        u.pm = fm + ((wgid % nig) % gsz); u.pn = (wgid % nig) / gsz; u.ks = 0; return true;
    }
    __device__ __forceinline__ void a_ready(const Unit&) const {}
    __device__ __forceinline__ void done(const Unit&) const {}
    __device__ __forceinline__ const bf16_t* bt(const Gemm& g, const Unit&) const { return g.Bt; }
};

__device__ __forceinline__ unsigned cvt_pk_bf16(float lo, float hi) { unsigned r; asm volatile("v_cvt_pk_bf16_f32 %0, %1, %2" : "=v"(r) : "v"(lo), "v"(hi)); return r; }
typedef float f32x2 __attribute__((ext_vector_type(2)));

typedef int i32x4_t __attribute__((ext_vector_type(4)));
typedef int i32x8_t __attribute__((ext_vector_type(8)));
__device__ __forceinline__ i32x8_t cat8(bf16x8 lo, bf16x8 hi) { const i32x4_t l = __builtin_bit_cast(i32x4_t, lo), h = __builtin_bit_cast(i32x4_t, hi); return __builtin_shufflevector(l, h, 0, 1, 2, 3, 4, 5, 6, 7); }
template <class Epi, class Sched, bool ALIGN_EPI = false, bool SP2 = false, bool FP8 = false>
__device__ __forceinline__ void gemm_phase(PG8_LAS unsigned char* lds, const Gemm g, const Sched& S, const Epi& E) {
    const int tid = threadIdx.x, wid = __builtin_amdgcn_readfirstlane(tid >> 6), lane = tid & 63, wr = wid >> 2, wc = wid & 3, fr = lane & 15, fq = lane >> 4;
    const int K = g.K, nt = K / BK, LD = g.ld;
    unsigned voffA[2], voffB[2];
#pragma unroll
    for (int i = 0; i < 2; ++i) { int R, C; stage_rc(tid * 16 + i * 8192, R, C); const int Rb = Epi::PERM ? ((R & ~31) + perm32(R & 31)) : R;
        voffA[i] = (unsigned)(R * LD + C) * 2u; voffB[i] = (unsigned)(Rb * LD + C) * 2u; }
    const size_t kstep = (size_t)(BK * 2);
    const size_t hstep = (size_t)HALF * LD * 2;
    const size_t tstep = 2 * hstep;
    const unsigned ldsw = (unsigned)wid * 1024u;
    const int aoff = lds_byte(wr * 64 + fr, fq * 8), boff = lds_byte(wc * 32 + fr, fq * 8);
#define PG8_SA(b, h) (((b) * 2 + (h)) * HTB)
#define PG8_SB(b, h) ((4 + (b) * 2 + (h)) * HTB)
#define PG8_STAGE(bufoff, gbase, voff) do { _Pragma("unroll") for (int _i = 0; _i < 2; ++_i) \
        __builtin_amdgcn_global_load_lds((const unsigned*)((const char*)(gbase) + (voff)[_i]), (PG8_LAS unsigned*)(lds + (bufoff) + ldsw + _i * 8192), 16, 0, 0); } while (0)
#define PG8_LDA(dst, b, h) do { if constexpr (FP8) { _Pragma("unroll") for (int m = 0; m < 4; ++m) dst##_8[m] = cat8(*(const PG8_LAS bf16x8*)(lds + PG8_SA(b, h) + aoff + m * 2048), *(const PG8_LAS bf16x8*)(lds + PG8_SA(b, h) + aoff + m * 2048 + 1024)); } \
    else { _Pragma("unroll") for (int m = 0; m < 4; ++m) _Pragma("unroll") for (int k = 0; k < 2; ++k) dst[m][k] = *(const PG8_LAS bf16x8*)(lds + PG8_SA(b, h) + aoff + m * 2048 + k * 1024); } } while (0)
#define PG8_LDB(dst, b, h) do { if constexpr (FP8) { _Pragma("unroll") for (int n = 0; n < 2; ++n) dst##_8[n] = cat8(*(const PG8_LAS bf16x8*)(lds + PG8_SB(b, h) + boff + n * 2048), *(const PG8_LAS bf16x8*)(lds + PG8_SB(b, h) + boff + n * 2048 + 1024)); } \
    else { _Pragma("unroll") for (int n = 0; n < 2; ++n) _Pragma("unroll") for (int k = 0; k < 2; ++k) dst[n][k] = *(const PG8_LAS bf16x8*)(lds + PG8_SB(b, h) + boff + n * 2048 + k * 1024); } } while (0)
#define PG8_MMA(ai, bj, At, Bt) do { __builtin_amdgcn_s_setprio(1); _Pragma("unroll") for (int m = 0; m < 4; ++m) _Pragma("unroll") for (int n = 0; n < 2; ++n) { \
        if constexpr (FP8) { asm volatile("v_mfma_scale_f32_16x16x128_f8f6f4 %0, %1, %2, %0, %3, %4 op_sel_hi:[0,0,0]" : "+v"(acc[ai][bj][m][n]) : "v"(Bt##_8[n]), "v"(At##_8[m]), "v"(f8_scale_w), "v"(f8_scale_a)); } \
        else { _Pragma("unroll") for (int k = 0; k < 2; ++k) acc[ai][bj][m][n] = __builtin_amdgcn_mfma_f32_16x16x32_bf16(Bt[n][k], At[m][k], acc[ai][bj][m][n], 0, 0, 0); } } __builtin_amdgcn_s_setprio(0); } while (0)
#define PG8_WAIT_V(n) asm volatile("s_waitcnt vmcnt(" #n ")" ::: "memory")
#define PG8_WAIT_L(n) asm volatile("s_waitcnt lgkmcnt(" #n ")" ::: "memory")
#define PG8_BAR __builtin_amdgcn_s_barrier()
#define PG8_SCHED __builtin_amdgcn_sched_barrier(0)
    Unit cur, nxt; int ui = 0;
    if (!S.next(0, cur)) return;
    f32x4 acc[2][2][4][2];
#pragma unroll
    for (int a = 0; a < 2; ++a)
#pragma unroll
        for (int b = 0; b < 2; ++b)
#pragma unroll
            for (int m = 0; m < 4; ++m)
#pragma unroll
                for (int n = 0; n < 2; ++n) acc[a][b][m][n] = (f32x4){0.f, 0.f, 0.f, 0.f};
    bf16x8 At[4][2], B0[2][2], B1[2][2]; i32x8_t At_8[4], B0_8[2], B1_8[2];
    const int f8_scale_w = 0x79797979, f8_scale_a = 0x7f7f7f7f;
    const char* cA = (const char*)g.A + (size_t)cur.pm * tstep + (size_t)cur.ks * K * 2; const char* cB = (const char*)S.bt(g, cur) + (size_t)cur.pn * tstep + (size_t)cur.ks * K * 2;
    S.a_ready(cur);
    if constexpr (SP2) {
        PG8_STAGE(PG8_SB(0, 0), cB, voffB); PG8_STAGE(PG8_SB(0, 1), cB + hstep, voffB); PG8_STAGE(PG8_SA(0, 0), cA, voffA); PG8_STAGE(PG8_SA(0, 1), cA + hstep, voffA);
        if (wr == 1) PG8_BAR;
        PG8_WAIT_V(2); PG8_BAR;
        PG8_STAGE(PG8_SB(1, 0), cB + kstep, voffB); PG8_STAGE(PG8_SA(1, 0), cA + kstep, voffA); PG8_STAGE(PG8_SB(1, 1), cB + hstep + kstep, voffB);
        PG8_WAIT_V(6); PG8_BAR;
    } else {
        PG8_STAGE(PG8_SB(0, 0), cB, voffB); PG8_STAGE(PG8_SA(0, 0), cA, voffA); PG8_STAGE(PG8_SB(0, 1), cB + hstep, voffB); PG8_STAGE(PG8_SA(0, 1), cA + hstep, voffA);
        if (wr == 1) PG8_BAR;
        PG8_WAIT_V(4); PG8_BAR;
        PG8_STAGE(PG8_SB(1, 0), cB + kstep, voffB); PG8_STAGE(PG8_SA(1, 0), cA + kstep, voffA); PG8_STAGE(PG8_SB(1, 1), cB + hstep + kstep, voffB);
        PG8_WAIT_V(6); PG8_BAR;
    }
    for (;;) {
        const bool has_next = S.next(ui + 1, nxt);
        const char* nA = has_next ? (const char*)g.A + (size_t)nxt.pm * tstep + (size_t)nxt.ks * K * 2 : cA; const char* nB = has_next ? (const char*)S.bt(g, nxt) + (size_t)nxt.pn * tstep + (size_t)nxt.ks * K * 2 : cB;
#pragma clang loop unroll(disable)
        for (int t = 0; t < nt; t += 2) {
            const bool last = (t == nt - 2);
            const char* a1 = cA + (size_t)(t + 1) * kstep;
            const char* a2 = last ? nA : cA + (size_t)(t + 2) * kstep; const char* b2 = last ? nB : cB + (size_t)(t + 2) * kstep;
            const char* a3 = a2 + kstep; const char* b3 = b2 + kstep;
            if (last && has_next) S.a_ready(nxt);
            if constexpr (SP2) {
            PG8_LDB(B0, 0, 0); PG8_LDB(B1, 0, 1); PG8_SCHED; PG8_LDA(At, 0, 0); PG8_STAGE(PG8_SA(1, 1), a1 + hstep, voffA);
            PG8_WAIT_V(8); PG8_WAIT_L(0); PG8_BAR; PG8_MMA(0, 0, At, B0); PG8_MMA(0, 1, At, B1); PG8_BAR; PG8_SCHED;
            PG8_LDA(At, 0, 1); PG8_STAGE(PG8_SB(0, 0), b2, voffB); PG8_STAGE(PG8_SB(0, 1), b2 + hstep, voffB); PG8_STAGE(PG8_SA(0, 0), a2, voffA);
            PG8_WAIT_V(8); PG8_WAIT_L(0); PG8_BAR; PG8_MMA(1, 0, At, B0); PG8_MMA(1, 1, At, B1); PG8_BAR; PG8_SCHED;
            PG8_LDB(B0, 1, 0); PG8_LDB(B1, 1, 1); PG8_SCHED; PG8_LDA(At, 1, 0); PG8_STAGE(PG8_SA(0, 1), a2 + hstep, voffA);
            PG8_WAIT_V(8); PG8_WAIT_L(0); PG8_BAR; PG8_MMA(0, 0, At, B0); PG8_MMA(0, 1, At, B1); PG8_BAR; PG8_SCHED;
            PG8_LDA(At, 1, 1); PG8_STAGE(PG8_SB(1, 0), b3, voffB); PG8_STAGE(PG8_SB(1, 1), b3 + hstep, voffB); PG8_STAGE(PG8_SA(1, 0), a3, voffA);
            PG8_WAIT_V(8); PG8_WAIT_L(0); PG8_BAR; PG8_MMA(1, 0, At, B0); PG8_MMA(1, 1, At, B1); PG8_BAR; PG8_SCHED;
            } else {
            PG8_LDB(B0, 0, 0); PG8_SCHED; PG8_LDA(At, 0, 0); PG8_STAGE(PG8_SA(1, 1), a1 + hstep, voffA);
            PG8_WAIT_L(8); PG8_BAR; PG8_WAIT_L(0); PG8_MMA(0, 0, At, B0); PG8_BAR; PG8_SCHED;
            PG8_LDB(B1, 0, 1); PG8_STAGE(PG8_SB(0, 0), b2, voffB);
            PG8_BAR; PG8_WAIT_L(0); PG8_MMA(0, 1, At, B1); PG8_BAR;
            PG8_LDA(At, 0, 1); PG8_STAGE(PG8_SA(0, 0), a2, voffA);
            PG8_BAR; PG8_WAIT_L(0); PG8_MMA(1, 0, At, B0); PG8_BAR; PG8_SCHED;
            PG8_STAGE(PG8_SB(0, 1), b2 + hstep, voffB);
            PG8_WAIT_V(6); PG8_BAR; PG8_MMA(1, 1, At, B1); PG8_BAR;
            PG8_LDB(B0, 1, 0); PG8_SCHED; PG8_LDA(At, 1, 0); PG8_STAGE(PG8_SA(0, 1), a2 + hstep, voffA);
            PG8_WAIT_L(8); PG8_BAR; PG8_WAIT_L(0); PG8_MMA(0, 0, At, B0); PG8_BAR; PG8_SCHED;
            PG8_LDB(B1, 1, 1); PG8_STAGE(PG8_SB(1, 0), b3, voffB);
            PG8_BAR; PG8_WAIT_L(0); PG8_MMA(0, 1, At, B1); PG8_BAR;
            PG8_LDA(At, 1, 1); PG8_STAGE(PG8_SA(1, 0), a3, voffA);
            PG8_BAR; PG8_WAIT_L(0); PG8_MMA(1, 0, At, B0); PG8_BAR; PG8_SCHED;
            PG8_STAGE(PG8_SB(1, 1), b3 + hstep, voffB);
            PG8_WAIT_V(6); PG8_BAR; PG8_MMA(1, 1, At, B1); PG8_BAR;
            }
        }
        if constexpr (ALIGN_EPI) { if (wr == 0) PG8_BAR; }
        if constexpr (FP8) asm volatile("s_nop 15\n\ts_nop 15" ::: "memory");
        if constexpr (!Epi::AFTER_DRAIN) { E(acc, cur, wr, wc, fr, fq); S.done(cur); }
        if (!has_next) break;
#pragma unroll
        for (int a = 0; a < 2; ++a)
#pragma unroll
            for (int b = 0; b < 2; ++b)
#pragma unroll
                for (int m = 0; m < 4; ++m)
#pragma unroll
                    for (int n = 0; n < 2; ++n) acc[a][b][m][n] = (f32x4){0.f, 0.f, 0.f, 0.f};
        cur = nxt; cA = nA; cB = nB; ++ui;
        if constexpr (ALIGN_EPI) { if (wr == 1) PG8_BAR; }
    }
    PG8_WAIT_V(0);
    if constexpr (!ALIGN_EPI) { if (wr == 0) PG8_BAR; }
    PG8_BAR;
    if constexpr (Epi::AFTER_DRAIN) { E.fused(acc, cur, wr, wc, fr, fq, lds, wid, lane); S.done(cur); }
#undef PG8_SA
#undef PG8_SB
#undef PG8_STAGE
#undef PG8_LDA
#undef PG8_LDB
#undef PG8_MMA
#undef PG8_WAIT_V
#undef PG8_WAIT_L
#undef PG8_BAR
#undef PG8_SCHED
}
}


constexpr int NWAVES = 8, NTHR = 512;
constexpr int D = 1024, NB = 4, SEQ = 4096, CTXL = 256, RLAT = NB * SEQ, RCTX = NB * CTXL, RALL = RLAT + RCTX;
constexpr int NPROJ = 3456, NPROJP = 3584, DFF = 2816, NE = 8;
constexpr int C_RQ = 0, C_RK = 384, C_RV = 768, C_RG = 1152, C_CB = 1536, C_CC = 1792, C_CX = 2048, C_NQ = 2304, C_NK = 2688, C_NV = 3072;
constexpr int MOE_ROWS = 2 * RLAT + NE * 256;
constexpr float EPS = 1e-6f;

constexpr size_t MiB = 1u << 20, KiB = 1u << 10;
constexpr size_t WS_CTL = 0, CTL_ZERO_BYTES = 1 * MiB;
constexpr size_t WS_MODP = 1 * MiB;
constexpr size_t WS_MOD = 3 * MiB;
constexpr size_t WS_ROWW = 3 * MiB + 256 * KiB;
constexpr size_t WS_ROPE = 3 * MiB + 512 * KiB;
constexpr size_t WS_CNT = WS_ROPE + 16 * KiB;
constexpr size_t WS_TILE = WS_ROPE + 32 * KiB;
constexpr size_t WS_TOKE = WS_ROPE + 64 * KiB;
constexpr size_t WS_TOKW = WS_ROPE + 128 * KiB;
constexpr size_t WS_TOKP = WS_ROPE + 256 * KiB;
constexpr size_t WS_WIN = 4 * MiB;
constexpr size_t WS_WOUT = 18 * MiB;
constexpr size_t WS_FIN = 22 * MiB;
constexpr size_t WS_FOUT = 33 * MiB;
constexpr size_t WS_MIN = 39 * MiB;
constexpr size_t WS_MOUT = 127 * MiB;
constexpr size_t WS_H = 171 * MiB;
constexpr size_t WS_A = 239 * MiB;
constexpr size_t WS_PROJ = 273 * MiB;
constexpr size_t WS_YMIX = 392 * MiB;
constexpr size_t WS_HID = 273 * MiB;
constexpr size_t WS_OBUF = 474 * MiB;
constexpr size_t WS_SORT = 526 * MiB;
constexpr size_t WS_SLOT = 474 * MiB;
constexpr size_t WS_PART = 610 * MiB;
constexpr size_t WS_END = 654 * MiB;
constexpr int CW_BAR = 4096;

constexpr int RING_OFF = 0, RING_BYTES = 131072;
constexpr int LDSCTL_OFF = RING_BYTES, MISC_OFF = LDSCTL_OFF + 320;
constexpr int LDS_BYTES = 147456;

#define GAS __attribute__((address_space(1)))
#define LAS __attribute__((address_space(3)))
typedef unsigned short bf16;
typedef unsigned v4u __attribute__((ext_vector_type(4)));
typedef unsigned v2u __attribute__((ext_vector_type(2)));
typedef float f32x4 __attribute__((ext_vector_type(4)));
typedef GAS unsigned gu32;
#define RLX_AGENT __ATOMIC_RELAXED, __HIP_MEMORY_SCOPE_AGENT
#define LDS_WAIT() asm volatile("s_waitcnt lgkmcnt(0)" ::: "memory")
__device__ __forceinline__ unsigned f2bf(float f) { unsigned u = __builtin_bit_cast(unsigned, f); return (u + 0x7fffu + ((u >> 16) & 1u)) >> 16; }
__device__ __forceinline__ unsigned pk2(float lo, float hi) { return f2bf(lo) | (f2bf(hi) << 16); }
__device__ __forceinline__ float bf2f(unsigned short b) { return __builtin_bit_cast(float, (unsigned)b << 16); }
__device__ __forceinline__ float bflo(unsigned u) { return __builtin_bit_cast(float, u << 16); }
__device__ __forceinline__ float bfhi(unsigned u) { return __builtin_bit_cast(float, u & 0xffff0000u); }
__device__ __forceinline__ float siluf(float x) { return x * __builtin_amdgcn_rcpf(1.f + __expf(-x)); }
__device__ __forceinline__ float wave_sum(float v) {
#pragma unroll
    for (int o = 1; o < 64; o <<= 1) v += __shfl_xor(v, o);
    return v;
}
__device__ __forceinline__ float wave_max(float v) {
#pragma unroll
    for (int o = 1; o < 64; o <<= 1) v = fmaxf(v, __shfl_xor(v, o));
    return v;
}
#define XB_TMO      128
#define XB_XCNT(j)  (256  + 64 * (j))
#define XB_XSUB(j)  (1280 + 64 * (j))
#define XB_XGEN(j)  (2304 + 64 * (j))
#define XB_TOP      3328
#define XB_TOPGEN   3392
#define XCD_BAR_WORDS 3456
#define XB_SPIN_CAP (1u << 18)

__device__ __forceinline__ unsigned xb_ld(unsigned* p)              { return __hip_atomic_load(p, __ATOMIC_RELAXED, __HIP_MEMORY_SCOPE_AGENT); }
__device__ __forceinline__ unsigned xb_add(unsigned* p, unsigned v) { return __hip_atomic_fetch_add(p, v, __ATOMIC_RELAXED, __HIP_MEMORY_SCOPE_AGENT); }
__device__ __forceinline__ unsigned xb_xcc_id() { return (unsigned)__builtin_amdgcn_s_getreg((3 << 11) | 20) & 0xFu; }
#define XB_SPIN(cond, bar) do { unsigned _sp = 0; while (cond) { __builtin_amdgcn_s_sleep(1); \
    if ((++_sp & 255u) == 0u) { if (xb_ld(&(bar)[XB_TMO])) break; if (_sp > XB_SPIN_CAP) { atomicAdd(&(bar)[XB_TMO], 1u); break; } } } } while (0)

struct XcdBarrier {
    unsigned* bar; unsigned x;
    volatile LAS unsigned* st;
};

__device__ __forceinline__ XcdBarrier xcd_barrier_post(unsigned* bar, volatile LAS unsigned* st) {
    XcdBarrier b; b.bar = bar; b.x = xb_xcc_id(); b.st = st;
    if (threadIdx.x == 0) (void)xb_add(&bar[XB_XCNT(b.x)], 1u);
    return b;
}
__device__ __forceinline__ void xcd_barrier_complete(unsigned* bar, unsigned x, unsigned& nloc, unsigned& nx) {
    const unsigned G = gridDim.x * gridDim.y * gridDim.z;
    unsigned sum, cnt, mine, sp = 0u;
    for (;;) {
        sum = 0u; cnt = 0u; mine = 0u;
#pragma unroll
        for (unsigned j = 0; j < 16; ++j) { const unsigned c = xb_ld(&bar[XB_XCNT(j)]); sum += c; cnt += (c > 0u) ? 1u : 0u; mine = (j == x) ? c : mine; }
        if (sum == G) break;
        __builtin_amdgcn_s_sleep(1);
        if ((++sp & 255u) == 0u) { if (xb_ld(&bar[XB_TMO])) break; if (sp > XB_SPIN_CAP) { atomicAdd(&bar[XB_TMO], 1u); break; } }
    }
    nloc = mine > 0u ? mine : 1u; nx = cnt > 0u ? cnt : 1u;
}

__device__ __forceinline__ void xcd_barrier(const XcdBarrier& b) {
    asm volatile("s_waitcnt vmcnt(0)" ::: "memory");
    __syncthreads();
    if (threadIdx.x == 0) {
        unsigned* bar = b.bar;
        __builtin_amdgcn_s_waitcnt(0);
        unsigned nloc = b.st[0], nx = b.st[1];
        if (nloc == 0u) { xcd_barrier_complete(bar, b.x, nloc, nx); b.st[0] = nloc; b.st[1] = nx; }
        const unsigned old = xb_add(&bar[XB_XSUB(b.x)], 1u);
        const unsigned gen = old / nloc;
        if (old + 1u == (gen + 1u) * nloc) {
            __builtin_amdgcn_fence(__ATOMIC_RELEASE, "agent");
            asm volatile("s_waitcnt vmcnt(0)" ::: "memory");
            const unsigned og = xb_add(&bar[XB_TOP], 1u);
            const unsigned tg = og / nx;
            if (og + 1u == (tg + 1u) * nx) xb_add(&bar[XB_TOPGEN], 1u);
            else XB_SPIN(xb_ld(&bar[XB_TOPGEN]) == tg, bar);
            __builtin_amdgcn_fence(__ATOMIC_ACQUIRE, "agent");
            xb_add(&bar[XB_XGEN(b.x)], 1u);
            asm volatile("s_waitcnt vmcnt(0)" ::: "memory");
        } else {
            XB_SPIN(xb_ld(&bar[XB_XGEN(b.x)]) == gen, bar);
            __builtin_amdgcn_fence(__ATOMIC_ACQUIRE, "agent");
            asm volatile("s_waitcnt vmcnt(0)" ::: "memory");
        }
    }
    __syncthreads();
}


namespace pg8 {
struct EpiInProj {
    static constexpr bool PERM = true, AFTER_DRAIN = false;
    bf16_t* O; const float* cosT; const float* sinT;
    __device__ __forceinline__ void operator()(const f32x4 (&acc)[2][2][4][2], const Unit& u, int wr, int wc, int fr, int fq) const {
        const bool rope = (u.pn <= 2) && (u.pm < 64);
        const int row0 = u.pm * BM + wr * 64 + fr, col0 = u.pn * BM + wc * 32 + 8 * fq;
        const float sgn = (fq < 2) ? -1.f : 1.f;
#pragma unroll
        for (int ai = 0; ai < 2; ++ai)
#pragma unroll
            for (int m = 0; m < 4; ++m) {
                const int row = row0 + ai * HALF + m * 16;
                f32x4 cs0 = {1.f, 1.f, 1.f, 1.f}, cs1 = cs0, sn0 = {0.f, 0.f, 0.f, 0.f}, sn1 = sn0;
                if (rope) { const int t = row & 4095, pos = (wc & 1) ? (t & 63) : (t >> 6); const float* cp = cosT + pos * 16 + 8 * (fq & 1); const float* sp = sinT + pos * 16 + 8 * (fq & 1);
                    cs0 = *(const f32x4*)cp; cs1 = *(const f32x4*)(cp + 4); sn0 = *(const f32x4*)sp; sn1 = *(const f32x4*)(sp + 4); }
#pragma unroll
                for (int bj = 0; bj < 2; ++bj) {
                    f32x4 v0 = acc[ai][bj][m][0], v1 = acc[ai][bj][m][1];
                    if (rope) {
                        f32x4 p0, p1;
#pragma unroll
                        for (int j = 0; j < 4; ++j) { p0[j] = __shfl_xor(v0[j], 32); p1[j] = __shfl_xor(v1[j], 32); }
                        v0 = v0 * cs0 + (p0 * sn0) * sgn; v1 = v1 * cs1 + (p1 * sn1) * sgn;
                    }
                    const float sc = (u.pn == 2 || (u.pn == 1 && bj == 1)) ? 0.125f : 1.f;
                    v0 = v0 * sc; v1 = v1 * sc;
                    u32x4 w; w.x = cvt_pk_bf16(v0[0], v0[1]); w.y = cvt_pk_bf16(v0[2], v0[3]); w.z = cvt_pk_bf16(v1[0], v1[1]); w.w = cvt_pk_bf16(v1[2], v1[3]);
                    *(u32x4*)(O + (size_t)row * 3584 + col0 + bj * HALF) = w;
                }
            }
    }
};
struct EpiResid {
    static constexpr bool PERM = false, AFTER_DRAIN = false;
    float* H; const float* src_lat; const float* src_ctx; const float* gmod; int goff;
    __device__ __forceinline__ void operator()(const f32x4 (&acc)[2][2][4][2], const Unit& u, int wr, int wc, int fr, int fq) const {
        const int row0 = u.pm * BM + wr * 64 + fr, col0 = u.pn * BM + wc * 32 + 4 * fq;
        const int bi = (u.pm < 64) ? (u.pm >> 4) : 4;
        const float* src = (u.pm < 64) ? src_lat : src_ctx - (size_t)16384 * 1024;
        f32x4 gv[2][2];
#pragma unroll
        for (int bj = 0; bj < 2; ++bj)
#pragma unroll
            for (int n = 0; n < 2; ++n) gv[bj][n] = *(const f32x4*)(gmod + bi * 6144 + goff + col0 + bj * HALF + n * 16);
#pragma unroll
        for (int ai = 0; ai < 2; ++ai)
            {
                f32x4 sv[4][2][2];
#pragma unroll
                for (int m = 0; m < 4; ++m)
#pragma unroll
                    for (int bj = 0; bj < 2; ++bj)
#pragma unroll
                        for (int n = 0; n < 2; ++n) sv[m][bj][n] = *(const f32x4*)(src + (size_t)(row0 + ai * HALF + m * 16) * 1024 + col0 + bj * HALF + n * 16);
                asm volatile("" ::: "memory");
#pragma unroll
                for (int m = 0; m < 4; ++m)
#pragma unroll
                    for (int bj = 0; bj < 2; ++bj)
#pragma unroll
                        for (int n = 0; n < 2; ++n) *(f32x4*)(H + (size_t)(row0 + ai * HALF + m * 16) * 1024 + col0 + bj * HALF + n * 16) = sv[m][bj][n] + gv[bj][n] * acc[ai][bj][m][n];
                asm volatile("" ::: "memory");
            }
    }
};
struct EpiSwiglu {
    static constexpr bool PERM = true, AFTER_DRAIN = false;
    bf16_t* O;
    __device__ __forceinline__ void operator()(const f32x4 (&acc)[2][2][4][2], const Unit& u, int wr, int wc, int fr, int fq) const {
        const int row0 = u.pm * BM + wr * 64 + fr, col0 = u.pn * HALF + wc * 32 + 8 * fq;
#pragma unroll
        for (int ai = 0; ai < 2; ++ai)
#pragma unroll
            for (int m = 0; m < 4; ++m) {
                float hv[8];
#pragma unroll
                for (int n = 0; n < 2; ++n)
#pragma unroll
                    for (int j = 0; j < 4; ++j) { const float g = acc[ai][0][m][n][j], up = acc[ai][1][m][n][j]; hv[n * 4 + j] = g * __builtin_amdgcn_rcpf(1.f + __expf(-g)) * up; }
                u32x4 w; w.x = cvt_pk_bf16(hv[0], hv[1]); w.y = cvt_pk_bf16(hv[2], hv[3]); w.z = cvt_pk_bf16(hv[4], hv[5]); w.w = cvt_pk_bf16(hv[6], hv[7]);
                *(u32x4*)(O + (size_t)(row0 + ai * HALF + m * 16) * 2816 + col0) = w;
            }
    }
};
__device__ __forceinline__ unsigned pk4_fp8(float a, float b, float c2, float d) {
    a = fminf(fmaxf(a, -448.f), 448.f); b = fminf(fmaxf(b, -448.f), 448.f); c2 = fminf(fmaxf(c2, -448.f), 448.f); d = fminf(fmaxf(d, -448.f), 448.f);
    unsigned w = 0; w = __builtin_amdgcn_cvt_pk_fp8_f32(a, b, w, false); w = __builtin_amdgcn_cvt_pk_fp8_f32(c2, d, w, true); return w;
}
struct EpiSwigluF8 {
    static constexpr bool PERM = true, AFTER_DRAIN = false;
    unsigned char* O;
    __device__ __forceinline__ void operator()(const f32x4 (&acc)[2][2][4][2], const Unit& u, int wr, int wc, int fr, int fq) const {
        const int row0 = u.pm * BM + wr * 64 + fr, col0 = u.pn * HALF + wc * 32 + 8 * fq;
#pragma unroll
        for (int ai = 0; ai < 2; ++ai)
#pragma unroll
            for (int m = 0; m < 4; ++m) {
                float hv[8];
#pragma unroll
                for (int n = 0; n < 2; ++n)
#pragma unroll
                    for (int j = 0; j < 4; ++j) { const float g = acc[ai][0][m][n][j], up = acc[ai][1][m][n][j]; hv[n * 4 + j] = g * __builtin_amdgcn_rcpf(1.f + __expf(-g)) * up; }
                typedef unsigned u32x2 __attribute__((ext_vector_type(2)));
                u32x2 w; w.x = pk4_fp8(hv[0], hv[1], hv[2], hv[3]); w.y = pk4_fp8(hv[4], hv[5], hv[6], hv[7]);
                *(u32x2*)(O + (size_t)(row0 + ai * HALF + m * 16) * 2816 + col0) = w;
            }
    }
};
struct EpiSlots {
    static constexpr bool PERM = true, AFTER_DRAIN = false;
    bf16_t* S; const float* roww;
    __device__ __forceinline__ void operator()(const f32x4 (&acc)[2][2][4][2], const Unit& u, int wr, int wc, int fr, int fq) const {
        const int row0 = u.pm * BM + wr * 64 + fr, col0 = u.pn * BM + wc * 32 + 8 * fq;
#pragma unroll
        for (int ai = 0; ai < 2; ++ai)
#pragma unroll
            for (int m = 0; m < 4; ++m) { const int row = row0 + ai * HALF + m * 16; const float w = roww[row]; bf16_t* rowp = S + (size_t)row * 1024 + col0;
#pragma unroll
                for (int bj = 0; bj < 2; ++bj) { const f32x4 v0 = acc[ai][bj][m][0] * w, v1 = acc[ai][bj][m][1] * w;
                    u32x4 q; q.x = cvt_pk_bf16(v0[0], v0[1]); q.y = cvt_pk_bf16(v0[2], v0[3]); q.z = cvt_pk_bf16(v1[0], v1[1]); q.w = cvt_pk_bf16(v1[2], v1[3]);
                    *(u32x4*)(rowp + bj * HALF) = q; } }
    }
};
struct EpiPartial {
    static constexpr bool PERM = false, AFTER_DRAIN = false;
    float* P; const float* gmod; int goff;
    __device__ __forceinline__ void operator()(const f32x4 (&acc)[2][2][4][2], const Unit& u, int wr, int wc, int fr, int fq) const {
        const int row0 = u.pm * BM + wr * 64 + fr, col0 = u.pn * BM + wc * 32 + 4 * fq;
        f32x4 gv[2][2];
#pragma unroll
        for (int bj = 0; bj < 2; ++bj)
#pragma unroll
            for (int n = 0; n < 2; ++n) gv[bj][n] = *(const f32x4*)(gmod + 4 * 6144 + goff + col0 + bj * HALF + n * 16);
        float* base = P + (size_t)u.ks * 1024 * 1024;
#pragma unroll
        for (int ai = 0; ai < 2; ++ai)
#pragma unroll
            for (int m = 0; m < 4; ++m) { float* rowp = base + (size_t)(row0 + ai * HALF + m * 16) * 1024 + col0;
#pragma unroll
                for (int bj = 0; bj < 2; ++bj)
#pragma unroll
                    for (int n = 0; n < 2; ++n) *(f32x4*)(rowp + bj * HALF + n * 16) = gv[bj][n] * acc[ai][bj][m][n]; }
    }
};
struct SplitOrder {
    int nS, G, c;
    __device__ void init(int nS_, int G_, int c_) { nS = nS_; G = G_; c = c_; }
    __device__ bool next(int i, Unit& u) const { const int L = i * G + c; if (L >= 16 * nS) return false; u.ks = L % nS; const int t = L / nS; u.pm = t >> 2; u.pn = t & 3; return true; }
    __device__ __forceinline__ void a_ready(const Unit&) const {}
    __device__ __forceinline__ void done(const Unit&) const {}
    __device__ __forceinline__ const bf16_t* bt(const Gemm& g, const Unit&) const { return g.Bt; }
};
struct MoeOrder {
    StaticOrder so; const int* tile_e; size_t estride;
    __device__ void init(int T, int N, int G, int c, const int* te, size_t es) { so.init(T * BM, N, G, c); tile_e = te; estride = es; }
    __device__ bool next(int i, Unit& u) const { return so.next(i, u); }
    __device__ __forceinline__ void a_ready(const Unit&) const {}
    __device__ __forceinline__ void done(const Unit&) const {}
    __device__ __forceinline__ const bf16_t* bt(const Gemm& g, const Unit& u) const { const int e = __builtin_amdgcn_readfirstlane(tile_e[u.pm]); return g.Bt + (size_t)e * estride; }
};
}

struct Ctx {
    LAS unsigned char* lds;
    int tid, lane, wave, G, bx, gw, NGW, gtid, NT;
    unsigned char* ws;
    const float* in[21];
};
#define WSP(T, off) ((T*)(C.ws + (off)))

template <bool ILV>
__device__ __forceinline__ void transpose_item(const float* W, int K, int N, bf16* WT, LAS float* scr, int item, int lane) {
    const int nblk = N / 32, kb = item / nblk, nb = item % nblk, k0 = 64 * kb, n0 = 32 * nb;
    int drow = n0;
    if (ILV) drow = (n0 < DFF) ? (n0 / 128) * 256 + (n0 % 128) : ((n0 - DFF) / 128) * 256 + 128 + ((n0 - DFF) % 128);
#pragma unroll 8
    for (int i = 0; i < 32; ++i) { const int kk = 2 * i + (lane >> 5); scr[kk * 33 + (lane & 31)] = __builtin_nontemporal_load(&W[(size_t)(k0 + kk) * N + n0 + (lane & 31)]); }
    LDS_WAIT(); asm volatile("" ::: "memory");
    const int c = lane & 7;
#pragma unroll
    for (int j = 0; j < 4; ++j) { const int n = (lane >> 3) + 8 * j; const LAS float* s = scr + (8 * c) * 33 + n;
        v4u o; o.x = pk2(s[0 * 33], s[1 * 33]); o.y = pk2(s[2 * 33], s[3 * 33]); o.z = pk2(s[4 * 33], s[5 * 33]); o.w = pk2(s[6 * 33], s[7 * 33]);
        *(v4u*)(WT + (size_t)(drow + n) * K + k0 + 8 * c) = o; }
    LDS_WAIT(); asm volatile("" ::: "memory");
}
template <bool ILV>
__device__ __forceinline__ void transpose_item_f8(const float* W, int K, int N, unsigned char* WT, LAS float* scr, int item, int lane) {
    const int nblk = N / 32, kb = item / nblk, nb = item % nblk, k0 = 64 * kb, n0 = 32 * nb;
    int drow = n0;
    if (ILV) drow = (n0 < DFF) ? (n0 / 128) * 256 + (n0 % 128) : ((n0 - DFF) / 128) * 256 + 128 + ((n0 - DFF) % 128);
#pragma unroll 8
    for (int i = 0; i < 32; ++i) { const int kk = 2 * i + (lane >> 5); scr[kk * 33 + (lane & 31)] = __builtin_nontemporal_load(&W[(size_t)(k0 + kk) * N + n0 + (lane & 31)]); }
    LDS_WAIT(); asm volatile("" ::: "memory");
    const int c = lane & 7;
#pragma unroll
    for (int j = 0; j < 4; ++j) { const int n = (lane >> 3) + 8 * j; const LAS float* s = scr + (8 * c) * 33 + n;
        v2u o; o.x = pg8::pk4_fp8(s[0 * 33] * 64.f, s[1 * 33] * 64.f, s[2 * 33] * 64.f, s[3 * 33] * 64.f); o.y = pg8::pk4_fp8(s[4 * 33] * 64.f, s[5 * 33] * 64.f, s[6 * 33] * 64.f, s[7 * 33] * 64.f);
        *(v2u*)(WT + (size_t)(drow + n) * K + k0 + 8 * c) = o; }
    LDS_WAIT(); asm volatile("" ::: "memory");
}
struct ItemDesc { const float* W; unsigned char* WT; int K, N, k0, n0, drow, f8; };
__device__ __forceinline__ ItemDesc item_desc(const Ctx& C, int it) {
    const float* w_in = C.in[8]; const float* w_out = C.in[9]; const float* ffn_in = C.in[14]; const float* ffn_out = C.in[15]; const float* moe_in = C.in[18]; const float* moe_out = C.in[19];
    constexpr int I_WIN = 16 * (NPROJ / 32), I_WOUT = 16 * 32, I_FIN = 16 * (2 * DFF / 32), I_FOUT = (DFF / 64) * 32;
    ItemDesc d; int r = it, item, ilv = 0; d.f8 = 0;
    if (r < 2 * I_WIN) { const int l = r / I_WIN; d.W = w_in + (size_t)l * D * NPROJ; d.K = D; d.N = NPROJ; d.WT = (unsigned char*)(WSP(bf16, WS_WIN) + (size_t)l * NPROJP * D); item = r % I_WIN; }
    else if ((r -= 2 * I_WIN) < 2 * I_WOUT) { const int l = r / I_WOUT; d.W = w_out + (size_t)l * D * D; d.K = D; d.N = D; d.WT = (unsigned char*)(WSP(bf16, WS_WOUT) + (size_t)l * D * D); item = r % I_WOUT; }
    else if ((r -= 2 * I_WOUT) < I_FIN) { d.W = ffn_in; d.K = D; d.N = 2 * DFF; d.WT = (unsigned char*)WSP(bf16, WS_FIN); item = r; ilv = 1; }
    else if ((r -= I_FIN) < I_FOUT) { d.W = ffn_out; d.K = DFF; d.N = D; d.WT = (unsigned char*)WSP(bf16, WS_FOUT); item = r; }
    else if ((r -= I_FOUT) < NE * I_FIN) { const int e = r / I_FIN; d.W = moe_in + (size_t)e * D * 2 * DFF; d.K = D; d.N = 2 * DFF; d.WT = WSP(unsigned char, WS_MIN) + (size_t)e * 2 * DFF * D; item = r % I_FIN; ilv = 1; d.f8 = 1; }
    else { r -= NE * I_FIN; const int e = r / I_FOUT; d.W = moe_out + (size_t)e * DFF * D; d.K = DFF; d.N = D; d.WT = WSP(unsigned char, WS_MOUT) + (size_t)e * D * DFF; item = r % I_FOUT; d.f8 = 1; }
    const int nblk = d.N / 32, kb = item / nblk, nb = item % nblk; d.k0 = 64 * kb; d.n0 = 32 * nb;
    d.drow = ilv ? ((d.n0 < DFF) ? (d.n0 / 128) * 256 + (d.n0 % 128) : ((d.n0 - DFF) / 128) * 256 + 128 + ((d.n0 - DFF) % 128)) : d.n0;
    return d;
}
__device__ __forceinline__ void item_load(const ItemDesc& d, int lane, float (&v)[32]) {
    const float* p = d.W + (size_t)(d.k0 + (lane >> 5)) * d.N + d.n0 + (lane & 31);
#pragma unroll
    for (int i = 0; i < 32; ++i) v[i] = __builtin_nontemporal_load(p + (size_t)(2 * i) * d.N);
}
__device__ __forceinline__ void item_finish(const ItemDesc& d, int lane, LAS float* scr, const float (&v)[32]) {
#pragma unroll
    for (int i = 0; i < 32; ++i) scr[(2 * i + (lane >> 5)) * 33 + (lane & 31)] = v[i];
    LDS_WAIT(); asm volatile("" ::: "memory");
    const int c = lane & 7;
    if (d.f8) {
#pragma unroll
        for (int j = 0; j < 4; ++j) { const int n = (lane >> 3) + 8 * j; const LAS float* s = scr + (8 * c) * 33 + n;
            v2u o; o.x = pg8::pk4_fp8(s[0 * 33] * 64.f, s[1 * 33] * 64.f, s[2 * 33] * 64.f, s[3 * 33] * 64.f); o.y = pg8::pk4_fp8(s[4 * 33] * 64.f, s[5 * 33] * 64.f, s[6 * 33] * 64.f, s[7 * 33] * 64.f);
            *(v2u*)(d.WT + (size_t)(d.drow + n) * d.K + d.k0 + 8 * c) = o; }
    } else {
#pragma unroll
        for (int j = 0; j < 4; ++j) { const int n = (lane >> 3) + 8 * j; const LAS float* s = scr + (8 * c) * 33 + n;
            v4u o; o.x = pk2(s[0 * 33], s[1 * 33]); o.y = pk2(s[2 * 33], s[3 * 33]); o.z = pk2(s[4 * 33], s[5 * 33]); o.w = pk2(s[6 * 33], s[7 * 33]);
            *(v4u*)((bf16*)d.WT + (size_t)(d.drow + n) * d.K + d.k0 + 8 * c) = o; }
    }
    LDS_WAIT(); asm volatile("" ::: "memory");
}
__device__ __forceinline__ void p_prologue(const Ctx& C) {
    const float* cvec = C.in[1]; const float* cctx = C.in[3]; const float* ada_w = C.in[4]; const float* ada_b = C.in[5];
    for (int task = C.G - 1 - C.bx; task < 48; task += C.G) {
        const int layer = task / 24, cg = task % 24, col = 256 * cg + 4 * C.lane;
        LAS float* stab = (LAS float*)(C.lds + RING_OFF + 49152);
        __syncthreads();
        for (int i = C.tid; i < 5 * D; i += NTHR) { const int r = i >> 10, k = i & 1023; stab[i] = siluf((r < 4) ? cvec[r * D + k] : cctx[k]); }
        __syncthreads();
        f32x4 acc[5];
#pragma unroll
        for (int r = 0; r < 5; ++r) acc[r] = (f32x4){0.f, 0.f, 0.f, 0.f};
#pragma unroll 16
        for (int kk = 0; kk < 128; ++kk) {
            const int k = 128 * C.wave + kk;
            const f32x4 w = __builtin_nontemporal_load((const f32x4*)(ada_w + ((size_t)layer * D + k) * 6144 + col));
#pragma unroll
            for (int r = 0; r < 5; ++r) acc[r] = acc[r] + w * stab[r * D + k];
        }
        __syncthreads();
        LAS float* red = (LAS float*)(C.lds + RING_OFF);
#pragma unroll
        for (int r = 0; r < 5; ++r) *(LAS f32x4*)(red + (C.wave * 5 + r) * 256 + 4 * C.lane) = acc[r];
        __syncthreads();
        for (int o = C.tid; o < 5 * 256; o += NTHR) {
            const int r = o >> 8, cc = o & 255;
            float s = ada_b[layer * 6144 + 256 * cg + cc];
#pragma unroll
            for (int w = 0; w < 8; ++w) s += red[(w * 5 + r) * 256 + cc];
            WSP(float, WS_MOD)[(layer * 5 + r) * 6144 + 256 * cg + cc] = s;
        }
        __syncthreads();
    }
    LAS float* scr = (LAS float*)(C.lds + RING_OFF + C.wave * 16384);
    constexpr int NITEMS = 2 * (16 * (NPROJ / 32)) + 2 * (16 * 32) + 16 * (2 * DFF / 32) + (DFF / 64) * 32 + NE * (16 * (2 * DFF / 32) + (DFF / 64) * 32);
    {
        float va[32], vb[32];
        const int nmod = (C.G > 96) ? 48 : 0, first_mod = C.G - nmod;
        const int vw = (C.bx < first_mod) ? C.gw : ((C.wave < 6) ? first_mod * NWAVES + (C.bx - first_mod) * 6 + C.wave : NITEMS), nvw = first_mod * NWAVES + nmod * 6;
        int it0 = vw;
        if (it0 < NITEMS) {
            ItemDesc d0 = item_desc(C, it0), d1 = d0; item_load(d0, C.lane, va);
            for (;;) {
                const int it1 = it0 + nvw; const bool h1 = it1 < NITEMS;
                if (h1) { d1 = item_desc(C, it1); item_load(d1, C.lane, vb); }
                item_finish(d0, C.lane, scr, va);
                if (!h1) break;
                it0 = it1 + nvw; const bool h0 = it0 < NITEMS;
                if (h0) { d0 = item_desc(C, it0); item_load(d0, C.lane, va); }
                item_finish(d1, C.lane, scr, vb);
                if (!h0) break;
            }
        }
    }
    for (int idx = C.gtid; idx < 1024; idx += C.NT) {
        const int pos = idx >> 4, i = idx & 15;
        const float inv = powf(10000.0f, -(float)i / 16.0f), ang = (float)pos * inv;
        WSP(float, WS_ROPE)[idx] = cosf(ang); WSP(float, WS_ROPE)[1024 + idx] = sinf(ang);
    }
}
template <int NP>
__device__ __forceinline__ void norm_row(const float* hrow, const float* gvec, const float* sh, const float* sc, bf16* orow, int lane, f32x4 (&a)[4], const float* prow = nullptr, float* hout = nullptr) {
    float ss = 0.f;
#pragma unroll
    for (int j = 0; j < 4; ++j) { a[j] = *(const f32x4*)(hrow + 4 * lane + 256 * j);
        if (NP > 0) {
#pragma unroll
            for (int p = 0; p < NP; ++p) a[j] = a[j] + *(const f32x4*)(prow + (size_t)p * 1024 * 1024 + 4 * lane + 256 * j);
            if (hout) *(f32x4*)(hout + 4 * lane + 256 * j) = a[j]; }
        ss += (a[j].x * a[j].x + a[j].y * a[j].y) + (a[j].z * a[j].z + a[j].w * a[j].w); }
    const float rstd = 1.0f / sqrtf(wave_sum(ss) * (1.0f / D) + EPS);
#pragma unroll
    for (int j = 0; j < 4; ++j) {
        const int c = 4 * lane + 256 * j;
        const f32x4 g = *(const f32x4*)(gvec + c), s1 = *(const f32x4*)(sc + c), s0 = *(const f32x4*)(sh + c);
        a[j] = (a[j] * rstd * g) * (s1 + 1.0f) + s0;
        v2u o; o.x = pk2(a[j].x, a[j].y); o.y = pk2(a[j].z, a[j].w);
        *(v2u*)(orow + c) = o;
    }
}
template <bool ROUTER, int NPC>
__device__ __forceinline__ void p_norm(const Ctx& C, int layer, int which, bool do_ctx, bool from_input, bool ctx_from_input, bool ctx_write_h) {
    const float* gvec = (which ? C.in[7] : C.in[6]) + layer * D;
    const float* mod = WSP(float, WS_MOD) + layer * 30720;
    const int o_sh = which ? 3 * D : 0, o_sc = which ? 4 * D : D;
    f32x4 rwr[4][4][2]; float rbr[8];
    if (ROUTER) { const float* rw = C.in[16]; const float* rb = C.in[17];
#pragma unroll
        for (int jj = 0; jj < 4; ++jj)
#pragma unroll
            for (int i = 0; i < 4; ++i) { const int k = 4 * C.lane + 256 * jj + i; rwr[jj][i][0] = *(const f32x4*)(rw + k * 8); rwr[jj][i][1] = *(const f32x4*)(rw + k * 8 + 4); }
#pragma unroll
        for (int e = 0; e < 8; ++e) rbr[e] = rb[e]; }
    LAS int* lcnt = (LAS int*)(C.lds + RING_OFF);
    for (int blk = C.bx; blk < 256; blk += C.G) {
        if (ROUTER) { if (C.tid < 8) lcnt[C.tid] = 0; __syncthreads(); }
        for (int j = 0; j < 8; ++j) {
            const int m = 64 * blk + 8 * C.wave + j, b = m >> 12;
            f32x4 a[4];
            norm_row<0>((from_input ? C.in[0] : WSP(float, WS_H)) + (size_t)m * D, gvec, mod + b * 6144 + o_sh, mod + b * 6144 + o_sc, WSP(bf16, WS_A) + (size_t)m * D, C.lane, a);
            if (ROUTER) {
                float lg[8];
#pragma unroll
                for (int e = 0; e < 8; ++e) lg[e] = 0.f;
#pragma unroll
                for (int jj = 0; jj < 4; ++jj)
#pragma unroll
                    for (int i = 0; i < 4; ++i) {
                        const float av = a[jj][i]; const f32x4 w0 = rwr[jj][i][0], w1 = rwr[jj][i][1];
                        lg[0] += av * w0.x; lg[1] += av * w0.y; lg[2] += av * w0.z; lg[3] += av * w0.w;
                        lg[4] += av * w1.x; lg[5] += av * w1.y; lg[6] += av * w1.z; lg[7] += av * w1.w;
                    }
                float r4[4], r2[2], r1;
#pragma unroll
                for (int e = 0; e < 4; ++e) { const bool hi = (C.lane & 1) != 0; const float keep = hi ? lg[e + 4] : lg[e], send = hi ? lg[e] : lg[e + 4]; r4[e] = keep + __shfl_xor(send, 1); }
#pragma unroll
                for (int e = 0; e < 2; ++e) { const bool hi = (C.lane & 2) != 0; const float keep = hi ? r4[e + 2] : r4[e], send = hi ? r4[e] : r4[e + 2]; r2[e] = keep + __shfl_xor(send, 2); }
                { const bool hi = (C.lane & 4) != 0; const float keep = hi ? r2[1] : r2[0], send = hi ? r2[0] : r2[1]; r1 = keep + __shfl_xor(send, 4); }
                r1 += __shfl_xor(r1, 8); r1 += __shfl_xor(r1, 16); r1 += __shfl_xor(r1, 32);
#pragma unroll
                for (int e = 0; e < 8; ++e) { const int src = ((e >> 2) & 1) | (((e >> 1) & 1) << 1) | ((e & 1) << 2); lg[e] = __shfl(r1, src) + rbr[e]; }
                int e1 = 0; float v1 = lg[0];
#pragma unroll
                for (int e = 1; e < 8; ++e) if (lg[e] > v1) { v1 = lg[e]; e1 = e; }
                int e2 = -1; float v2 = -3.0e38f;
#pragma unroll
                for (int e = 0; e < 8; ++e) if (e != e1 && lg[e] > v2) { v2 = lg[e]; e2 = e; }
                const float ex = __expf(v2 - v1), w1v = 1.0f / (1.0f + ex), w2v = ex * w1v;
                if (C.lane == 0) {
                    WSP(int, WS_TOKE)[m] = e1 | (e2 << 8);
                    WSP(float, WS_TOKW)[2 * m] = w1v; WSP(float, WS_TOKW)[2 * m + 1] = w2v;
                    atomicAdd((int*)(lcnt + e1), 1); atomicAdd((int*)(lcnt + e2), 1);
                }
            }
        }
        if (ROUTER) { __syncthreads(); if (C.tid < 8) WSP(int, WS_CNT)[blk * 8 + C.tid] = lcnt[C.tid]; __syncthreads(); }
    }
    if (do_ctx) {
        for (int cm = C.gw; cm < RCTX; cm += C.NGW) {
            const int m = RLAT + cm; f32x4 a[4];
            norm_row<NPC>(ctx_from_input ? C.in[2] + (size_t)cm * D : WSP(float, WS_H) + (size_t)m * D, gvec, mod + 4 * 6144 + o_sh, mod + 4 * 6144 + o_sc, WSP(bf16, WS_A) + (size_t)m * D, C.lane, a, WSP(float, WS_PART) + (size_t)cm * D, ctx_write_h ? WSP(float, WS_H) + (size_t)m * D : nullptr);
        }
    }
}
typedef short bf16x8 __attribute__((ext_vector_type(8)));
constexpr float LOG2E = 1.4426950408889634f;
constexpr int VTL_STRIDE = 1040, VTC_STRIDE = 528;
constexpr int NA_VTL = 0, NA_VTC = 64 * VTL_STRIDE, NA_RPB = NA_VTC + 64 * VTC_STRIDE, NA_XCH = 102400;
static_assert(NA_RPB + 465 * 4 <= NA_XCH && NA_XCH + 4 * 64 * 18 * 4 <= RING_BYTES, "NA LDS map");
__device__ __forceinline__ unsigned cvtpk(float lo, float hi) { unsigned r; asm volatile("v_cvt_pk_bf16_f32 %0, %1, %2" : "=v"(r) : "v"(lo), "v"(hi)); return r; }

template <bool LOCAL, int NT, int KT0 = 0, int KT1 = NT>
__device__ __forceinline__ void load_kfrags(bf16x8 (&kf)[NT][2], const bf16* Kbase, int krow0, int lane) {
    const int n = lane & 15, g = lane >> 4;
#pragma unroll
    for (int kt = KT0; kt < KT1; ++kt) {
        const int krow = LOCAL ? krow0 + (kt >> 1) * 64 + (kt & 1) * 16 + n : krow0 + 16 * kt + n;
        const bf16x8* kp = (const bf16x8*)(Kbase + (size_t)krow * NPROJP + 8 * g);
        kf[kt][0] = kp[0]; kf[kt][1] = kp[4];
    }
}
template <bool LOCAL, int NT>
__device__ __forceinline__ void attn_wave_core(const bf16x8 (&kfA)[8][2], const bf16* Kbase, int krow0, const bf16x8 (&qf)[2], LAS const unsigned char* vt, int vstride,
                                               LAS const float* rpb, int r, int r0, int qc, int cbase, float& m_out, float& l_out, f32x4 (&o)[4], int lane) {
    const int n = lane & 15, g = lane >> 4;
    f32x4 s[NT];
#pragma unroll
    for (int kt = 0; kt < 8; ++kt) {
        f32x4 acc = {0.f, 0.f, 0.f, 0.f};
        acc = __builtin_amdgcn_mfma_f32_16x16x32_bf16(kfA[kt][0], qf[0], acc, 0, 0, 0);
        acc = __builtin_amdgcn_mfma_f32_16x16x32_bf16(kfA[kt][1], qf[1], acc, 0, 0, 0);
        s[kt] = acc;
    }
    if constexpr (NT > 8) {
        __builtin_amdgcn_sched_barrier(0);
        bf16x8 kfB[NT][2];
        load_kfrags<LOCAL, NT, 8, NT>(kfB, Kbase, krow0, lane);
#pragma unroll
        for (int kt = 8; kt < NT; ++kt) {
            f32x4 acc = {0.f, 0.f, 0.f, 0.f};
            acc = __builtin_amdgcn_mfma_f32_16x16x32_bf16(kfB[kt][0], qf[0], acc, 0, 0, 0);
            acc = __builtin_amdgcn_mfma_f32_16x16x32_bf16(kfB[kt][1], qf[1], acc, 0, 0, 0);
            s[kt] = acc;
        }
        __builtin_amdgcn_sched_barrier(0);
    }
    const float SC = 0.125f * LOG2E;
    const int c0 = min(max(qc - 8, 0), 48);
    float mx = -1.0e30f;
#pragma unroll
    for (int kt = 0; kt < NT; ++kt)
#pragma unroll
        for (int reg = 0; reg < 4; ++reg) {
            float v = s[kt][reg] * SC;
            if (LOCAL) {
                const int i = kt >> 1, kc = cbase + 16 * (kt & 1) + 4 * g + reg;
                const int dr = r0 + i - r + 7, dc = min(max(kc - qc, -15), 15) + 15;
                const float bias = rpb[dr * 31 + dc];
                v = (kc >= c0 && kc < c0 + 16) ? v + bias : -1.0e30f;
            }
            s[kt][reg] = v; mx = fmaxf(mx, v);
        }
    mx = fmaxf(mx, __shfl_xor(mx, 16)); mx = fmaxf(mx, __shfl_xor(mx, 32));
    float l = 0.f;
#pragma unroll
    for (int kt = 0; kt < NT; ++kt)
#pragma unroll
        for (int reg = 0; reg < 4; ++reg) { const float p = __builtin_amdgcn_exp2f(s[kt][reg] - mx); s[kt][reg] = p; l += p; }
    l += __shfl_xor(l, 16); l += __shfl_xor(l, 32);
#pragma unroll
    for (int dt = 0; dt < 4; ++dt) o[dt] = (f32x4){0.f, 0.f, 0.f, 0.f};
#pragma unroll
    for (int u = 0; u < NT / 2; ++u) {
        v4u pw; pw.x = cvtpk(s[2 * u][0], s[2 * u][1]); pw.y = cvtpk(s[2 * u][2], s[2 * u][3]); pw.z = cvtpk(s[2 * u + 1][0], s[2 * u + 1][1]); pw.w = cvtpk(s[2 * u + 1][2], s[2 * u + 1][3]);
        const bf16x8 pb = __builtin_bit_cast(bf16x8, pw);
        const int slotA = LOCAL ? ((r0 + u) & 7) * 64 + cbase + 4 * g : 32 * u + 4 * g, slotB = slotA + 16;
#pragma unroll
        for (int dt = 0; dt < 4; ++dt) {
            LAS const unsigned char* rowp = vt + (16 * dt + n) * vstride;
            const v2u a_lo = *(LAS const v2u*)(rowp + slotA * 2), a_hi = *(LAS const v2u*)(rowp + slotB * 2);
            v4u aw; aw.x = a_lo.x; aw.y = a_lo.y; aw.z = a_hi.x; aw.w = a_hi.y;
            o[dt] = __builtin_amdgcn_mfma_f32_16x16x32_bf16(__builtin_bit_cast(bf16x8, aw), pb, o[dt], 0, 0, 0);
        }
    }
    m_out = mx; l_out = l;
}
__device__ __forceinline__ void attn_wave_mixed(const bf16x8 (&kfA)[8][2], const bf16* Kbase, int kcrow0, const bf16x8 (&qf)[2], LAS const unsigned char* vtl, LAS const unsigned char* vtc,
                                                LAS const float* rpb, int part, int r, int r0, int qc, int cbase, float& m_out, float& l_out, f32x4 (&o)[4], int lane) {
    const int n = lane & 15, g = lane >> 4;
    f32x4 s[16];
#pragma unroll
    for (int kt = 0; kt < 8; ++kt) {
        f32x4 acc = {0.f, 0.f, 0.f, 0.f};
        acc = __builtin_amdgcn_mfma_f32_16x16x32_bf16(kfA[kt][0], qf[0], acc, 0, 0, 0);
        acc = __builtin_amdgcn_mfma_f32_16x16x32_bf16(kfA[kt][1], qf[1], acc, 0, 0, 0);
        s[kt] = acc;
    }
    __builtin_amdgcn_sched_barrier(0);
    {
        bf16x8 kfB[8][2];
        load_kfrags<false, 8>(kfB, Kbase, kcrow0, lane);
#pragma unroll
        for (int kt = 0; kt < 8; ++kt) {
            f32x4 acc = {0.f, 0.f, 0.f, 0.f};
            acc = __builtin_amdgcn_mfma_f32_16x16x32_bf16(kfB[kt][0], qf[0], acc, 0, 0, 0);
            acc = __builtin_amdgcn_mfma_f32_16x16x32_bf16(kfB[kt][1], qf[1], acc, 0, 0, 0);
            s[8 + kt] = acc;
        }
    }
    __builtin_amdgcn_sched_barrier(0);
    const float SC = 0.125f * LOG2E;
    const int c0 = min(max(qc - 8, 0), 48);
    float mx = -1.0e30f;
#pragma unroll
    for (int kt = 0; kt < 16; ++kt)
#pragma unroll
        for (int reg = 0; reg < 4; ++reg) {
            float v = s[kt][reg] * SC;
            if (kt < 8) {
                const int i = 4 * part + (kt >> 1), kc = cbase + 16 * (kt & 1) + 4 * g + reg;
                const int dr = r0 + i - r + 7, dc = min(max(kc - qc, -15), 15) + 15;
                const float bias = rpb[dr * 31 + dc];
                v = (kc >= c0 && kc < c0 + 16) ? v + bias : -1.0e30f;
            }
            s[kt][reg] = v; mx = fmaxf(mx, v);
        }
    mx = fmaxf(mx, __shfl_xor(mx, 16)); mx = fmaxf(mx, __shfl_xor(mx, 32));
    float l = 0.f;
#pragma unroll
    for (int kt = 0; kt < 16; ++kt)
#pragma unroll
        for (int reg = 0; reg < 4; ++reg) { const float p = __builtin_amdgcn_exp2f(s[kt][reg] - mx); s[kt][reg] = p; l += p; }
    l += __shfl_xor(l, 16); l += __shfl_xor(l, 32);
#pragma unroll
    for (int dt = 0; dt < 4; ++dt) o[dt] = (f32x4){0.f, 0.f, 0.f, 0.f};
#pragma unroll
    for (int u = 0; u < 8; ++u) {
        v4u pw; pw.x = cvtpk(s[2 * u][0], s[2 * u][1]); pw.y = cvtpk(s[2 * u][2], s[2 * u][3]); pw.z = cvtpk(s[2 * u + 1][0], s[2 * u + 1][1]); pw.w = cvtpk(s[2 * u + 1][2], s[2 * u + 1][3]);
        const bf16x8 pb = __builtin_bit_cast(bf16x8, pw);
        const bool loc = (u < 4);
        const int slotA = loc ? ((r0 + 4 * part + u) & 7) * 64 + cbase + 4 * g : 128 * part + 32 * (u - 4) + 4 * g, slotB = slotA + 16;
        LAS const unsigned char* vt = loc ? vtl : vtc; const int vstride = loc ? VTL_STRIDE : VTC_STRIDE;
#pragma unroll
        for (int dt = 0; dt < 4; ++dt) {
            LAS const unsigned char* rowp = vt + (16 * dt + n) * vstride;
            const v2u a_lo = *(LAS const v2u*)(rowp + slotA * 2), a_hi = *(LAS const v2u*)(rowp + slotB * 2);
            v4u aw; aw.x = a_lo.x; aw.y = a_lo.y; aw.z = a_hi.x; aw.w = a_hi.y;
            o[dt] = __builtin_amdgcn_mfma_f32_16x16x32_bf16(__builtin_bit_cast(bf16x8, aw), pb, o[dt], 0, 0, 0);
        }
    }
    m_out = mx; l_out = l;
}
template <int NCH>
__device__ __forceinline__ void vt_scatter(const bf16* vrow, int ch0, LAS unsigned char* vt, int vstride, int slot) {
    v4u x[NCH];
#pragma unroll
    for (int c = 0; c < NCH; ++c) x[c] = *(const v4u*)(vrow + 8 * (ch0 + c));
#pragma unroll
    for (int c = 0; c < NCH; ++c) {
        LAS unsigned char* p = vt + (8 * (ch0 + c)) * vstride + slot * 2;
        *(LAS unsigned short*)(p) = (unsigned short)(x[c].x & 0xffffu); *(LAS unsigned short*)(p + vstride) = (unsigned short)(x[c].x >> 16);
        *(LAS unsigned short*)(p + 2 * vstride) = (unsigned short)(x[c].y & 0xffffu); *(LAS unsigned short*)(p + 3 * vstride) = (unsigned short)(x[c].y >> 16);
        *(LAS unsigned short*)(p + 4 * vstride) = (unsigned short)(x[c].z & 0xffffu); *(LAS unsigned short*)(p + 5 * vstride) = (unsigned short)(x[c].z >> 16);
        *(LAS unsigned short*)(p + 6 * vstride) = (unsigned short)(x[c].w & 0xffffu); *(LAS unsigned short*)(p + 7 * vstride) = (unsigned short)(x[c].w >> 16);
    }
}
__device__ __forceinline__ void attn_merge_store(const Ctx& C, int part, int qb, float m, float l, f32x4 (&o)[4], int qrow0, int h) {
    LAS float* xch = (LAS float*)(C.lds + RING_OFF + NA_XCH) + (qb * 64 + C.lane) * 18;
    if (part == 1) {
        xch[0] = m; xch[1] = l;
#pragma unroll
        for (int dt = 0; dt < 4; ++dt) *(LAS f32x4*)(xch + 2 + 4 * dt) = o[dt];
    }
    __syncthreads();
    if (part == 0) {
        const float m2 = xch[0], l2 = xch[1];
        const float mt = fmaxf(m, m2), f1 = __builtin_amdgcn_exp2f(m - mt), f2 = __builtin_amdgcn_exp2f(m2 - mt);
        const float inv = 1.0f / (l * f1 + l2 * f2);
        const int n = C.lane & 15, g = C.lane >> 4;
        bf16* yp = WSP(bf16, WS_YMIX) + (size_t)(qrow0 + n) * D + 640 + 64 * h + 4 * g;
#pragma unroll
        for (int dt = 0; dt < 4; ++dt) {
            const f32x4 o2 = *(LAS f32x4*)(xch + 2 + 4 * dt);
            const f32x4 v = (o[dt] * f1 + o2 * f2) * inv;
            v2u w; w.x = cvtpk(v[0], v[1]); w.y = cvtpk(v[2], v[3]);
            *(v2u*)(yp + 16 * dt) = w;
        }
    }
}
__device__ __forceinline__ void na_band(const Ctx& C, int layer, int u0, int nu) {
    const bf16* PROJ = WSP(bf16, WS_PROJ);
    LAS unsigned char* vtl = C.lds + RING_OFF + NA_VTL; LAS unsigned char* vtc = C.lds + RING_OFF + NA_VTC; LAS float* rpb = (LAS float*)(C.lds + RING_OFF + NA_RPB);
    const int qb = C.wave & 3, part = C.wave >> 2, n = C.lane & 15, g = C.lane >> 4;
    const int cbase = (qb == 0) ? 0 : (qb == 1) ? 8 : (qb == 2) ? 24 : 32;
    int cur_bh = -1, have_hi = 0;
    for (int uu = 0; uu < nu; ++uu) {
        const int u = u0 + uu, bh = u >> 6, r = u & 63, b = bh / 6, h = bh % 6;
        const int r0 = min(max(r - 4, 0), 56);
        const int qrow0 = b * SEQ + r * 64 + 16 * qb;
        bf16x8 qf[2];
        { const bf16x8* qp = (const bf16x8*)(PROJ + (size_t)(qrow0 + n) * NPROJP + C_NQ + 64 * h + 8 * g); qf[0] = qp[0]; qf[1] = qp[4]; }
        bf16x8 kf[8][2];
        load_kfrags<true, 8, 0, 8>(kf, PROJ + C_NK + 64 * h, b * SEQ + (r0 + 4 * part) * 64 + cbase, C.lane);
        const bool newbh = (bh != cur_bh);
        const int lo = newbh ? r0 : max(r0, have_hi);
        const int vkey = C.tid & 63, vch = C.tid >> 6;
        v4u vpre = {0u, 0u, 0u, 0u};
        if (lo < r0 + 8) vpre = *(const v4u*)(PROJ + (size_t)(b * SEQ + (r0 + 7) * 64 + vkey) * NPROJP + C_NV + 64 * h + 8 * vch);
        __syncthreads();
        if (newbh) {
            vt_scatter<4>(PROJ + (size_t)(RLAT + b * CTXL + (C.tid & 255)) * NPROJP + C_NV + 64 * h, 4 * (C.tid >> 8), vtc, VTC_STRIDE, C.tid & 255);
            const float* rp = C.in[13] + (size_t)(layer * 6 + h) * 465; for (int i = C.tid; i < 465; i += NTHR) rpb[i] = rp[i] * LOG2E;
        }
        for (int row = lo; row < r0 + 8; ++row) {
            v4u x = vpre;
            if (row != r0 + 7) x = *(const v4u*)(PROJ + (size_t)(b * SEQ + row * 64 + vkey) * NPROJP + C_NV + 64 * h + 8 * vch);
            LAS unsigned char* p = vtl + (8 * vch) * VTL_STRIDE + ((row & 7) * 64 + vkey) * 2;
            *(LAS unsigned short*)(p) = (unsigned short)(x.x & 0xffffu); *(LAS unsigned short*)(p + VTL_STRIDE) = (unsigned short)(x.x >> 16);
            *(LAS unsigned short*)(p + 2 * VTL_STRIDE) = (unsigned short)(x.y & 0xffffu); *(LAS unsigned short*)(p + 3 * VTL_STRIDE) = (unsigned short)(x.y >> 16);
            *(LAS unsigned short*)(p + 4 * VTL_STRIDE) = (unsigned short)(x.z & 0xffffu); *(LAS unsigned short*)(p + 5 * VTL_STRIDE) = (unsigned short)(x.z >> 16);
            *(LAS unsigned short*)(p + 6 * VTL_STRIDE) = (unsigned short)(x.w & 0xffffu); *(LAS unsigned short*)(p + 7 * VTL_STRIDE) = (unsigned short)(x.w >> 16);
        }
        cur_bh = bh; have_hi = r0 + 8;
        __syncthreads();
        float m, l; f32x4 o[4];
        attn_wave_mixed(kf, PROJ + C_NK + 64 * h, RLAT + b * CTXL + 128 * part, qf, vtl, vtc, rpb, part, r, r0, 16 * qb + n, cbase, m, l, o, C.lane);
        attn_merge_store(C, part, qb, m, l, o, qrow0, h);
    }
}
constexpr int VT2_ROWS = 10, VT2_STRIDE = VT2_ROWS * 64 * 2 + 16;
constexpr int NA2_VTL = 0, NA2_VTC = 64 * VT2_STRIDE, NA2_RPB = NA2_VTC + 64 * VTC_STRIDE;
static_assert(NA2_RPB + (480 + 465) * 4 <= RING_BYTES && (VT2_STRIDE / 4) % 64 == 4, "NA2 LDS map");
template <bool LOCAL>
__device__ __forceinline__ void na2_scores(f32x4 (&s)[16], const bf16x8 (&kfA)[8][2], const bf16* Kbase, int krow0, const bf16x8 (&qf)[2], int lane) {
#pragma unroll
    for (int kt = 0; kt < 8; ++kt) { f32x4 acc = {0.f, 0.f, 0.f, 0.f};
        acc = __builtin_amdgcn_mfma_f32_16x16x32_bf16(kfA[kt][0], qf[0], acc, 0, 0, 0); acc = __builtin_amdgcn_mfma_f32_16x16x32_bf16(kfA[kt][1], qf[1], acc, 0, 0, 0); s[kt] = acc; }
    __builtin_amdgcn_sched_barrier(0);
    bf16x8 kfB[16][2];
    load_kfrags<LOCAL, 16, 8, 16>(kfB, Kbase, krow0, lane);
#pragma unroll
    for (int kt = 8; kt < 16; ++kt) { f32x4 acc = {0.f, 0.f, 0.f, 0.f};
        acc = __builtin_amdgcn_mfma_f32_16x16x32_bf16(kfB[kt][0], qf[0], acc, 0, 0, 0); acc = __builtin_amdgcn_mfma_f32_16x16x32_bf16(kfB[kt][1], qf[1], acc, 0, 0, 0); s[kt] = acc; }
    __builtin_amdgcn_sched_barrier(0);
}
__device__ __forceinline__ void na_band2(const Ctx& C, int layer, int u0, int nu) {
    const bf16* PROJ = WSP(bf16, WS_PROJ);
    LAS unsigned char* vtl = C.lds + RING_OFF + NA2_VTL; LAS unsigned char* vtc = C.lds + RING_OFF + NA2_VTC; LAS float* rpb = (LAS float*)(C.lds + RING_OFF + NA2_RPB);
    const int qb = C.wave & 3, grp = C.wave >> 2, n = C.lane & 15, g = C.lane >> 4;
    const int cbase = (qb == 0) ? 0 : (qb == 1) ? 8 : (qb == 2) ? 24 : 32;
    const float SC = 0.125f * LOG2E;
    int boff[2][4]; float bscl[2][4];
    { const int qc = 16 * qb + n, c0 = min(max(qc - 8, 0), 48);
#pragma unroll
      for (int hh = 0; hh < 2; ++hh)
#pragma unroll
        for (int reg = 0; reg < 4; ++reg) { const int kcol = cbase + 16 * hh + 4 * g + reg; const bool ok = (kcol >= c0) && (kcol < c0 + 16);
            boff[hh][reg] = ok ? (min(max(kcol - qc, -15), 15) + 15) * 4 : 480 * 4; bscl[hh][reg] = ok ? SC : 0.f; } }
    int cur_bh = -1, have_hi = 0;
    for (int uu = 0; uu < nu; uu += 2) {
        const int ua = u0 + uu, bh = ua >> 6, ra = ua & 63, b = bh / 6, h = bh % 6;
        const int r0a = min(max(ra - 4, 0), 56), r0b = min(max(ra + 1 - 4, 0), 56);
        const int r = ra + grp, r0 = grp ? r0b : r0a;
        const int qrow0 = b * SEQ + r * 64 + 16 * qb;
        const bool newbh = (bh != cur_bh);
        const int lo = newbh ? r0a : max(r0a, have_hi), hi = r0b + 8;
        const int vkey = C.tid & 63, vch = C.tid >> 6;
        const v4u vpa = *(const v4u*)(PROJ + (size_t)(b * SEQ + (hi - 2) * 64 + vkey) * NPROJP + C_NV + 64 * h + 8 * vch);
        const v4u vpb = *(const v4u*)(PROJ + (size_t)(b * SEQ + (hi - 1) * 64 + vkey) * NPROJP + C_NV + 64 * h + 8 * vch);
        bf16x8 qf[2];
        { const bf16x8* qp = (const bf16x8*)(PROJ + (size_t)(qrow0 + n) * NPROJP + C_NQ + 64 * h + 8 * g); qf[0] = qp[0]; qf[1] = qp[4]; }
        bf16x8 kf[8][2];
        load_kfrags<true, 8, 0, 8>(kf, PROJ + C_NK + 64 * h, b * SEQ + r0 * 64 + cbase, C.lane);
        __syncthreads();
        if (newbh) {
            vt_scatter<4>(PROJ + (size_t)(RLAT + b * CTXL + (C.tid & 255)) * NPROJP + C_NV + 64 * h, 4 * (C.tid >> 8), vtc, VTC_STRIDE, C.tid & 255);
            const float* rp = C.in[13] + (size_t)(layer * 6 + h) * 465; for (int i = C.tid; i < 465; i += NTHR) rpb[i] = rp[i] * LOG2E;
            for (int i = C.tid; i < 15 * 31; i += NTHR) rpb[480 + i] = -1.0e30f;
        }
        for (int row = lo; row < hi; ++row) {
            v4u x;
            if (row == hi - 2) x = vpa; else if (row == hi - 1) x = vpb; else x = *(const v4u*)(PROJ + (size_t)(b * SEQ + row * 64 + vkey) * NPROJP + C_NV + 64 * h + 8 * vch);
            LAS unsigned char* p = vtl + (8 * vch) * VT2_STRIDE + ((row % VT2_ROWS) * 64 + vkey) * 2;
            *(LAS unsigned short*)(p) = (unsigned short)(x.x & 0xffffu); *(LAS unsigned short*)(p + VT2_STRIDE) = (unsigned short)(x.x >> 16);
            *(LAS unsigned short*)(p + 2 * VT2_STRIDE) = (unsigned short)(x.y & 0xffffu); *(LAS unsigned short*)(p + 3 * VT2_STRIDE) = (unsigned short)(x.y >> 16);
            *(LAS unsigned short*)(p + 4 * VT2_STRIDE) = (unsigned short)(x.z & 0xffffu); *(LAS unsigned short*)(p + 5 * VT2_STRIDE) = (unsigned short)(x.z >> 16);
            *(LAS unsigned short*)(p + 6 * VT2_STRIDE) = (unsigned short)(x.w & 0xffffu); *(LAS unsigned short*)(p + 7 * VT2_STRIDE) = (unsigned short)(x.w >> 16);
        }
        cur_bh = bh; have_hi = hi;
        __syncthreads();
        f32x4 s[16];
        na2_scores<true>(s, kf, PROJ + C_NK + 64 * h, b * SEQ + r0 * 64 + cbase, qf, C.lane);
        bf16x8 kc[8][2];
        load_kfrags<false, 8, 0, 8>(kc, PROJ + C_NK + 64 * h, RLAT + b * CTXL, C.lane);
        float mx = -1.0e30f;
        { LAS const unsigned char* rb = (LAS const unsigned char*)rpb + (r0 - r + 7) * 124;
#pragma unroll
          for (int kt = 0; kt < 16; ++kt)
#pragma unroll
            for (int reg = 0; reg < 4; ++reg) {
                const float bias = *(LAS const float*)(rb + boff[kt & 1][reg] + (kt >> 1) * 124);
                const float v = s[kt][reg] * bscl[kt & 1][reg] + bias;
                s[kt][reg] = v; mx = fmaxf(mx, v);
            } }
        mx = fmaxf(mx, __shfl_xor(mx, 16)); mx = fmaxf(mx, __shfl_xor(mx, 32));
        float l = 0.f;
#pragma unroll
        for (int kt = 0; kt < 16; ++kt)
#pragma unroll
            for (int reg = 0; reg < 4; ++reg) { const float p = __builtin_amdgcn_exp2f(s[kt][reg] - mx); s[kt][reg] = p; l += p; }
        f32x4 o[4];
#pragma unroll
        for (int dt = 0; dt < 4; ++dt) o[dt] = (f32x4){0.f, 0.f, 0.f, 0.f};
#pragma unroll
        for (int u = 0; u < 8; ++u) {
            v4u pw; pw.x = cvtpk(s[2 * u][0], s[2 * u][1]); pw.y = cvtpk(s[2 * u][2], s[2 * u][3]); pw.z = cvtpk(s[2 * u + 1][0], s[2 * u + 1][1]); pw.w = cvtpk(s[2 * u + 1][2], s[2 * u + 1][3]);
            const bf16x8 pb = __builtin_bit_cast(bf16x8, pw);
            const int slotA = ((r0 + u) % VT2_ROWS) * 64 + cbase + 4 * g, slotB = slotA + 16;
#pragma unroll
            for (int dt = 0; dt < 4; ++dt) {
                LAS const unsigned char* rowp = vtl + (16 * dt + n) * VT2_STRIDE;
                const v2u a_lo = *(LAS const v2u*)(rowp + slotA * 2), a_hi = *(LAS const v2u*)(rowp + slotB * 2);
                v4u aw; aw.x = a_lo.x; aw.y = a_lo.y; aw.z = a_hi.x; aw.w = a_hi.y;
                o[dt] = __builtin_amdgcn_mfma_f32_16x16x32_bf16(__builtin_bit_cast(bf16x8, aw), pb, o[dt], 0, 0, 0);
            }
        }
        na2_scores<false>(s, kc, PROJ + C_NK + 64 * h, RLAT + b * CTXL, qf, C.lane);
        float mx2 = -1.0e30f;
#pragma unroll
        for (int kt = 0; kt < 16; ++kt)
#pragma unroll
            for (int reg = 0; reg < 4; ++reg) { const float v = s[kt][reg] * SC; s[kt][reg] = v; mx2 = fmaxf(mx2, v); }
        mx2 = fmaxf(mx2, __shfl_xor(mx2, 16)); mx2 = fmaxf(mx2, __shfl_xor(mx2, 32));
        const float mt = fmaxf(mx, mx2), f1 = __builtin_amdgcn_exp2f(mx - mt);
        l *= f1;
#pragma unroll
        for (int dt = 0; dt < 4; ++dt) o[dt] = o[dt] * f1;
#pragma unroll
        for (int kt = 0; kt < 16; ++kt)
#pragma unroll
            for (int reg = 0; reg < 4; ++reg) { const float p = __builtin_amdgcn_exp2f(s[kt][reg] - mt); s[kt][reg] = p; l += p; }
        l += __shfl_xor(l, 16); l += __shfl_xor(l, 32);
#pragma unroll
        for (int u = 0; u < 8; ++u) {
            v4u pw; pw.x = cvtpk(s[2 * u][0], s[2 * u][1]); pw.y = cvtpk(s[2 * u][2], s[2 * u][3]); pw.z = cvtpk(s[2 * u + 1][0], s[2 * u + 1][1]); pw.w = cvtpk(s[2 * u + 1][2], s[2 * u + 1][3]);
            const bf16x8 pb = __builtin_bit_cast(bf16x8, pw);
            const int slotA = 32 * u + 4 * g, slotB = slotA + 16;
#pragma unroll
            for (int dt = 0; dt < 4; ++dt) {
                LAS const unsigned char* rowp = vtc + (16 * dt + n) * VTC_STRIDE;
                const v2u a_lo = *(LAS const v2u*)(rowp + slotA * 2), a_hi = *(LAS const v2u*)(rowp + slotB * 2);
                v4u aw; aw.x = a_lo.x; aw.y = a_lo.y; aw.z = a_hi.x; aw.w = a_hi.y;
                o[dt] = __builtin_amdgcn_mfma_f32_16x16x32_bf16(__builtin_bit_cast(bf16x8, aw), pb, o[dt], 0, 0, 0);
            }
        }
        const float inv = 1.0f / l;
        bf16* yp = WSP(bf16, WS_YMIX) + (size_t)(qrow0 + n) * D + 640 + 64 * h + 4 * g;
#pragma unroll
        for (int dt = 0; dt < 4; ++dt) { const f32x4 v = o[dt] * inv; v2u w; w.x = cvtpk(v[0], v[1]); w.y = cvtpk(v[2], v[3]); *(v2u*)(yp + 16 * dt) = w; }
    }
    __syncthreads();
}
__device__ __forceinline__ void ctxattn_unit(const Ctx& C, int b, int h, int qblk) {
    const bf16* PROJ = WSP(bf16, WS_PROJ);
    LAS unsigned char* vtc = C.lds + RING_OFF + NA_VTC; LAS float* rpb = (LAS float*)(C.lds + RING_OFF + NA_RPB);
    __syncthreads();
    vt_scatter<4>(PROJ + (size_t)(RLAT + b * CTXL + (C.tid & 255)) * NPROJP + C_NV + 64 * h, 4 * (C.tid >> 8), vtc, VTC_STRIDE, C.tid & 255);
    __syncthreads();
    const int qb = C.wave & 3, part = C.wave >> 2, n = C.lane & 15, g = C.lane >> 4;
    const int qrow0 = RLAT + b * CTXL + 64 * qblk + 16 * qb;
    bf16x8 qf[2];
    { const bf16x8* qp = (const bf16x8*)(PROJ + (size_t)(qrow0 + n) * NPROJP + C_NQ + 64 * h + 8 * g); qf[0] = qp[0]; qf[1] = qp[4]; }
    float m, l; f32x4 o[4];
    bf16x8 kf[8][2];
    load_kfrags<false, 8>(kf, PROJ + C_NK + 64 * h, RLAT + b * CTXL + 128 * part, C.lane);
    attn_wave_core<false, 8>(kf, PROJ + C_NK + 64 * h, RLAT + b * CTXL + 128 * part, qf, vtc + 256 * part, VTC_STRIDE, rpb, 0, 0, 0, 0, m, l, o, C.lane);
    attn_merge_store(C, part, qb, m, l, o, qrow0, h);
}

constexpr size_t WS_UT = WS_OBUF;
constexpr size_t WS_SB = WS_OBUF + 26 * MiB;
constexpr int RT_STRIDE = 272;
__device__ __forceinline__ float logsig(float x) { return -log1pf(expf(-x)); }
__device__ __forceinline__ int ret_row0(int b, int c) { return (c < 2) ? RLAT + b * CTXL + 128 * c : b * SEQ + 128 * (c - 2); }

__device__ __forceinline__ void ret_a_unit(const Ctx& C, int layer, int b, int h, int c) {
    const bf16* PROJ = WSP(bf16, WS_PROJ);
    LAS unsigned char* kt = C.lds + RING_OFF; LAS unsigned char* vft = kt + 64 * RT_STRIDE; LAS unsigned char* vbt = vft + 64 * RT_STRIDE;
    const float lgf = logsig(C.in[10][(layer * 2 + 0) * 6 + h]), lgb = logsig(C.in[10][(layer * 2 + 1) * 6 + h]);
    const int row0 = ret_row0(b, c);
    __syncthreads();
    {
        const int j = C.tid & 127, q4 = C.tid >> 7;
        const bf16* pr = PROJ + (size_t)(row0 + j) * NPROJP + 64 * h + 16 * q4;
        const v4u k0 = *(const v4u*)(pr + C_RK), k1 = *(const v4u*)(pr + C_RK + 8), v0 = *(const v4u*)(pr + C_RV), v1 = *(const v4u*)(pr + C_RV + 8);
        const float wf = expf(lgf * (float)(127 - j)), wb = expf(lgb * (float)j);
        const unsigned kw[8] = {k0.x, k0.y, k0.z, k0.w, k1.x, k1.y, k1.z, k1.w}, vw[8] = {v0.x, v0.y, v0.z, v0.w, v1.x, v1.y, v1.z, v1.w};
#pragma unroll
        for (int i = 0; i < 8; ++i) {
            const int d = 16 * q4 + 2 * i;
            *(LAS unsigned short*)(kt + d * RT_STRIDE + 2 * j) = (unsigned short)(kw[i] & 0xffffu); *(LAS unsigned short*)(kt + (d + 1) * RT_STRIDE + 2 * j) = (unsigned short)(kw[i] >> 16);
            const float a = bflo(vw[i]), bb = bfhi(vw[i]);
            *(LAS unsigned short*)(vft + d * RT_STRIDE + 2 * j) = (unsigned short)f2bf(a * wf); *(LAS unsigned short*)(vft + (d + 1) * RT_STRIDE + 2 * j) = (unsigned short)f2bf(bb * wf);
            *(LAS unsigned short*)(vbt + d * RT_STRIDE + 2 * j) = (unsigned short)f2bf(a * wb); *(LAS unsigned short*)(vbt + (d + 1) * RT_STRIDE + 2 * j) = (unsigned short)f2bf(bb * wb);
        }
    }
    __syncthreads();
    const int dir = C.wave >> 2, dt = C.wave & 3, n = C.lane & 15, g = C.lane >> 4;
    LAS const unsigned char* vt = dir ? vbt : vft;
    f32x4 acc[4];
#pragma unroll
    for (int et = 0; et < 4; ++et) acc[et] = (f32x4){0.f, 0.f, 0.f, 0.f};
#pragma unroll
    for (int s = 0; s < 4; ++s) {
        const bf16x8 a = *(LAS const bf16x8*)(kt + (16 * dt + n) * RT_STRIDE + (32 * s + 8 * g) * 2);
#pragma unroll
        for (int et = 0; et < 4; ++et) {
            const bf16x8 bf = *(LAS const bf16x8*)(vt + (16 * et + n) * RT_STRIDE + (32 * s + 8 * g) * 2);
            acc[et] = __builtin_amdgcn_mfma_f32_16x16x32_bf16(a, bf, acc[et], 0, 0, 0);
        }
    }
    float* U = WSP(float, WS_UT) + ((size_t)((dir * 24 + b * 6 + h) * 34 + c)) * 4096;
#pragma unroll
    for (int et = 0; et < 4; ++et) *(f32x4*)(U + (16 * et + n) * 64 + 16 * dt + 4 * g) = acc[et];
}
typedef float f32x2v __attribute__((ext_vector_type(2)));
__device__ __forceinline__ void ret_scan(const Ctx& C, int layer) {
    for (int task = C.gtid; task < 48 * 2048; task += C.NT) {
        const int dir = task / (24 * 2048), rem = task % (24 * 2048), bh = rem >> 11, p = rem & 2047, h = bh % 6;
        const float dec = expf(128.0f * logsig(C.in[10][(layer * 2 + dir) * 6 + h]));
        const float* __restrict__ U = WSP(float, WS_UT) + ((size_t)(dir * 24 + bh) * 34) * 4096 + 2 * p;
        bf16* __restrict__ SB = WSP(bf16, WS_SB) + ((size_t)(dir * 24 + bh) * 34) * 4096 + 2 * p;
        f32x2v u[34];
#pragma unroll
        for (int k = 0; k < 34; ++k) { const int c = dir ? ((k < 2) ? 1 - k : 35 - k) : k; u[k] = *(const f32x2v*)(U + (size_t)c * 4096); }
        float s0 = 0.f, s1 = 0.f;
#pragma unroll
        for (int k = 0; k < 34; ++k) {
            const int c = dir ? ((k < 2) ? 1 - k : 35 - k) : k;
            *(unsigned*)(SB + (size_t)c * 4096) = pk2(s0, s1);
            s0 = dec * s0 + u[k].x; s1 = dec * s1 + u[k].y;
        }
    }
}
constexpr int RC_KS = 144;
constexpr int RC_VT = 0, RC_K = 64 * RT_STRIDE, RC_SB = RC_K + 128 * RC_KS, RC_TAB = RC_SB + 2 * 64 * RC_KS;
static_assert(RC_TAB + 1024 <= RING_BYTES, "retC LDS map");
__device__ __forceinline__ void ret_c_unit(const Ctx& C, int layer, int b, int h, int c) {
    const bf16* PROJ = WSP(bf16, WS_PROJ);
    LAS unsigned char* vt = C.lds + RING_OFF + RC_VT; LAS unsigned char* kim = C.lds + RING_OFF + RC_K; LAS unsigned char* sim = C.lds + RING_OFF + RC_SB;
    LAS float* tabf = (LAS float*)(C.lds + RING_OFF + RC_TAB);
    const float lgf = logsig(C.in[10][(layer * 2 + 0) * 6 + h]), lgb = logsig(C.in[10][(layer * 2 + 1) * 6 + h]);
    const int row0 = ret_row0(b, c);
    const int n = C.lane & 15, g = C.lane >> 4, i = 16 * C.wave + n, rowi = row0 + i;
    bf16x8 qf[2];
    { const bf16x8* qp = (const bf16x8*)(PROJ + (size_t)rowi * NPROJP + C_RQ + 64 * h + 8 * g); qf[0] = qp[0]; qf[1] = qp[4]; }
    v2u gw[4];
    { const bf16* gp = PROJ + (size_t)rowi * NPROJP + C_RG + 64 * h + 4 * g;
#pragma unroll
      for (int et = 0; et < 4; ++et) gw[et] = *(const v2u*)(gp + 16 * et); }
    const int vj = C.tid & 127, vq4 = C.tid >> 7;
    const bf16* vpr = PROJ + (size_t)(row0 + vj) * NPROJP + 64 * h + 16 * vq4;
    const v4u v0 = *(const v4u*)(vpr + C_RV), v1 = *(const v4u*)(vpr + C_RV + 8);
    const v4u k0 = *(const v4u*)(vpr + C_RK), k1 = *(const v4u*)(vpr + C_RK + 8);
    const int se = C.tid & 63, sq = (C.tid >> 6) & 3, sd = C.tid >> 8;
    const bf16* spr = WSP(bf16, WS_SB) + ((size_t)((sd * 24 + b * 6 + h) * 34 + c)) * 4096 + se * 64 + 16 * sq;
    const v4u s0 = *(const v4u*)(spr), s1 = *(const v4u*)(spr + 8);
    __syncthreads();
    {
        const unsigned vw[8] = {v0.x, v0.y, v0.z, v0.w, v1.x, v1.y, v1.z, v1.w};
#pragma unroll
        for (int ii = 0; ii < 8; ++ii) { const int dd = 16 * vq4 + 2 * ii;
            *(LAS unsigned short*)(vt + dd * RT_STRIDE + 2 * vj) = (unsigned short)(vw[ii] & 0xffffu); *(LAS unsigned short*)(vt + (dd + 1) * RT_STRIDE + 2 * vj) = (unsigned short)(vw[ii] >> 16); }
        *(LAS v4u*)(kim + vj * RC_KS + 32 * vq4) = k0; *(LAS v4u*)(kim + vj * RC_KS + 32 * vq4 + 16) = k1;
        *(LAS v4u*)(sim + (sd * 64 + se) * RC_KS + 32 * sq) = s0; *(LAS v4u*)(sim + (sd * 64 + se) * RC_KS + 32 * sq + 16) = s1;
        if (C.tid < 255) { const int dl = C.tid - 127; tabf[C.tid] = (dl > 0) ? expf(lgf * (float)dl) : ((dl < 0) ? expf(lgb * (float)(-dl)) : 2.0f); }
    }
    __syncthreads();
    f32x4 st[8];
#pragma unroll
    for (int jt = 0; jt < 8; ++jt) {
        LAS const unsigned char* kp = kim + (16 * jt + n) * RC_KS + 16 * g;
        const bf16x8 ka = *(LAS const bf16x8*)(kp), kb = *(LAS const bf16x8*)(kp + 64);
        f32x4 acc = {0.f, 0.f, 0.f, 0.f};
        acc = __builtin_amdgcn_mfma_f32_16x16x32_bf16(ka, qf[0], acc, 0, 0, 0);
        acc = __builtin_amdgcn_mfma_f32_16x16x32_bf16(kb, qf[1], acc, 0, 0, 0);
        st[jt] = acc;
    }
#pragma unroll
    for (int jt = 0; jt < 8; ++jt)
#pragma unroll
        for (int reg = 0; reg < 4; ++reg) {
            const int j = 16 * jt + 4 * g + reg;
            st[jt][reg] *= tabf[127 + i - j];
        }
    f32x4 o[4];
#pragma unroll
    for (int et = 0; et < 4; ++et) o[et] = (f32x4){0.f, 0.f, 0.f, 0.f};
#pragma unroll
    for (int u = 0; u < 4; ++u) {
        v4u pw; pw.x = cvtpk(st[2 * u][0], st[2 * u][1]); pw.y = cvtpk(st[2 * u][2], st[2 * u][3]); pw.z = cvtpk(st[2 * u + 1][0], st[2 * u + 1][1]); pw.w = cvtpk(st[2 * u + 1][2], st[2 * u + 1][3]);
        const bf16x8 pb = __builtin_bit_cast(bf16x8, pw);
        const int slotA = 32 * u + 4 * g, slotB = slotA + 16;
#pragma unroll
        for (int et = 0; et < 4; ++et) {
            LAS const unsigned char* rowp = vt + (16 * et + n) * RT_STRIDE;
            const v2u a_lo = *(LAS const v2u*)(rowp + slotA * 2), a_hi = *(LAS const v2u*)(rowp + slotB * 2);
            v4u aw; aw.x = a_lo.x; aw.y = a_lo.y; aw.z = a_hi.x; aw.w = a_hi.y;
            o[et] = __builtin_amdgcn_mfma_f32_16x16x32_bf16(__builtin_bit_cast(bf16x8, aw), pb, o[et], 0, 0, 0);
        }
    }
#pragma unroll
    for (int dir = 0; dir < 2; ++dir) {
        const float scl = dir ? expf(lgb * (float)(128 - i)) : expf(lgf * (float)(i + 1));
#pragma unroll
        for (int et = 0; et < 4; ++et) {
            LAS const unsigned char* sp = sim + (dir * 64 + 16 * et + n) * RC_KS + 16 * g;
            const bf16x8 a0 = *(LAS const bf16x8*)(sp), a1 = *(LAS const bf16x8*)(sp + 64);
            f32x4 t = {0.f, 0.f, 0.f, 0.f};
            t = __builtin_amdgcn_mfma_f32_16x16x32_bf16(a0, qf[0], t, 0, 0, 0);
            t = __builtin_amdgcn_mfma_f32_16x16x32_bf16(a1, qf[1], t, 0, 0, 0);
            o[et] = o[et] + t * scl;
        }
    }
    float sm = 0.f;
#pragma unroll
    for (int et = 0; et < 4; ++et) sm += (o[et][0] + o[et][1]) + (o[et][2] + o[et][3]);
    sm += __shfl_xor(sm, 16); sm += __shfl_xor(sm, 32);
    const float mu = sm * (1.f / 64.f);
    float sq2 = 0.f;
#pragma unroll
    for (int et = 0; et < 4; ++et) { o[et] = o[et] - mu; sq2 += (o[et][0] * o[et][0] + o[et][1] * o[et][1]) + (o[et][2] * o[et][2] + o[et][3] * o[et][3]); }
    sq2 += __shfl_xor(sq2, 16); sq2 += __shfl_xor(sq2, 32);
    const float rstd = 1.0f / sqrtf(sq2 * (1.f / 64.f) + EPS);
    const float* gn = C.in[11] + layer * 384 + 64 * h;
    bf16* yp = WSP(bf16, WS_YMIX) + (size_t)rowi * D + 64 * h + 4 * g;
#pragma unroll
    for (int et = 0; et < 4; ++et) {
        const f32x4 gg = *(const f32x4*)(gn + 16 * et + 4 * g);
        const float y0 = o[et][0] * rstd * gg[0] * siluf(bflo(gw[et].x)), y1 = o[et][1] * rstd * gg[1] * siluf(bfhi(gw[et].x));
        const float y2 = o[et][2] * rstd * gg[2] * siluf(bflo(gw[et].y)), y3 = o[et][3] * rstd * gg[3] * siluf(bfhi(gw[et].y));
        v2u w; w.x = cvtpk(y0, y1); w.y = cvtpk(y2, y3);
        *(v2u*)(yp + 16 * et) = w;
    }
}

__device__ __forceinline__ void p_mix1(const Ctx& C, int layer) {
    { const int per = (1536 + C.G - 1) / C.G, u0 = C.bx * per, nu = min(per, 1536 - u0); if (nu > 0) { if ((per & 1) == 0) na_band2(C, layer, u0, nu); else na_band(C, layer, u0, nu); } }
    const int n_ctx = (layer == 0) ? 96 : 0, nu2 = n_ctx + 816;
    for (int u = C.bx; u < nu2; u += C.G) {
        if (u < n_ctx) { const int bh = u >> 2; ctxattn_unit(C, bh / 6, bh % 6, u & 3); }
        else { const int v = u - n_ctx, bh = v / 34; ret_a_unit(C, layer, bh / 6, bh % 6, v % 34); }
    }
    __syncthreads();
}
__device__ __forceinline__ void p_mix2(const Ctx& C, int layer) {
    ret_scan(C, layer);
    const bf16* PROJ = WSP(bf16, WS_PROJ); bf16* Y = WSP(bf16, WS_YMIX);
    const float* cw = C.in[12] + layer * 3 * 256;
    const int nrows = (layer == 0) ? RALL : RLAT;
    for (int idx = C.gtid; idx < nrows * 32; idx += C.NT) {
        const int m = idx >> 5, ch = (idx & 31) * 8;
        int tpos, len; if (m < RLAT) { tpos = m & 4095; len = SEQ; } else { tpos = (m - RLAT) & 255; len = CTXL; }
        const bf16* p = PROJ + (size_t)m * NPROJP + ch;
        const v4u zero = {0u, 0u, 0u, 0u};
        const v4u cb = *(const v4u*)(p + C_CB), cc1 = *(const v4u*)(p + C_CC), cx1 = *(const v4u*)(p + C_CX);
        const v4u cc0 = (tpos > 0) ? *(const v4u*)(p + C_CC - NPROJP) : zero, cx0 = (tpos > 0) ? *(const v4u*)(p + C_CX - NPROJP) : zero;
        const v4u cc2 = (tpos < len - 1) ? *(const v4u*)(p + C_CC + NPROJP) : zero, cx2 = (tpos < len - 1) ? *(const v4u*)(p + C_CX + NPROJP) : zero;
        const f32x4 w0a = *(const f32x4*)(cw + ch), w0b = *(const f32x4*)(cw + ch + 4), w1a = *(const f32x4*)(cw + 256 + ch), w1b = *(const f32x4*)(cw + 256 + ch + 4), w2a = *(const f32x4*)(cw + 512 + ch), w2b = *(const f32x4*)(cw + 512 + ch + 4);
        float y[8];
#pragma unroll
        for (int i = 0; i < 4; ++i) {
            const float wl0 = (i < 2) ? w0a[2 * i] : w0b[2 * i - 4], wh0 = (i < 2) ? w0a[2 * i + 1] : w0b[2 * i - 3];
            const float wl1 = (i < 2) ? w1a[2 * i] : w1b[2 * i - 4], wh1 = (i < 2) ? w1a[2 * i + 1] : w1b[2 * i - 3];
            const float wl2 = (i < 2) ? w2a[2 * i] : w2b[2 * i - 4], wh2 = (i < 2) ? w2a[2 * i + 1] : w2b[2 * i - 3];
            y[2 * i] = bflo(cb[i]) * (wl0 * bflo(cc0[i]) * bflo(cx0[i]) + wl1 * bflo(cc1[i]) * bflo(cx1[i]) + wl2 * bflo(cc2[i]) * bflo(cx2[i]));
            y[2 * i + 1] = bfhi(cb[i]) * (wh0 * bfhi(cc0[i]) * bfhi(cx0[i]) + wh1 * bfhi(cc1[i]) * bfhi(cx1[i]) + wh2 * bfhi(cc2[i]) * bfhi(cx2[i]));
        }
        v4u o; o.x = cvtpk(y[0], y[1]); o.y = cvtpk(y[2], y[3]); o.z = cvtpk(y[4], y[5]); o.w = cvtpk(y[6], y[7]);
        *(v4u*)(Y + (size_t)m * D + 384 + ch) = o;
    }
}
__device__ __forceinline__ void p_mix3(const Ctx& C, int layer) {
    const int nu = (layer == 0) ? 816 : 768;
    for (int u = C.bx; u < nu; u += C.G) {
        if (layer == 0) { const int bh = u / 34; ret_c_unit(C, layer, bh / 6, bh % 6, u % 34); }
        else { const int bh = u >> 5; ret_c_unit(C, layer, bh / 6, bh % 6, 2 + (u & 31)); }
    }
    __syncthreads();
}
__device__ __forceinline__ void p_moe_lists(const Ctx& C) {
    LAS int* L = (LAS int*)(C.lds + RING_OFF);
    const int* CNT = WSP(int, WS_CNT);
    for (int blk = C.bx; blk < 256; blk += C.G) {
        __syncthreads();
        for (int i = C.tid; i < 2048; i += NTHR) L[i] = CNT[i];
        if (C.tid < 64) L[2080 + C.tid] = WSP(int, WS_TOKE)[64 * blk + C.tid];
        __syncthreads();
        {
            const int e = C.wave; int tot = 0, pre = 0;
#pragma unroll
            for (int q = 0; q < 4; ++q) { const int k = 4 * C.lane + q; const int cnt = L[k * 8 + e]; tot += cnt; pre += (k < blk) ? cnt : 0; }
#pragma unroll
            for (int o = 1; o < 64; o <<= 1) { tot += __shfl_xor(tot, o); pre += __shfl_xor(pre, o); }
            if (C.lane == 0) { L[2048 + e] = tot; L[2064 + e] = pre; }
        }
        __syncthreads();
        if (C.tid == 0) { int base = 0; for (int e = 0; e < 8; ++e) { L[2056 + e] = base; base += (L[2048 + e] + 255) & ~255; } }
        __syncthreads();
        {
            const int e = C.wave, ee = L[2080 + C.lane], e1 = ee & 255, e2 = ee >> 8;
            const bool hit = (e1 == e) || (e2 == e);
            const unsigned long long bal = __ballot(hit);
            const int rank = __popcll(bal & ((1ull << C.lane) - 1ull));
            if (hit) L[2144 + 2 * C.lane + ((e1 == e) ? 0 : 1)] = L[2056 + e] + L[2064 + e] + rank;
        }
        __syncthreads();
        if (C.tid < 128) { const int t = C.tid >> 1, k = C.tid & 1, m = 64 * blk + t, pos = L[2144 + C.tid];
            WSP(int, WS_TOKP)[2 * m + k] = pos; WSP(float, WS_ROWW)[pos] = WSP(float, WS_TOKW)[2 * m + k]; }
        for (int j = 0; j < 8; ++j) { const int t = 8 * C.wave + j, m = 64 * blk + t;
            const v4u* src = (const v4u*)(WSP(bf16, WS_A) + (size_t)m * D) + 2 * C.lane;
            const v4u x0 = src[0], x1 = src[1];
            v4u y; y.x = pg8::pk4_fp8(bflo(x0.x), bfhi(x0.x), bflo(x0.y), bfhi(x0.y)); y.y = pg8::pk4_fp8(bflo(x0.z), bfhi(x0.z), bflo(x0.w), bfhi(x0.w));
            y.z = pg8::pk4_fp8(bflo(x1.x), bfhi(x1.x), bflo(x1.y), bfhi(x1.y)); y.w = pg8::pk4_fp8(bflo(x1.z), bfhi(x1.z), bflo(x1.w), bfhi(x1.w));
#pragma unroll
            for (int k = 0; k < 2; ++k) { v4u* dst = (v4u*)(WSP(unsigned char, WS_SORT) + (size_t)L[2144 + 2 * t + k] * D) + C.lane; dst[0] = y; } }
        if (blk == 0 && C.tid == 0) { int T = 0; int* TE = WSP(int, WS_TILE);
            for (int e = 0; e < 8; ++e) { const int nt = (L[2048 + e] + 255) >> 8; for (int k = 0; k < nt; ++k) TE[T + k] = e; T += nt; }
            TE[255] = T; }
    }
    __syncthreads();
}
__device__ __forceinline__ void p_final(const Ctx& C, float* out) {
    const float* fg = C.in[20]; const float* mod = WSP(float, WS_MOD) + 30720; const bf16* SL = WSP(bf16, WS_SLOT);
    for (int m0 = C.gw; m0 < RLAT; m0 += 2 * C.NGW) {
        int mm[2], pp[2][2]; bool ok[2];
#pragma unroll
        for (int r = 0; r < 2; ++r) { mm[r] = m0 + r * C.NGW; ok[r] = mm[r] < RLAT; const int mc = ok[r] ? mm[r] : m0; mm[r] = mc; pp[r][0] = WSP(int, WS_TOKP)[2 * mc]; pp[r][1] = WSP(int, WS_TOKP)[2 * mc + 1]; }
        f32x4 v[2][4]; float ss[2] = {0.f, 0.f};
#pragma unroll
        for (int r = 0; r < 2; ++r)
#pragma unroll
            for (int j = 0; j < 4; ++j) { const int c = 4 * C.lane + 256 * j; const int b = mm[r] >> 12;
                const f32x4 hv = *(const f32x4*)(WSP(float, WS_H) + (size_t)mm[r] * D + c), g2 = *(const f32x4*)(mod + b * 6144 + 5 * D + c);
                const v2u q1 = *(const v2u*)(SL + (size_t)pp[r][0] * D + c), q2 = *(const v2u*)(SL + (size_t)pp[r][1] * D + c);
                const f32x4 s1 = {bflo(q1.x), bfhi(q1.x), bflo(q1.y), bfhi(q1.y)}, s2 = {bflo(q2.x), bfhi(q2.x), bflo(q2.y), bfhi(q2.y)};
                v[r][j] = hv + g2 * (s1 + s2); ss[r] += (v[r][j].x * v[r][j].x + v[r][j].y * v[r][j].y) + (v[r][j].z * v[r][j].z + v[r][j].w * v[r][j].w); }
#pragma unroll
        for (int r = 0; r < 2; ++r) {
            const float rstd = 1.0f / sqrtf(wave_sum(ss[r]) * (1.0f / D) + EPS);
            if (ok[r]) {
#pragma unroll
                for (int j = 0; j < 4; ++j) { const int c = 4 * C.lane + 256 * j; __builtin_nontemporal_store(v[r][j] * rstd * *(const f32x4*)(fg + c), (f32x4*)(out + (size_t)mm[r] * D + c)); }
            }
        }
    }
}

#ifndef MK_ONE_LAUNCH
#define MK_ONE_LAUNCH 1
#endif
constexpr int NPHASES = 21;
#ifndef PROBE_DUP
#define PROBE_DUP 0u
#endif
#define REPS(k) ((((PROBE_DUP) >> (k)) & 1u) ? 2 : 1)
struct Args { const float* in[21]; float* out; unsigned char* ws; int ph_lo, ph_hi; };
__global__ void __launch_bounds__(NTHR, 2) fwd(Args args) {
    extern __shared__ __attribute__((aligned(16))) unsigned char lds_raw[];
    Ctx C;
    C.lds = (LAS unsigned char*)lds_raw;
    C.tid = threadIdx.x; C.lane = C.tid & 63; C.wave = __builtin_amdgcn_readfirstlane(C.tid >> 6);
    C.G = gridDim.x; C.bx = blockIdx.x; C.gw = C.bx * NWAVES + C.wave; C.NGW = C.G * NWAVES; C.gtid = C.bx * NTHR + C.tid; C.NT = C.G * NTHR;
    C.ws = args.ws;
#pragma unroll
    for (int i = 0; i < 21; ++i) C.in[i] = args.in[i];
    volatile LAS unsigned* MISC = (volatile LAS unsigned*)(C.lds + MISC_OFF);
    for (int u = C.tid; u < (LDS_BYTES - LDSCTL_OFF) / 4; u += NTHR) ((LAS unsigned*)(C.lds + LDSCTL_OFF))[u] = 0u;
    __syncthreads();
    const int lo = args.ph_lo, hi = args.ph_hi;
    unsigned* barw = (unsigned*)(C.ws + WS_CTL) + CW_BAR;
    XcdBarrier bar; bar.bar = barw; bar.x = 0; bar.st = nullptr;
    if (hi - lo > 1) bar = xcd_barrier_post(barw, MISC + 8);
#define IN(k) (lo <= (k) && (k) < hi)
#define SEAM(k) do { if (IN(k) && IN((k) + 1)) xcd_barrier(bar); } while (0)
    LAS unsigned char* ring = C.lds + RING_OFF;
    const float* cosT = WSP(float, WS_ROPE); const float* sinT = cosT + 1024;

    if (IN(0)) for (int rep = 0; rep < REPS(0); ++rep) { p_prologue(C); } SEAM(0);
    if (IN(1)) for (int rep = 0; rep < REPS(1); ++rep) { p_norm<false, 0>(C, 0, 0, true, true, true, false); } SEAM(1);
    if (IN(2)) for (int rep = 0; rep < REPS(2); ++rep) { pg8::Gemm g{WSP(bf16, WS_A), WSP(bf16, WS_WIN), RALL, NPROJP, D, D}; pg8::StaticOrder S; S.init(RALL, NPROJP, C.G, C.bx);
        pg8::EpiInProj E{WSP(bf16, WS_PROJ), cosT, sinT};
        pg8::gemm_phase<pg8::EpiInProj, pg8::StaticOrder, true, true>(ring, g, S, E); } SEAM(2);
    if (IN(3)) for (int rep = 0; rep < REPS(3); ++rep) { p_mix1(C, 0); } SEAM(3);
    if (IN(4)) for (int rep = 0; rep < REPS(4); ++rep) { p_mix2(C, 0); } SEAM(4);
    if (IN(5)) for (int rep = 0; rep < REPS(5); ++rep) { p_mix3(C, 0); } SEAM(5);
    if (IN(6)) for (int rep = 0; rep < REPS(6); ++rep) { { pg8::Gemm g{WSP(bf16, WS_YMIX), WSP(bf16, WS_WOUT), RLAT, D, D, D}; pg8::StaticOrder S; S.init(RLAT, D, C.G, C.bx);
        pg8::EpiResid E{WSP(float, WS_H), C.in[0], C.in[2], WSP(float, WS_MOD), 2 * D};
        pg8::gemm_phase<pg8::EpiResid, pg8::StaticOrder, true, true>(ring, g, S, E); }
        { pg8::Gemm g{WSP(bf16, WS_YMIX) + (size_t)RLAT * D, WSP(bf16, WS_WOUT), RCTX, D, 256, D}; pg8::SplitOrder S; S.init(4, C.G, C.bx);
        pg8::EpiPartial E{WSP(float, WS_PART), WSP(float, WS_MOD), 2 * D};
        pg8::gemm_phase<pg8::EpiPartial, pg8::SplitOrder, false, true>(ring, g, S, E); } } SEAM(6);
    if (IN(7)) for (int rep = 0; rep < REPS(7); ++rep) { p_norm<false, 4>(C, 0, 1, true, false, true, true); } SEAM(7);
    if (IN(8)) for (int rep = 0; rep < REPS(8); ++rep) { pg8::Gemm g{WSP(bf16, WS_A), WSP(bf16, WS_FIN), RALL, 2 * DFF, D, D}; pg8::StaticOrder S; S.init(RALL, 2 * DFF, C.G, C.bx);
        pg8::EpiSwiglu E{WSP(bf16, WS_HID)};
        pg8::gemm_phase<pg8::EpiSwiglu, pg8::StaticOrder, true, true>(ring, g, S, E); } SEAM(8);
    if (IN(9)) for (int rep = 0; rep < REPS(9); ++rep) { { pg8::Gemm g{WSP(bf16, WS_HID), WSP(bf16, WS_FOUT), RLAT, D, DFF, DFF}; pg8::StaticOrder S; S.init(RLAT, D, C.G, C.bx);
        pg8::EpiResid E{WSP(float, WS_H), WSP(float, WS_H), WSP(float, WS_H) + (size_t)RLAT * D, WSP(float, WS_MOD), 5 * D};
        pg8::gemm_phase<pg8::EpiResid, pg8::StaticOrder, true, true>(ring, g, S, E); }
        { pg8::Gemm g{WSP(bf16, WS_HID) + (size_t)RLAT * DFF, WSP(bf16, WS_FOUT), RCTX, D, 256, DFF}; pg8::SplitOrder S; S.init(11, C.G, C.bx);
        pg8::EpiPartial E{WSP(float, WS_PART), WSP(float, WS_MOD), 5 * D};
        pg8::gemm_phase<pg8::EpiPartial, pg8::SplitOrder, false, true>(ring, g, S, E); } } SEAM(9);
    if (IN(10)) for (int rep = 0; rep < REPS(10); ++rep) { p_norm<false, 11>(C, 1, 0, true, false, false, false); } SEAM(10);
    if (IN(11)) for (int rep = 0; rep < REPS(11); ++rep) { pg8::Gemm g{WSP(bf16, WS_A), WSP(bf16, WS_WIN) + (size_t)NPROJP * D, RALL, NPROJP, D, D}; pg8::StaticOrder S; S.init(RALL, NPROJP, C.G, C.bx);
        pg8::EpiInProj E{WSP(bf16, WS_PROJ), cosT, sinT};
        pg8::gemm_phase<pg8::EpiInProj, pg8::StaticOrder, true, true>(ring, g, S, E); } SEAM(11);
    if (IN(12)) for (int rep = 0; rep < REPS(12); ++rep) { p_mix1(C, 1); } SEAM(12);
    if (IN(13)) for (int rep = 0; rep < REPS(13); ++rep) { p_mix2(C, 1); } SEAM(13);
    if (IN(14)) for (int rep = 0; rep < REPS(14); ++rep) { p_mix3(C, 1); } SEAM(14);
    if (IN(15)) for (int rep = 0; rep < REPS(15); ++rep) { pg8::Gemm g{WSP(bf16, WS_YMIX), WSP(bf16, WS_WOUT) + (size_t)D * D, RLAT, D, D, D}; pg8::StaticOrder S; S.init(RLAT, D, C.G, C.bx);
        pg8::EpiResid E{WSP(float, WS_H), WSP(float, WS_H), WSP(float, WS_H) + (size_t)RLAT * D, WSP(float, WS_MOD) + 30720, 2 * D};
        pg8::gemm_phase<pg8::EpiResid, pg8::StaticOrder, true, true>(ring, g, S, E); } SEAM(15);
    if (IN(16)) for (int rep = 0; rep < REPS(16); ++rep) { p_norm<true, 0>(C, 1, 1, false, false, false, false); } SEAM(16);
    if (IN(17)) for (int rep = 0; rep < REPS(17); ++rep) { p_moe_lists(C); } SEAM(17);
    if (IN(18)) for (int rep = 0; rep < REPS(18); ++rep) { const int T = __builtin_amdgcn_readfirstlane(WSP(int, WS_TILE)[255]);
        pg8::Gemm g{WSP(bf16, WS_SORT), WSP(bf16, WS_MIN), T * 256, 2 * DFF, D / 2, D / 2}; pg8::MoeOrder S; S.init(T, 2 * DFF, C.G, C.bx, WSP(int, WS_TILE), (size_t)2 * DFF * D / 2);
        pg8::EpiSwigluF8 E{WSP(unsigned char, WS_HID)};
        pg8::gemm_phase<pg8::EpiSwigluF8, pg8::MoeOrder, true, true, true>(ring, g, S, E); } SEAM(18);
    if (IN(19)) for (int rep = 0; rep < REPS(19); ++rep) { const int T = __builtin_amdgcn_readfirstlane(WSP(int, WS_TILE)[255]);
        pg8::Gemm g{WSP(bf16, WS_HID), WSP(bf16, WS_MOUT), T * 256, D, DFF / 2, DFF / 2}; pg8::MoeOrder S; S.init(T, D, C.G, C.bx, WSP(int, WS_TILE), (size_t)D * DFF / 2);
        pg8::EpiSlots E{WSP(bf16, WS_SLOT), WSP(float, WS_ROWW)};
        pg8::gemm_phase<pg8::EpiSlots, pg8::MoeOrder, true, true, true>(ring, g, S, E); } SEAM(19);
    if (IN(20)) for (int rep = 0; rep < REPS(20); ++rep) { p_final(C, args.out); }
#undef IN
#undef SEAM
}

extern "C" void kernel_launch(void* const* d_in, const int* in_sizes, int n_in, void* d_out, int out_size, void* d_ws, size_t ws_size, hipStream_t stream) {
    static int grid = 0;
    if (grid == 0) {
        if (n_in != 21 || ws_size < WS_END) { fprintf(stderr, "kernel_launch: unexpected n_in %d or ws_size %zu (need %zu)\n", n_in, ws_size, (size_t)WS_END); grid = -1; return; }
        int dev = 0, cus = 0, per_cu = 0;
        if (hipGetDevice(&dev) != hipSuccess || hipDeviceGetAttribute(&cus, hipDeviceAttributeMultiprocessorCount, dev) != hipSuccess) { grid = -1; return; }
        if (hipFuncSetAttribute((const void*)fwd, hipFuncAttributeMaxDynamicSharedMemorySize, LDS_BYTES) != hipSuccess) { fprintf(stderr, "kernel_launch: hipFuncSetAttribute failed\n"); grid = -1; return; }
        if (hipOccupancyMaxActiveBlocksPerMultiprocessor(&per_cu, (const void*)fwd, NTHR, LDS_BYTES) != hipSuccess || per_cu < 1) fprintf(stderr, "kernel_launch: occupancy query reports %d\n", per_cu);
        (void)hipGetLastError();
        grid = cus < 256 ? cus : 256;
    }
    if (grid < 0) return;
    (void)hipMemsetAsync((char*)d_ws + WS_CTL, 0, CTL_ZERO_BYTES, stream);
    Args a{};
    for (int i = 0; i < 21; ++i) a.in[i] = (const float*)d_in[i];
    a.out = (float*)d_out; a.ws = (unsigned char*)d_ws;
#if MK_ONE_LAUNCH
    a.ph_lo = 0; a.ph_hi = NPHASES;
    hipLaunchKernelGGL(fwd, dim3(grid), dim3(NTHR), LDS_BYTES, stream, a);
#else
    for (int p = 0; p < NPHASES; ++p) { a.ph_lo = p; a.ph_hi = p + 1; hipLaunchKernelGGL(fwd, dim3(grid), dim3(NTHR), LDS_BYTES, stream, a); }
#endif
}
```

```cpp
#include <hip/hip_runtime.h>
#include <cstdio>
#include <cstdint>
namespace pg8 {
#define PG8_LAS __attribute__((address_space(3)))
typedef unsigned short bf16_t;
typedef short bf16x8 __attribute__((ext_vector_type(8)));
typedef float f32x4 __attribute__((ext_vector_type(4)));
typedef unsigned u32x4 __attribute__((ext_vector_type(4)));
constexpr int BM = 256, BK = 64, HALF = 128, HTB = HALF * BK * 2  , STAGE_BYTES = 8 * HTB, NXCD = 8, WGM = 8;

__host__ __device__ __forceinline__ int lds_byte(int r, int c) { const int st = (r >> 4) * 2 + (c >> 5), rr = r & 15, cc = c & 31, ob = rr * 64 + cc * 2; return st * 1024 + (ob ^ (((ob >> 9) & 1) << 5)); }
__host__ __device__ __forceinline__ void stage_rc(int b, int& R, int& C) { const int st = b / 1024, sb = b % 1024, swz = sb ^ (((sb >> 9) & 1) << 5); R = (st >> 1) * 16 + swz / 64; C = (st & 1) * 32 + (swz % 64) / 2; }
__host__ __device__ __forceinline__ int perm32(int rho) { const int n = rho >> 4, i = rho & 15; return 8 * (i >> 2) + 4 * n + (i & 3); }

struct Unit { int pm, pn, ks; };
struct Gemm { const bf16_t* A; const bf16_t* Bt; int M, N, K, ld; };

struct StaticOrder {
    int nM, nN, nwg, G, c;
    __host__ __device__ void init(int M, int N, int G_, int c_) { nM = M / BM; nN = N / BM; nwg = nM * nN; G = G_; c = c_; }
    __host__ __device__ bool next(int i, Unit& u) const {
        const long L = (long)i * G + c; if (L >= nwg) return false;
        int wgid = (int)L; { const int q = nwg / NXCD, r = nwg % NXCD, xcd = wgid % NXCD, off = wgid / NXCD; wgid = (xcd < r ? xcd * (q + 1) : r * (q + 1) + (xcd - r) * q) + off; }
        const int nig = WGM * nN, gid = wgid / nig, fm = gid * WGM, gsz = (nM - fm) < WGM ? (nM - fm) : WGM;
        u.pm = fm + ((wgid % nig) % gsz); u.pn = (wgid % nig) / gsz; u.ks = 0; return true;
    }
    __device__ __forceinline__ void a_ready(const Unit&) const {}
    __device__ __forceinline__ void done(const Unit&) const {}
    __device__ __forceinline__ const bf16_t* bt(const Gemm& g, const Unit&) const { return g.Bt; }
};

__device__ __forceinline__ unsigned cvt_pk_bf16(float lo, float hi) { unsigned r; asm volatile("v_cvt_pk_bf16_f32 %0, %1, %2" : "=v"(r) : "v"(lo), "v"(hi)); return r; }
typedef float f32x2 __attribute__((ext_vector_type(2)));

typedef int i32x4_t __attribute__((ext_vector_type(4)));
typedef int i32x8_t __attribute__((ext_vector_type(8)));
__device__ __forceinline__ i32x8_t cat8(bf16x8 lo, bf16x8 hi) { const i32x4_t l = __builtin_bit_cast(i32x4_t, lo), h = __builtin_bit_cast(i32x4_t, hi); return __builtin_shufflevector(l, h, 0, 1, 2, 3, 4, 5, 6, 7); }
template <class Epi, class Sched, bool ALIGN_EPI = false, bool SP2 = false, bool FP8 = false>
__device__ __forceinline__ void gemm_phase(PG8_LAS unsigned char* lds, const Gemm g, const Sched& S, const Epi& E) {
    const int tid = threadIdx.x, wid = __builtin_amdgcn_readfirstlane(tid >> 6), lane = tid & 63, wr = wid >> 2, wc = wid & 3, fr = lane & 15, fq = lane >> 4;
    const int K = g.K, nt = K / BK, LD = g.ld;
    unsigned voffA[2], voffB[2];
#pragma unroll
    for (int i = 0; i < 2; ++i) { int R, C; stage_rc(tid * 16 + i * 8192, R, C); const int Rb = Epi::PERM ? ((R & ~31) + perm32(R & 31)) : R;
        voffA[i] = (unsigned)(R * LD + C) * 2u; voffB[i] = (unsigned)(Rb * LD + C) * 2u; }
    const size_t kstep = (size_t)(BK * 2);
    const size_t hstep = (size_t)HALF * LD * 2;
    const size_t tstep = 2 * hstep;
    const unsigned ldsw = (unsigned)wid * 1024u;
    const int aoff = lds_byte(wr * 64 + fr, fq * 8), boff = lds_byte(wc * 32 + fr, fq * 8);
#define PG8_SA(b, h) (((b) * 2 + (h)) * HTB)
#define PG8_SB(b, h) ((4 + (b) * 2 + (h)) * HTB)
#define PG8_STAGE(bufoff, gbase, voff) do { _Pragma("unroll") for (int _i = 0; _i < 2; ++_i) \
        __builtin_amdgcn_global_load_lds((const unsigned*)((const char*)(gbase) + (voff)[_i]), (PG8_LAS unsigned*)(lds + (bufoff) + ldsw + _i * 8192), 16, 0, 0); } while (0)
#define PG8_LDA(dst, b, h) do { if constexpr (FP8) { _Pragma("unroll") for (int m = 0; m < 4; ++m) dst##_8[m] = cat8(*(const PG8_LAS bf16x8*)(lds + PG8_SA(b, h) + aoff + m * 2048), *(const PG8_LAS bf16x8*)(lds + PG8_SA(b, h) + aoff + m * 2048 + 1024)); } \
    else { _Pragma("unroll") for (int m = 0; m < 4; ++m) _Pragma("unroll") for (int k = 0; k < 2; ++k) dst[m][k] = *(const PG8_LAS bf16x8*)(lds + PG8_SA(b, h) + aoff + m * 2048 + k * 1024); } } while (0)
#define PG8_LDB(dst, b, h) do { if constexpr (FP8) { _Pragma("unroll") for (int n = 0; n < 2; ++n) dst##_8[n] = cat8(*(const PG8_LAS bf16x8*)(lds + PG8_SB(b, h) + boff + n * 2048), *(const PG8_LAS bf16x8*)(lds + PG8_SB(b, h) + boff + n * 2048 + 1024)); } \
    else { _Pragma("unroll") for (int n = 0; n < 2; ++n) _Pragma("unroll") for (int k = 0; k < 2; ++k) dst[n][k] = *(const PG8_LAS bf16x8*)(lds + PG8_SB(b, h) + boff + n * 2048 + k * 1024); } } while (0)
#define PG8_MMA(ai, bj, At, Bt) do { __builtin_amdgcn_s_setprio(1); _Pragma("unroll") for (int m = 0; m < 4; ++m) _Pragma("unroll") for (int n = 0; n < 2; ++n) { \
        if constexpr (FP8) { asm volatile("v_mfma_scale_f32_16x16x128_f8f6f4 %0, %1, %2, %0, %3, %4 op_sel_hi:[0,0,0]" : "+v"(acc[ai][bj][m][n]) : "v"(Bt##_8[n]), "v"(At##_8[m]), "v"(f8_scale_w), "v"(f8_scale_a)); } \
        else { _Pragma("unroll") for (int k = 0; k < 2; ++k) acc[ai][bj][m][n] = __builtin_amdgcn_mfma_f32_16x16x32_bf16(Bt[n][k], At[m][k], acc[ai][bj][m][n], 0, 0, 0); } } __builtin_amdgcn_s_setprio(0); } while (0)
#define PG8_WAIT_V(n) asm volatile("s_waitcnt vmcnt(" #n ")" ::: "memory")
#define PG8_WAIT_L(n) asm volatile("s_waitcnt lgkmcnt(" #n ")" ::: "memory")
#define PG8_BAR __builtin_amdgcn_s_barrier()
#define PG8_SCHED __builtin_amdgcn_sched_barrier(0)
    Unit cur, nxt; int ui = 0;
    if (!S.next(0, cur)) return;
    f32x4 acc[2][2][4][2];
#pragma unroll
    for (int a = 0; a < 2; ++a)
#pragma unroll
        for (int b = 0; b < 2; ++b)
#pragma unroll
            for (int m = 0; m < 4; ++m)
#pragma unroll
                for (int n = 0; n < 2; ++n) acc[a][b][m][n] = (f32x4){0.f, 0.f, 0.f, 0.f};
    bf16x8 At[4][2], B0[2][2], B1[2][2]; i32x8_t At_8[4], B0_8[2], B1_8[2];
    const int f8_scale_w = 0x79797979, f8_scale_a = 0x7f7f7f7f;
    const char* cA = (const char*)g.A + (size_t)cur.pm * tstep + (size_t)cur.ks * K * 2; const char* cB = (const char*)S.bt(g, cur) + (size_t)cur.pn * tstep + (size_t)cur.ks * K * 2;
    S.a_ready(cur);
    if constexpr (SP2) {
        PG8_STAGE(PG8_SB(0, 0), cB, voffB); PG8_STAGE(PG8_SB(0, 1), cB + hstep, voffB); PG8_STAGE(PG8_SA(0, 0), cA, voffA); PG8_STAGE(PG8_SA(0, 1), cA + hstep, voffA);
        if (wr == 1) PG8_BAR;
        PG8_WAIT_V(2); PG8_BAR;
        PG8_STAGE(PG8_SB(1, 0), cB + kstep, voffB); PG8_STAGE(PG8_SA(1, 0), cA + kstep, voffA); PG8_STAGE(PG8_SB(1, 1), cB + hstep + kstep, voffB);
        PG8_WAIT_V(6); PG8_BAR;
    } else {
        PG8_STAGE(PG8_SB(0, 0), cB, voffB); PG8_STAGE(PG8_SA(0, 0), cA, voffA); PG8_STAGE(PG8_SB(0, 1), cB + hstep, voffB); PG8_STAGE(PG8_SA(0, 1), cA + hstep, voffA);
        if (wr == 1) PG8_BAR;
        PG8_WAIT_V(4); PG8_BAR;
        PG8_STAGE(PG8_SB(1, 0), cB + kstep, voffB); PG8_STAGE(PG8_SA(1, 0), cA + kstep, voffA); PG8_STAGE(PG8_SB(1, 1), cB + hstep + kstep, voffB);
        PG8_WAIT_V(6); PG8_BAR;
    }
    for (;;) {
        const bool has_next = S.next(ui + 1, nxt);
        const char* nA = has_next ? (const char*)g.A + (size_t)nxt.pm * tstep + (size_t)nxt.ks * K * 2 : cA; const char* nB = has_next ? (const char*)S.bt(g, nxt) + (size_t)nxt.pn * tstep + (size_t)nxt.ks * K * 2 : cB;
#pragma clang loop unroll(disable)
        for (int t = 0; t < nt; t += 2) {
            const bool last = (t == nt - 2);
            const char* a1 = cA + (size_t)(t + 1) * kstep;
            const char* a2 = last ? nA : cA + (size_t)(t + 2) * kstep; const char* b2 = last ? nB : cB + (size_t)(t + 2) * kstep;
            const char* a3 = a2 + kstep; const char* b3 = b2 + kstep;
            if (last && has_next) S.a_ready(nxt);
            if constexpr (SP2) {
            PG8_LDB(B0, 0, 0); PG8_LDB(B1, 0, 1); PG8_SCHED; PG8_LDA(At, 0, 0); PG8_STAGE(PG8_SA(1, 1), a1 + hstep, voffA);
            PG8_WAIT_V(8); PG8_WAIT_L(0); PG8_BAR; PG8_MMA(0, 0, At, B0); PG8_MMA(0, 1, At, B1); PG8_BAR; PG8_SCHED;
            PG8_LDA(At, 0, 1); PG8_STAGE(PG8_SB(0, 0), b2, voffB); PG8_STAGE(PG8_SB(0, 1), b2 + hstep, voffB); PG8_STAGE(PG8_SA(0, 0), a2, voffA);
            PG8_WAIT_V(8); PG8_WAIT_L(0); PG8_BAR; PG8_MMA(1, 0, At, B0); PG8_MMA(1, 1, At, B1); PG8_BAR; PG8_SCHED;
            PG8_LDB(B0, 1, 0); PG8_LDB(B1, 1, 1); PG8_SCHED; PG8_LDA(At, 1, 0); PG8_STAGE(PG8_SA(0, 1), a2 + hstep, voffA);
            PG8_WAIT_V(8); PG8_WAIT_L(0); PG8_BAR; PG8_MMA(0, 0, At, B0); PG8_MMA(0, 1, At, B1); PG8_BAR; PG8_SCHED;
            PG8_LDA(At, 1, 1); PG8_STAGE(PG8_SB(1, 0), b3, voffB); PG8_STAGE(PG8_SB(1, 1), b3 + hstep, voffB); PG8_STAGE(PG8_SA(1, 0), a3, voffA);
            PG8_WAIT_V(8); PG8_WAIT_L(0); PG8_BAR; PG8_MMA(1, 0, At, B0); PG8_MMA(1, 1, At, B1); PG8_BAR; PG8_SCHED;
            } else {
            PG8_LDB(B0, 0, 0); PG8_SCHED; PG8_LDA(At, 0, 0); PG8_STAGE(PG8_SA(1, 1), a1 + hstep, voffA);
            PG8_WAIT_L(8); PG8_BAR; PG8_WAIT_L(0); PG8_MMA(0, 0, At, B0); PG8_BAR; PG8_SCHED;
            PG8_LDB(B1, 0, 1); PG8_STAGE(PG8_SB(0, 0), b2, voffB);
            PG8_BAR; PG8_WAIT_L(0); PG8_MMA(0, 1, At, B1); PG8_BAR;
            PG8_LDA(At, 0, 1); PG8_STAGE(PG8_SA(0, 0), a2, voffA);
            PG8_BAR; PG8_WAIT_L(0); PG8_MMA(1, 0, At, B0); PG8_BAR; PG8_SCHED;
            PG8_STAGE(PG8_SB(0, 1), b2 + hstep, voffB);
            PG8_WAIT_V(6); PG8_BAR; PG8_MMA(1, 1, At, B1); PG8_BAR;
            PG8_LDB(B0, 1, 0); PG8_SCHED; PG8_LDA(At, 1, 0); PG8_STAGE(PG8_SA(0, 1), a2 + hstep, voffA);
            PG8_WAIT_L(8); PG8_BAR; PG8_WAIT_L(0); PG8_MMA(0, 0, At, B0); PG8_BAR; PG8_SCHED;
            PG8_LDB(B1, 1, 1); PG8_STAGE(PG8_SB(1, 0), b3, voffB);
            PG8_BAR; PG8_WAIT_L(0); PG8_MMA(0, 1, At, B1); PG8_BAR;
            PG8_LDA(At, 1, 1); PG8_STAGE(PG8_SA(1, 0), a3, voffA);
            PG8_BAR; PG8_WAIT_L(0); PG8_MMA(1, 0, At, B0); PG8_BAR; PG8_SCHED;
            PG8_STAGE(PG8_SB(1, 1), b3 + hstep, voffB);
            PG8_WAIT_V(6); PG8_BAR; PG8_MMA(1, 1, At, B1); PG8_BAR;
            }
        }
        if constexpr (ALIGN_EPI) { if (wr == 0) PG8_BAR; }
        if constexpr (FP8) asm volatile("s_nop 15\n\ts_nop 15" ::: "memory");
        if constexpr (!Epi::AFTER_DRAIN) { E(acc, cur, wr, wc, fr, fq); S.done(cur); }
        if (!has_next) break;
#pragma unroll
        for (int a = 0; a < 2; ++a)
#pragma unroll
            for (int b = 0; b < 2; ++b)
#pragma unroll
                for (int m = 0; m < 4; ++m)
#pragma unroll
                    for (int n = 0; n < 2; ++n) acc[a][b][m][n] = (f32x4){0.f, 0.f, 0.f, 0.f};
        cur = nxt; cA = nA; cB = nB; ++ui;
        if constexpr (ALIGN_EPI) { if (wr == 1) PG8_BAR; }
    }
    PG8_WAIT_V(0);
    if constexpr (!ALIGN_EPI) { if (wr == 0) PG8_BAR; }
    PG8_BAR;
    if constexpr (Epi::AFTER_DRAIN) { E.fused(acc, cur, wr, wc, fr, fq, lds, wid, lane); S.done(cur); }
#undef PG8_SA
#undef PG8_SB
#undef PG8_STAGE
#undef PG8_LDA
#undef PG8_LDB
#undef PG8_MMA
#undef PG8_WAIT_V
#undef PG8_WAIT_L
#undef PG8_BAR
#undef PG8_SCHED
}
}


constexpr int NWAVES = 8, NTHR = 512;
constexpr int D = 1024, NB = 4, SEQ = 4096, CTXL = 256, RLAT = NB * SEQ, RCTX = NB * CTXL, RALL = RLAT + RCTX;
constexpr int NPROJ = 3456, NPROJP = 3584, DFF = 2816, NE = 8;
constexpr int C_RQ = 0, C_RK = 384, C_RV = 768, C_RG = 1152, C_CB = 1536, C_CC = 1792, C_CX = 2048, C_NQ = 2304, C_NK = 2688, C_NV = 3072;
constexpr int MOE_ROWS = 2 * RLAT + NE * 256;
constexpr float EPS = 1e-6f;

constexpr size_t MiB = 1u << 20, KiB = 1u << 10;
constexpr size_t WS_CTL = 0, CTL_ZERO_BYTES = 1 * MiB;
constexpr size_t WS_MODP = 1 * MiB;
constexpr size_t WS_MOD = 3 * MiB;
constexpr size_t WS_ROWW = 3 * MiB + 256 * KiB;
constexpr size_t WS_ROPE = 3 * MiB + 512 * KiB;
constexpr size_t WS_CNT = WS_ROPE + 16 * KiB;
constexpr size_t WS_TILE = WS_ROPE + 32 * KiB;
constexpr size_t WS_TOKE = WS_ROPE + 64 * KiB;
constexpr size_t WS_TOKW = WS_ROPE + 128 * KiB;
constexpr size_t WS_TOKP = WS_ROPE + 256 * KiB;
constexpr size_t WS_WIN = 4 * MiB;
constexpr size_t WS_WOUT = 18 * MiB;
constexpr size_t WS_FIN = 22 * MiB;
constexpr size_t WS_FOUT = 33 * MiB;
constexpr size_t WS_MIN = 39 * MiB;
constexpr size_t WS_MOUT = 127 * MiB;
constexpr size_t WS_H = 171 * MiB;
constexpr size_t WS_A = 239 * MiB;
constexpr size_t WS_PROJ = 273 * MiB;
constexpr size_t WS_YMIX = 392 * MiB;
constexpr size_t WS_HID = 273 * MiB;
constexpr size_t WS_OBUF = 474 * MiB;
constexpr size_t WS_SORT = 526 * MiB;
constexpr size_t WS_SLOT = 474 * MiB;
constexpr size_t WS_PART = 610 * MiB;
constexpr size_t WS_END = 654 * MiB;
constexpr int CW_BAR = 4096;

constexpr int RING_OFF = 0, RING_BYTES = 131072;
constexpr int LDSCTL_OFF = RING_BYTES, MISC_OFF = LDSCTL_OFF + 320;
constexpr int LDS_BYTES = 147456;

#define GAS __attribute__((address_space(1)))
#define LAS __attribute__((address_space(3)))
typedef unsigned short bf16;
typedef unsigned v4u __attribute__((ext_vector_type(4)));
typedef unsigned v2u __attribute__((ext_vector_type(2)));
typedef float f32x4 __attribute__((ext_vector_type(4)));
typedef GAS unsigned gu32;
#define RLX_AGENT __ATOMIC_RELAXED, __HIP_MEMORY_SCOPE_AGENT
#define LDS_WAIT() asm volatile("s_waitcnt lgkmcnt(0)" ::: "memory")
__device__ __forceinline__ unsigned f2bf(float f) { unsigned u = __builtin_bit_cast(unsigned, f); return (u + 0x7fffu + ((u >> 16) & 1u)) >> 16; }
__device__ __forceinline__ unsigned pk2(float lo, float hi) { return f2bf(lo) | (f2bf(hi) << 16); }
__device__ __forceinline__ float bf2f(unsigned short b) { return __builtin_bit_cast(float, (unsigned)b << 16); }
__device__ __forceinline__ float bflo(unsigned u) { return __builtin_bit_cast(float, u << 16); }
__device__ __forceinline__ float bfhi(unsigned u) { return __builtin_bit_cast(float, u & 0xffff0000u); }
__device__ __forceinline__ float siluf(float x) { return x * __builtin_amdgcn_rcpf(1.f + __expf(-x)); }
__device__ __forceinline__ float wave_sum(float v) {
#pragma unroll
    for (int o = 1; o < 64; o <<= 1) v += __shfl_xor(v, o);
    return v;
}
__device__ __forceinline__ float wave_max(float v) {
#pragma unroll
    for (int o = 1; o < 64; o <<= 1) v = fmaxf(v, __shfl_xor(v, o));
    return v;
}
#define XB_TMO      128
#define XB_XCNT(j)  (256  + 64 * (j))
#define XB_XSUB(j)  (1280 + 64 * (j))
#define XB_XGEN(j)  (2304 + 64 * (j))
#define XB_TOP      3328
#define XB_TOPGEN   3392
#define XCD_BAR_WORDS 3456
#define XB_SPIN_CAP (1u << 18)

__device__ __forceinline__ unsigned xb_ld(unsigned* p)              { return __hip_atomic_load(p, __ATOMIC_RELAXED, __HIP_MEMORY_SCOPE_AGENT); }
__device__ __forceinline__ unsigned xb_add(unsigned* p, unsigned v) { return __hip_atomic_fetch_add(p, v, __ATOMIC_RELAXED, __HIP_MEMORY_SCOPE_AGENT); }
__device__ __forceinline__ unsigned xb_xcc_id() { return (unsigned)__builtin_amdgcn_s_getreg((3 << 11) | 20) & 0xFu; }
#define XB_SPIN(cond, bar) do { unsigned _sp = 0; while (cond) { __builtin_amdgcn_s_sleep(1); \
    if ((++_sp & 255u) == 0u) { if (xb_ld(&(bar)[XB_TMO])) break; if (_sp > XB_SPIN_CAP) { atomicAdd(&(bar)[XB_TMO], 1u); break; } } } } while (0)

struct XcdBarrier {
    unsigned* bar; unsigned x;
    volatile LAS unsigned* st;
};

__device__ __forceinline__ XcdBarrier xcd_barrier_post(unsigned* bar, volatile LAS unsigned* st) {
    XcdBarrier b; b.bar = bar; b.x = xb_xcc_id(); b.st = st;
    if (threadIdx.x == 0) (void)xb_add(&bar[XB_XCNT(b.x)], 1u);
    return b;
}
__device__ __forceinline__ void xcd_barrier_complete(unsigned* bar, unsigned x, unsigned& nloc, unsigned& nx) {
    const unsigned G = gridDim.x * gridDim.y * gridDim.z;
    unsigned sum, cnt, mine, sp = 0u;
    for (;;) {
        sum = 0u; cnt = 0u; mine = 0u;
#pragma unroll
        for (unsigned j = 0; j < 16; ++j) { const unsigned c = xb_ld(&bar[XB_XCNT(j)]); sum += c; cnt += (c > 0u) ? 1u : 0u; mine = (j == x) ? c : mine; }
        if (sum == G) break;
        __builtin_amdgcn_s_sleep(1);
        if ((++sp & 255u) == 0u) { if (xb_ld(&bar[XB_TMO])) break; if (sp > XB_SPIN_CAP) { atomicAdd(&bar[XB_TMO], 1u); break; } }
    }
    nloc = mine > 0u ? mine : 1u; nx = cnt > 0u ? cnt : 1u;
}

__device__ __forceinline__ void xcd_barrier(const XcdBarrier& b) {
    asm volatile("s_waitcnt vmcnt(0)" ::: "memory");
    __syncthreads();
    if (threadIdx.x == 0) {
        unsigned* bar = b.bar;
        __builtin_amdgcn_s_waitcnt(0);
        unsigned nloc = b.st[0], nx = b.st[1];
        if (nloc == 0u) { xcd_barrier_complete(bar, b.x, nloc, nx); b.st[0] = nloc; b.st[1] = nx; }
        const unsigned old = xb_add(&bar[XB_XSUB(b.x)], 1u);
        const unsigned gen = old / nloc;
        if (old + 1u == (gen + 1u) * nloc) {
            __builtin_amdgcn_fence(__ATOMIC_RELEASE, "agent");
            asm volatile("s_waitcnt vmcnt(0)" ::: "memory");
            const unsigned og = xb_add(&bar[XB_TOP], 1u);
            const unsigned tg = og / nx;
            if (og + 1u == (tg + 1u) * nx) xb_add(&bar[XB_TOPGEN], 1u);
            else XB_SPIN(xb_ld(&bar[XB_TOPGEN]) == tg, bar);
            __builtin_amdgcn_fence(__ATOMIC_ACQUIRE, "agent");
            xb_add(&bar[XB_XGEN(b.x)], 1u);
            asm volatile("s_waitcnt vmcnt(0)" ::: "memory");
        } else {
            XB_SPIN(xb_ld(&bar[XB_XGEN(b.x)]) == gen, bar);
            __builtin_amdgcn_fence(__ATOMIC_ACQUIRE, "agent");
            asm volatile("s_waitcnt vmcnt(0)" ::: "memory");
        }
    }
    __syncthreads();
}


namespace pg8 {
struct EpiInProj {
    static constexpr bool PERM = true, AFTER_DRAIN = false;
    bf16_t* O; const float* cosT; const float* sinT;
    __device__ __forceinline__ void operator()(const f32x4 (&acc)[2][2][4][2], const Unit& u, int wr, int wc, int fr, int fq) const {
        const bool rope = (u.pn <= 2) && (u.pm < 64);
        const int row0 = u.pm * BM + wr * 64 + fr, col0 = u.pn * BM + wc * 32 + 8 * fq;
        const float sgn = (fq < 2) ? -1.f : 1.f;
#pragma unroll
        for (int ai = 0; ai < 2; ++ai)
#pragma unroll
            for (int m = 0; m < 4; ++m) {
                const int row = row0 + ai * HALF + m * 16;
                f32x4 cs0 = {1.f, 1.f, 1.f, 1.f}, cs1 = cs0, sn0 = {0.f, 0.f, 0.f, 0.f}, sn1 = sn0;
                if (rope) { const int t = row & 4095, pos = (wc & 1) ? (t & 63) : (t >> 6); const float* cp = cosT + pos * 16 + 8 * (fq & 1); const float* sp = sinT + pos * 16 + 8 * (fq & 1);
                    cs0 = *(const f32x4*)cp; cs1 = *(const f32x4*)(cp + 4); sn0 = *(const f32x4*)sp; sn1 = *(const f32x4*)(sp + 4); }
#pragma unroll
                for (int bj = 0; bj < 2; ++bj) {
                    f32x4 v0 = acc[ai][bj][m][0], v1 = acc[ai][bj][m][1];
                    if (rope) {
                        f32x4 p0, p1;
#pragma unroll
                        for (int j = 0; j < 4; ++j) { p0[j] = __shfl_xor(v0[j], 32); p1[j] = __shfl_xor(v1[j], 32); }
                        v0 = v0 * cs0 + (p0 * sn0) * sgn; v1 = v1 * cs1 + (p1 * sn1) * sgn;
                    }
                    const float sc = (u.pn == 2 || (u.pn == 1 && bj == 1)) ? 0.125f : 1.f;
                    v0 = v0 * sc; v1 = v1 * sc;
                    u32x4 w; w.x = cvt_pk_bf16(v0[0], v0[1]); w.y = cvt_pk_bf16(v0[2], v0[3]); w.z = cvt_pk_bf16(v1[0], v1[1]); w.w = cvt_pk_bf16(v1[2], v1[3]);
                    *(u32x4*)(O + (size_t)row * 3584 + col0 + bj * HALF) = w;
                }
            }
    }
};
struct EpiResid {
    static constexpr bool PERM = false, AFTER_DRAIN = false;
    float* H; const float* src_lat; const float* src_ctx; const float* gmod; int goff;
    __device__ __forceinline__ void operator()(const f32x4 (&acc)[2][2][4][2], const Unit& u, int wr, int wc, int fr, int fq) const {
        const int row0 = u.pm * BM + wr * 64 + fr, col0 = u.pn * BM + wc * 32 + 4 * fq;
        const int bi = (u.pm < 64) ? (u.pm >> 4) : 4;
        const float* src = (u.pm < 64) ? src_lat : src_ctx - (size_t)16384 * 1024;
        f32x4 gv[2][2];
#pragma unroll
        for (int bj = 0; bj < 2; ++bj)
#pragma unroll
            for (int n = 0; n < 2; ++n) gv[bj][n] = *(const f32x4*)(gmod + bi * 6144 + goff + col0 + bj * HALF + n * 16);
#pragma unroll
        for (int ai = 0; ai < 2; ++ai)
            {
                f32x4 sv[4][2][2];
#pragma unroll
                for (int m = 0; m < 4; ++m)
#pragma unroll
                    for (int bj = 0; bj < 2; ++bj)
#pragma unroll
                        for (int n = 0; n < 2; ++n) sv[m][bj][n] = *(const f32x4*)(src + (size_t)(row0 + ai * HALF + m * 16) * 1024 + col0 + bj * HALF + n * 16);
                asm volatile("" ::: "memory");
#pragma unroll
                for (int m = 0; m < 4; ++m)
#pragma unroll
                    for (int bj = 0; bj < 2; ++bj)
#pragma unroll
                        for (int n = 0; n < 2; ++n) *(f32x4*)(H + (size_t)(row0 + ai * HALF + m * 16) * 1024 + col0 + bj * HALF + n * 16) = sv[m][bj][n] + gv[bj][n] * acc[ai][bj][m][n];
                asm volatile("" ::: "memory");
            }
    }
};
struct EpiSwiglu {
    static constexpr bool PERM = true, AFTER_DRAIN = false;
    bf16_t* O;
    __device__ __forceinline__ void operator()(const f32x4 (&acc)[2][2][4][2], const Unit& u, int wr, int wc, int fr, int fq) const {
        const int row0 = u.pm * BM + wr * 64 + fr, col0 = u.pn * HALF + wc * 32 + 8 * fq;
#pragma unroll
        for (int ai = 0; ai < 2; ++ai)
#pragma unroll
            for (int m = 0; m < 4; ++m) {
                float hv[8];
#pragma unroll
                for (int n = 0; n < 2; ++n)
#pragma unroll
                    for (int j = 0; j < 4; ++j) { const float g = acc[ai][0][m][n][j], up = acc[ai][1][m][n][j]; hv[n * 4 + j] = g * __builtin_amdgcn_rcpf(1.f + __expf(-g)) * up; }
                u32x4 w; w.x = cvt_pk_bf16(hv[0], hv[1]); w.y = cvt_pk_bf16(hv[2], hv[3]); w.z = cvt_pk_bf16(hv[4], hv[5]); w.w = cvt_pk_bf16(hv[6], hv[7]);
                *(u32x4*)(O + (size_t)(row0 + ai * HALF + m * 16) * 2816 + col0) = w;
            }
    }
};
__device__ __forceinline__ unsigned pk4_fp8(float a, float b, float c2, float d) {
    a = fminf(fmaxf(a, -448.f), 448.f); b = fminf(fmaxf(b, -448.f), 448.f); c2 = fminf(fmaxf(c2, -448.f), 448.f); d = fminf(fmaxf(d, -448.f), 448.f);
    unsigned w = 0; w = __builtin_amdgcn_cvt_pk_fp8_f32(a, b, w, false); w = __builtin_amdgcn_cvt_pk_fp8_f32(c2, d, w, true); return w;
}
struct EpiSwigluF8 {
    static constexpr bool PERM = true, AFTER_DRAIN = false;
    unsigned char* O;
    __device__ __forceinline__ void operator()(const f32x4 (&acc)[2][2][4][2], const Unit& u, int wr, int wc, int fr, int fq) const {
        const int row0 = u.pm * BM + wr * 64 + fr, col0 = u.pn * HALF + wc * 32 + 8 * fq;
#pragma unroll
        for (int ai = 0; ai < 2; ++ai)
#pragma unroll
            for (int m = 0; m < 4; ++m) {
                float hv[8];
#pragma unroll
                for (int n = 0; n < 2; ++n)
#pragma unroll
                    for (int j = 0; j < 4; ++j) { const float g = acc[ai][0][m][n][j], up = acc[ai][1][m][n][j]; hv[n * 4 + j] = g * __builtin_amdgcn_rcpf(1.f + __expf(-g)) * up; }
                typedef unsigned u32x2 __attribute__((ext_vector_type(2)));
                u32x2 w; w.x = pk4_fp8(hv[0], hv[1], hv[2], hv[3]); w.y = pk4_fp8(hv[4], hv[5], hv[6], hv[7]);
                *(u32x2*)(O + (size_t)(row0 + ai * HALF + m * 16) * 2816 + col0) = w;
            }
    }
};
struct EpiSlots {
    static constexpr bool PERM = true, AFTER_DRAIN = false;
    bf16_t* S; const float* roww;
    __device__ __forceinline__ void operator()(const f32x4 (&acc)[2][2][4][2], const Unit& u, int wr, int wc, int fr, int fq) const {
        const int row0 = u.pm * BM + wr * 64 + fr, col0 = u.pn * BM + wc * 32 + 8 * fq;
#pragma unroll
        for (int ai = 0; ai < 2; ++ai)
#pragma unroll
            for (int m = 0; m < 4; ++m) { const int row = row0 + ai * HALF + m * 16; const float w = roww[row]; bf16_t* rowp = S + (size_t)row * 1024 + col0;
#pragma unroll
                for (int bj = 0; bj < 2; ++bj) { const f32x4 v0 = acc[ai][bj][m][0] * w, v1 = acc[ai][bj][m][1] * w;
                    u32x4 q; q.x = cvt_pk_bf16(v0[0], v0[1]); q.y = cvt_pk_bf16(v0[2], v0[3]); q.z = cvt_pk_bf16(v1[0], v1[1]); q.w = cvt_pk_bf16(v1[2], v1[3]);
                    *(u32x4*)(rowp + bj * HALF) = q; } }
    }
};
struct EpiPartial {
    static constexpr bool PERM = false, AFTER_DRAIN = false;
    float* P; const float* gmod; int goff;
    __device__ __forceinline__ void operator()(const f32x4 (&acc)[2][2][4][2], const Unit& u, int wr, int wc, int fr, int fq) const {
        const int row0 = u.pm * BM + wr * 64 + fr, col0 = u.pn * BM + wc * 32 + 4 * fq;
        f32x4 gv[2][2];
#pragma unroll
        for (int bj = 0; bj < 2; ++bj)
#pragma unroll
            for (int n = 0; n < 2; ++n) gv[bj][n] = *(const f32x4*)(gmod + 4 * 6144 + goff + col0 + bj * HALF + n * 16);
        float* base = P + (size_t)u.ks * 1024 * 1024;
#pragma unroll
        for (int ai = 0; ai < 2; ++ai)
#pragma unroll
            for (int m = 0; m < 4; ++m) { float* rowp = base + (size_t)(row0 + ai * HALF + m * 16) * 1024 + col0;
#pragma unroll
                for (int bj = 0; bj < 2; ++bj)
#pragma unroll
                    for (int n = 0; n < 2; ++n) *(f32x4*)(rowp + bj * HALF + n * 16) = gv[bj][n] * acc[ai][bj][m][n]; }
    }
};
struct SplitOrder {
    int nS, G, c;
    __device__ void init(int nS_, int G_, int c_) { nS = nS_; G = G_; c = c_; }
    __device__ bool next(int i, Unit& u) const { const int L = i * G + c; if (L >= 16 * nS) return false; u.ks = L % nS; const int t = L / nS; u.pm = t >> 2; u.pn = t & 3; return true; }
    __device__ __forceinline__ void a_ready(const Unit&) const {}
    __device__ __forceinline__ void done(const Unit&) const {}
    __device__ __forceinline__ const bf16_t* bt(const Gemm& g, const Unit&) const { return g.Bt; }
};
struct MoeOrder {
    StaticOrder so; const int* tile_e; size_t estride;
    __device__ void init(int T, int N, int G, int c, const int* te, size_t es) { so.init(T * BM, N, G, c); tile_e = te; estride = es; }
    __device__ bool next(int i, Unit& u) const { return so.next(i, u); }
    __device__ __forceinline__ void a_ready(const Unit&) const {}
    __device__ __forceinline__ void done(const Unit&) const {}
    __device__ __forceinline__ const bf16_t* bt(const Gemm& g, const Unit& u) const { const int e = __builtin_amdgcn_readfirstlane(tile_e[u.pm]); return g.Bt + (size_t)e * estride; }
};
}

struct Ctx {
    LAS unsigned char* lds;
    int tid, lane, wave, G, bx, gw, NGW, gtid, NT;
    unsigned char* ws;
    const float* in[21];
};
#define WSP(T, off) ((T*)(C.ws + (off)))

template <bool ILV>
__device__ __forceinline__ void transpose_item(const float* W, int K, int N, bf16* WT, LAS float* scr, int item, int lane) {
    const int nblk = N / 32, kb = item / nblk, nb = item % nblk, k0 = 64 * kb, n0 = 32 * nb;
    int drow = n0;
    if (ILV) drow = (n0 < DFF) ? (n0 / 128) * 256 + (n0 % 128) : ((n0 - DFF) / 128) * 256 + 128 + ((n0 - DFF) % 128);
#pragma unroll 8
    for (int i = 0; i < 32; ++i) { const int kk = 2 * i + (lane >> 5); scr[kk * 33 + (lane & 31)] = __builtin_nontemporal_load(&W[(size_t)(k0 + kk) * N + n0 + (lane & 31)]); }
    LDS_WAIT(); asm volatile("" ::: "memory");
    const int c = lane & 7;
#pragma unroll
    for (int j = 0; j < 4; ++j) { const int n = (lane >> 3) + 8 * j; const LAS float* s = scr + (8 * c) * 33 + n;
        v4u o; o.x = pk2(s[0 * 33], s[1 * 33]); o.y = pk2(s[2 * 33], s[3 * 33]); o.z = pk2(s[4 * 33], s[5 * 33]); o.w = pk2(s[6 * 33], s[7 * 33]);
        *(v4u*)(WT + (size_t)(drow + n) * K + k0 + 8 * c) = o; }
    LDS_WAIT(); asm volatile("" ::: "memory");
}
template <bool ILV>
__device__ __forceinline__ void transpose_item_f8(const float* W, int K, int N, unsigned char* WT, LAS float* scr, int item, int lane) {
    const int nblk = N / 32, kb = item / nblk, nb = item % nblk, k0 = 64 * kb, n0 = 32 * nb;
    int drow = n0;
    if (ILV) drow = (n0 < DFF) ? (n0 / 128) * 256 + (n0 % 128) : ((n0 - DFF) / 128) * 256 + 128 + ((n0 - DFF) % 128);
#pragma unroll 8
    for (int i = 0; i < 32; ++i) { const int kk = 2 * i + (lane >> 5); scr[kk * 33 + (lane & 31)] = __builtin_nontemporal_load(&W[(size_t)(k0 + kk) * N + n0 + (lane & 31)]); }
    LDS_WAIT(); asm volatile("" ::: "memory");
    const int c = lane & 7;
#pragma unroll
    for (int j = 0; j < 4; ++j) { const int n = (lane >> 3) + 8 * j; const LAS float* s = scr + (8 * c) * 33 + n;
        v2u o; o.x = pg8::pk4_fp8(s[0 * 33] * 64.f, s[1 * 33] * 64.f, s[2 * 33] * 64.f, s[3 * 33] * 64.f); o.y = pg8::pk4_fp8(s[4 * 33] * 64.f, s[5 * 33] * 64.f, s[6 * 33] * 64.f, s[7 * 33] * 64.f);
        *(v2u*)(WT + (size_t)(drow + n) * K + k0 + 8 * c) = o; }
    LDS_WAIT(); asm volatile("" ::: "memory");
}
struct ItemDesc { const float* W; unsigned char* WT; int K, N, k0, n0, drow, f8; };
__device__ __forceinline__ ItemDesc item_desc(const Ctx& C, int it) {
    const float* w_in = C.in[8]; const float* w_out = C.in[9]; const float* ffn_in = C.in[14]; const float* ffn_out = C.in[15]; const float* moe_in = C.in[18]; const float* moe_out = C.in[19];
    constexpr int I_WIN = 16 * (NPROJ / 32), I_WOUT = 16 * 32, I_FIN = 16 * (2 * DFF / 32), I_FOUT = (DFF / 64) * 32;
    ItemDesc d; int r = it, item, ilv = 0; d.f8 = 0;
    if (r < 2 * I_WIN) { const int l = r / I_WIN; d.W = w_in + (size_t)l * D * NPROJ; d.K = D; d.N = NPROJ; d.WT = (unsigned char*)(WSP(bf16, WS_WIN) + (size_t)l * NPROJP * D); item = r % I_WIN; }
    else if ((r -= 2 * I_WIN) < 2 * I_WOUT) { const int l = r / I_WOUT; d.W = w_out + (size_t)l * D * D; d.K = D; d.N = D; d.WT = (unsigned char*)(WSP(bf16, WS_WOUT) + (size_t)l * D * D); item = r % I_WOUT; }
    else if ((r -= 2 * I_WOUT) < I_FIN) { d.W = ffn_in; d.K = D; d.N = 2 * DFF; d.WT = (unsigned char*)WSP(bf16, WS_FIN); item = r; ilv = 1; }
    else if ((r -= I_FIN) < I_FOUT) { d.W = ffn_out; d.K = DFF; d.N = D; d.WT = (unsigned char*)WSP(bf16, WS_FOUT); item = r; }
    else if ((r -= I_FOUT) < NE * I_FIN) { const int e = r / I_FIN; d.W = moe_in + (size_t)e * D * 2 * DFF; d.K = D; d.N = 2 * DFF; d.WT = WSP(unsigned char, WS_MIN) + (size_t)e * 2 * DFF * D; item = r % I_FIN; ilv = 1; d.f8 = 1; }
    else { r -= NE * I_FIN; const int e = r / I_FOUT; d.W = moe_out + (size_t)e * DFF * D; d.K = DFF; d.N = D; d.WT = WSP(unsigned char, WS_MOUT) + (size_t)e * D * DFF; item = r % I_FOUT; d.f8 = 1; }
    const int nblk = d.N / 32, kb = item / nblk, nb = item % nblk; d.k0 = 64 * kb; d.n0 = 32 * nb;
    d.drow = ilv ? ((d.n0 < DFF) ? (d.n0 / 128) * 256 + (d.n0 % 128) : ((d.n0 - DFF) / 128) * 256 + 128 + ((d.n0 - DFF) % 128)) : d.n0;
    return d;
}
__device__ __forceinline__ void item_load(const ItemDesc& d, int lane, float (&v)[32]) {
    const float* p = d.W + (size_t)(d.k0 + (lane >> 5)) * d.N + d.n0 + (lane & 31);
#pragma unroll
    for (int i = 0; i < 32; ++i) v[i] = __builtin_nontemporal_load(p + (size_t)(2 * i) * d.N);
}
__device__ __forceinline__ void item_finish(const ItemDesc& d, int lane, LAS float* scr, const float (&v)[32]) {
#pragma unroll
    for (int i = 0; i < 32; ++i) scr[(2 * i + (lane >> 5)) * 33 + (lane & 31)] = v[i];
    LDS_WAIT(); asm volatile("" ::: "memory");
    const int c = lane & 7;
    if (d.f8) {
#pragma unroll
        for (int j = 0; j < 4; ++j) { const int n = (lane >> 3) + 8 * j; const LAS float* s = scr + (8 * c) * 33 + n;
            v2u o; o.x = pg8::pk4_fp8(s[0 * 33] * 64.f, s[1 * 33] * 64.f, s[2 * 33] * 64.f, s[3 * 33] * 64.f); o.y = pg8::pk4_fp8(s[4 * 33] * 64.f, s[5 * 33] * 64.f, s[6 * 33] * 64.f, s[7 * 33] * 64.f);
            *(v2u*)(d.WT + (size_t)(d.drow + n) * d.K + d.k0 + 8 * c) = o; }
    } else {
#pragma unroll
        for (int j = 0; j < 4; ++j) { const int n = (lane >> 3) + 8 * j; const LAS float* s = scr + (8 * c) * 33 + n;
            v4u o; o.x = pk2(s[0 * 33], s[1 * 33]); o.y = pk2(s[2 * 33], s[3 * 33]); o.z = pk2(s[4 * 33], s[5 * 33]); o.w = pk2(s[6 * 33], s[7 * 33]);
            *(v4u*)((bf16*)d.WT + (size_t)(d.drow + n) * d.K + d.k0 + 8 * c) = o; }
    }
    LDS_WAIT(); asm volatile("" ::: "memory");
}
__device__ __forceinline__ void p_prologue(const Ctx& C) {
    const float* cvec = C.in[1]; const float* cctx = C.in[3]; const float* ada_w = C.in[4]; const float* ada_b = C.in[5];
    for (int task = C.G - 1 - C.bx; task < 48; task += C.G) {
        const int layer = task / 24, cg = task % 24, col = 256 * cg + 4 * C.lane;
        LAS float* stab = (LAS float*)(C.lds + RING_OFF + 49152);
        __syncthreads();
        for (int i = C.tid; i < 5 * D; i += NTHR) { const int r = i >> 10, k = i & 1023; stab[i] = siluf((r < 4) ? cvec[r * D + k] : cctx[k]); }
        __syncthreads();
        f32x4 acc[5];
#pragma unroll
        for (int r = 0; r < 5; ++r) acc[r] = (f32x4){0.f, 0.f, 0.f, 0.f};
#pragma unroll 16
        for (int kk = 0; kk < 128; ++kk) {
            const int k = 128 * C.wave + kk;
            const f32x4 w = __builtin_nontemporal_load((const f32x4*)(ada_w + ((size_t)layer * D + k) * 6144 + col));
#pragma unroll
            for (int r = 0; r < 5; ++r) acc[r] = acc[r] + w * stab[r * D + k];
        }
        __syncthreads();
        LAS float* red = (LAS float*)(C.lds + RING_OFF);
#pragma unroll
        for (int r = 0; r < 5; ++r) *(LAS f32x4*)(red + (C.wave * 5 + r) * 256 + 4 * C.lane) = acc[r];
        __syncthreads();
        for (int o = C.tid; o < 5 * 256; o += NTHR) {
            const int r = o >> 8, cc = o & 255;
            float s = ada_b[layer * 6144 + 256 * cg + cc];
#pragma unroll
            for (int w = 0; w < 8; ++w) s += red[(w * 5 + r) * 256 + cc];
            WSP(float, WS_MOD)[(layer * 5 + r) * 6144 + 256 * cg + cc] = s;
        }
        __syncthreads();
    }
    LAS float* scr = (LAS float*)(C.lds + RING_OFF + C.wave * 16384);
    constexpr int NITEMS = 2 * (16 * (NPROJ / 32)) + 2 * (16 * 32) + 16 * (2 * DFF / 32) + (DFF / 64) * 32 + NE * (16 * (2 * DFF / 32) + (DFF / 64) * 32);
    {
        float va[32], vb[32];
        const int nmod = (C.G > 96) ? 48 : 0, first_mod = C.G - nmod;
        const int vw = (C.bx < first_mod) ? C.gw : ((C.wave < 6) ? first_mod * NWAVES + (C.bx - first_mod) * 6 + C.wave : NITEMS), nvw = first_mod * NWAVES + nmod * 6;
        int it0 = vw;
        if (it0 < NITEMS) {
            ItemDesc d0 = item_desc(C, it0), d1 = d0; item_load(d0, C.lane, va);
            for (;;) {
                const int it1 = it0 + nvw; const bool h1 = it1 < NITEMS;
                if (h1) { d1 = item_desc(C, it1); item_load(d1, C.lane, vb); }
                item_finish(d0, C.lane, scr, va);
                if (!h1) break;
                it0 = it1 + nvw; const bool h0 = it0 < NITEMS;
                if (h0) { d0 = item_desc(C, it0); item_load(d0, C.lane, va); }
                item_finish(d1, C.lane, scr, vb);
                if (!h0) break;
            }
        }
    }
    for (int idx = C.gtid; idx < 1024; idx += C.NT) {
        const int pos = idx >> 4, i = idx & 15;
        const float inv = powf(10000.0f, -(float)i / 16.0f), ang = (float)pos * inv;
        WSP(float, WS_ROPE)[idx] = cosf(ang); WSP(float, WS_ROPE)[1024 + idx] = sinf(ang);
    }
}
template <int NP>
__device__ __forceinline__ void norm_row(const float* hrow, const float* gvec, const float* sh, const float* sc, bf16* orow, int lane, f32x4 (&a)[4], const float* prow = nullptr, float* hout = nullptr) {
    float ss = 0.f;
#pragma unroll
    for (int j = 0; j < 4; ++j) { a[j] = *(const f32x4*)(hrow + 4 * lane + 256 * j);
        if (NP > 0) {
#pragma unroll
            for (int p = 0; p < NP; ++p) a[j] = a[j] + *(const f32x4*)(prow + (size_t)p * 1024 * 1024 + 4 * lane + 256 * j);
            if (hout) *(f32x4*)(hout + 4 * lane + 256 * j) = a[j]; }
        ss += (a[j].x * a[j].x + a[j].y * a[j].y) + (a[j].z * a[j].z + a[j].w * a[j].w); }
    const float rstd = 1.0f / sqrtf(wave_sum(ss) * (1.0f / D) + EPS);
#pragma unroll
    for (int j = 0; j < 4; ++j) {
        const int c = 4 * lane + 256 * j;
        const f32x4 g = *(const f32x4*)(gvec + c), s1 = *(const f32x4*)(sc + c), s0 = *(const f32x4*)(sh + c);
        a[j] = (a[j] * rstd * g) * (s1 + 1.0f) + s0;
        v2u o; o.x = pk2(a[j].x, a[j].y); o.y = pk2(a[j].z, a[j].w);
        *(v2u*)(orow + c) = o;
    }
}
template <bool ROUTER, int NPC>
__device__ __forceinline__ void p_norm(const Ctx& C, int layer, int which, bool do_ctx, bool from_input, bool ctx_from_input, bool ctx_write_h) {
    const float* gvec = (which ? C.in[7] : C.in[6]) + layer * D;
    const float* mod = WSP(float, WS_MOD) + layer * 30720;
    const int o_sh = which ? 3 * D : 0, o_sc = which ? 4 * D : D;
    f32x4 rwr[4][4][2]; float rbr[8];
    if (ROUTER) { const float* rw = C.in[16]; const float* rb = C.in[17];
#pragma unroll
        for (int jj = 0; jj < 4; ++jj)
#pragma unroll
            for (int i = 0; i < 4; ++i) { const int k = 4 * C.lane + 256 * jj + i; rwr[jj][i][0] = *(const f32x4*)(rw + k * 8); rwr[jj][i][1] = *(const f32x4*)(rw + k * 8 + 4); }
#pragma unroll
        for (int e = 0; e < 8; ++e) rbr[e] = rb[e]; }
    LAS int* lcnt = (LAS int*)(C.lds + RING_OFF);
    for (int blk = C.bx; blk < 256; blk += C.G) {
        if (ROUTER) { if (C.tid < 8) lcnt[C.tid] = 0; __syncthreads(); }
        for (int j = 0; j < 8; ++j) {
            const int m = 64 * blk + 8 * C.wave + j, b = m >> 12;
            f32x4 a[4];
            norm_row<0>((from_input ? C.in[0] : WSP(float, WS_H)) + (size_t)m * D, gvec, mod + b * 6144 + o_sh, mod + b * 6144 + o_sc, WSP(bf16, WS_A) + (size_t)m * D, C.lane, a);
            if (ROUTER) {
                float lg[8];
#pragma unroll
                for (int e = 0; e < 8; ++e) lg[e] = 0.f;
#pragma unroll
                for (int jj = 0; jj < 4; ++jj)
#pragma unroll
                    for (int i = 0; i < 4; ++i) {
                        const float av = a[jj][i]; const f32x4 w0 = rwr[jj][i][0], w1 = rwr[jj][i][1];
                        lg[0] += av * w0.x; lg[1] += av * w0.y; lg[2] += av * w0.z; lg[3] += av * w0.w;
                        lg[4] += av * w1.x; lg[5] += av * w1.y; lg[6] += av * w1.z; lg[7] += av * w1.w;
                    }
                float r4[4], r2[2], r1;
#pragma unroll
                for (int e = 0; e < 4; ++e) { const bool hi = (C.lane & 1) != 0; const float keep = hi ? lg[e + 4] : lg[e], send = hi ? lg[e] : lg[e + 4]; r4[e] = keep + __shfl_xor(send, 1); }
#pragma unroll
                for (int e = 0; e < 2; ++e) { const bool hi = (C.lane & 2) != 0; const float keep = hi ? r4[e + 2] : r4[e], send = hi ? r4[e] : r4[e + 2]; r2[e] = keep + __shfl_xor(send, 2); }
                { const bool hi = (C.lane & 4) != 0; const float keep = hi ? r2[1] : r2[0], send = hi ? r2[0] : r2[1]; r1 = keep + __shfl_xor(send, 4); }
                r1 += __shfl_xor(r1, 8); r1 += __shfl_xor(r1, 16); r1 += __shfl_xor(r1, 32);
#pragma unroll
                for (int e = 0; e < 8; ++e) { const int src = ((e >> 2) & 1) | (((e >> 1) & 1) << 1) | ((e & 1) << 2); lg[e] = __shfl(r1, src) + rbr[e]; }
                int e1 = 0; float v1 = lg[0];
#pragma unroll
                for (int e = 1; e < 8; ++e) if (lg[e] > v1) { v1 = lg[e]; e1 = e; }
                int e2 = -1; float v2 = -3.0e38f;
#pragma unroll
                for (int e = 0; e < 8; ++e) if (e != e1 && lg[e] > v2) { v2 = lg[e]; e2 = e; }
                const float ex = __expf(v2 - v1), w1v = 1.0f / (1.0f + ex), w2v = ex * w1v;
                if (C.lane == 0) {
                    WSP(int, WS_TOKE)[m] = e1 | (e2 << 8);
                    WSP(float, WS_TOKW)[2 * m] = w1v; WSP(float, WS_TOKW)[2 * m + 1] = w2v;
                    atomicAdd((int*)(lcnt + e1), 1); atomicAdd((int*)(lcnt + e2), 1);
                }
            }
        }
        if (ROUTER) { __syncthreads(); if (C.tid < 8) WSP(int, WS_CNT)[blk * 8 + C.tid] = lcnt[C.tid]; __syncthreads(); }
    }
    if (do_ctx) {
        for (int cm = C.gw; cm < RCTX; cm += C.NGW) {
            const int m = RLAT + cm; f32x4 a[4];
            norm_row<NPC>(ctx_from_input ? C.in[2] + (size_t)cm * D : WSP(float, WS_H) + (size_t)m * D, gvec, mod + 4 * 6144 + o_sh, mod + 4 * 6144 + o_sc, WSP(bf16, WS_A) + (size_t)m * D, C.lane, a, WSP(float, WS_PART) + (size_t)cm * D, ctx_write_h ? WSP(float, WS_H) + (size_t)m * D : nullptr);
        }
    }
}
typedef short bf16x8 __attribute__((ext_vector_type(8)));
constexpr float LOG2E = 1.4426950408889634f;
constexpr int VTL_STRIDE = 1040, VTC_STRIDE = 528;
constexpr int NA_VTL = 0, NA_VTC = 64 * VTL_STRIDE, NA_RPB = NA_VTC + 64 * VTC_STRIDE, NA_XCH = 102400;
static_assert(NA_RPB + 465 * 4 <= NA_XCH && NA_XCH + 4 * 64 * 18 * 4 <= RING_BYTES, "NA LDS map");
__device__ __forceinline__ unsigned cvtpk(float lo, float hi) { unsigned r; asm volatile("v_cvt_pk_bf16_f32 %0, %1, %2" : "=v"(r) : "v"(lo), "v"(hi)); return r; }

template <bool LOCAL, int NT, int KT0 = 0, int KT1 = NT>
__device__ __forceinline__ void load_kfrags(bf16x8 (&kf)[NT][2], const bf16* Kbase, int krow0, int lane) {
    const int n = lane & 15, g = lane >> 4;
#pragma unroll
    for (int kt = KT0; kt < KT1; ++kt) {
        const int krow = LOCAL ? krow0 + (kt >> 1) * 64 + (kt & 1) * 16 + n : krow0 + 16 * kt + n;
        const bf16x8* kp = (const bf16x8*)(Kbase + (size_t)krow * NPROJP + 8 * g);
        kf[kt][0] = kp[0]; kf[kt][1] = kp[4];
    }
}
template <bool LOCAL, int NT>
__device__ __forceinline__ void attn_wave_core(const bf16x8 (&kfA)[8][2], const bf16* Kbase, int krow0, const bf16x8 (&qf)[2], LAS const unsigned char* vt, int vstride,
                                               LAS const float* rpb, int r, int r0, int qc, int cbase, float& m_out, float& l_out, f32x4 (&o)[4], int lane) {
    const int n = lane & 15, g = lane >> 4;
    f32x4 s[NT];
#pragma unroll
    for (int kt = 0; kt < 8; ++kt) {
        f32x4 acc = {0.f, 0.f, 0.f, 0.f};
        acc = __builtin_amdgcn_mfma_f32_16x16x32_bf16(kfA[kt][0], qf[0], acc, 0, 0, 0);
        acc = __builtin_amdgcn_mfma_f32_16x16x32_bf16(kfA[kt][1], qf[1], acc, 0, 0, 0);
        s[kt] = acc;
    }
    if constexpr (NT > 8) {
        __builtin_amdgcn_sched_barrier(0);
        bf16x8 kfB[NT][2];
        load_kfrags<LOCAL, NT, 8, NT>(kfB, Kbase, krow0, lane);
#pragma unroll
        for (int kt = 8; kt < NT; ++kt) {
            f32x4 acc = {0.f, 0.f, 0.f, 0.f};
            acc = __builtin_amdgcn_mfma_f32_16x16x32_bf16(kfB[kt][0], qf[0], acc, 0, 0, 0);
            acc = __builtin_amdgcn_mfma_f32_16x16x32_bf16(kfB[kt][1], qf[1], acc, 0, 0, 0);
            s[kt] = acc;
        }
        __builtin_amdgcn_sched_barrier(0);
    }
    const float SC = 0.125f * LOG2E;
    const int c0 = min(max(qc - 8, 0), 48);
    float mx = -1.0e30f;
#pragma unroll
    for (int kt = 0; kt < NT; ++kt)
#pragma unroll
        for (int reg = 0; reg < 4; ++reg) {
            float v = s[kt][reg] * SC;
            if (LOCAL) {
                const int i = kt >> 1, kc = cbase + 16 * (kt & 1) + 4 * g + reg;
                const int dr = r0 + i - r + 7, dc = min(max(kc - qc, -15), 15) + 15;
                const float bias = rpb[dr * 31 + dc];
                v = (kc >= c0 && kc < c0 + 16) ? v + bias : -1.0e30f;
            }
            s[kt][reg] = v; mx = fmaxf(mx, v);
        }
    mx = fmaxf(mx, __shfl_xor(mx, 16)); mx = fmaxf(mx, __shfl_xor(mx, 32));
    float l = 0.f;
#pragma unroll
    for (int kt = 0; kt < NT; ++kt)
#pragma unroll
        for (int reg = 0; reg < 4; ++reg) { const float p = __builtin_amdgcn_exp2f(s[kt][reg] - mx); s[kt][reg] = p; l += p; }
    l += __shfl_xor(l, 16); l += __shfl_xor(l, 32);
#pragma unroll
    for (int dt = 0; dt < 4; ++dt) o[dt] = (f32x4){0.f, 0.f, 0.f, 0.f};
#pragma unroll
    for (int u = 0; u < NT / 2; ++u) {
        v4u pw; pw.x = cvtpk(s[2 * u][0], s[2 * u][1]); pw.y = cvtpk(s[2 * u][2], s[2 * u][3]); pw.z = cvtpk(s[2 * u + 1][0], s[2 * u + 1][1]); pw.w = cvtpk(s[2 * u + 1][2], s[2 * u + 1][3]);
        const bf16x8 pb = __builtin_bit_cast(bf16x8, pw);
        const int slotA = LOCAL ? ((r0 + u) & 7) * 64 + cbase + 4 * g : 32 * u + 4 * g, slotB = slotA + 16;
#pragma unroll
        for (int dt = 0; dt < 4; ++dt) {
            LAS const unsigned char* rowp = vt + (16 * dt + n) * vstride;
            const v2u a_lo = *(LAS const v2u*)(rowp + slotA * 2), a_hi = *(LAS const v2u*)(rowp + slotB * 2);
            v4u aw; aw.x = a_lo.x; aw.y = a_lo.y; aw.z = a_hi.x; aw.w = a_hi.y;
            o[dt] = __builtin_amdgcn_mfma_f32_16x16x32_bf16(__builtin_bit_cast(bf16x8, aw), pb, o[dt], 0, 0, 0);
        }
    }
    m_out = mx; l_out = l;
}
__device__ __forceinline__ void attn_wave_mixed(const bf16x8 (&kfA)[8][2], const bf16* Kbase, int kcrow0, const bf16x8 (&qf)[2], LAS const unsigned char* vtl, LAS const unsigned char* vtc,
                                                LAS const float* rpb, int part, int r, int r0, int qc, int cbase, float& m_out, float& l_out, f32x4 (&o)[4], int lane) {
    const int n = lane & 15, g = lane >> 4;
    f32x4 s[16];
#pragma unroll
    for (int kt = 0; kt < 8; ++kt) {
        f32x4 acc = {0.f, 0.f, 0.f, 0.f};
        acc = __builtin_amdgcn_mfma_f32_16x16x32_bf16(kfA[kt][0], qf[0], acc, 0, 0, 0);
        acc = __builtin_amdgcn_mfma_f32_16x16x32_bf16(kfA[kt][1], qf[1], acc, 0, 0, 0);
        s[kt] = acc;
    }
    __builtin_amdgcn_sched_barrier(0);
    {
        bf16x8 kfB[8][2];
        load_kfrags<false, 8>(kfB, Kbase, kcrow0, lane);
#pragma unroll
        for (int kt = 0; kt < 8; ++kt) {
            f32x4 acc = {0.f, 0.f, 0.f, 0.f};
            acc = __builtin_amdgcn_mfma_f32_16x16x32_bf16(kfB[kt][0], qf[0], acc, 0, 0, 0);
            acc = __builtin_amdgcn_mfma_f32_16x16x32_bf16(kfB[kt][1], qf[1], acc, 0, 0, 0);
            s[8 + kt] = acc;
        }
    }
    __builtin_amdgcn_sched_barrier(0);
    const float SC = 0.125f * LOG2E;
    const int c0 = min(max(qc - 8, 0), 48);
    float mx = -1.0e30f;
#pragma unroll
    for (int kt = 0; kt < 16; ++kt)
#pragma unroll
        for (int reg = 0; reg < 4; ++reg) {
            float v = s[kt][reg] * SC;
            if (kt < 8) {
                const int i = 4 * part + (kt >> 1), kc = cbase + 16 * (kt & 1) + 4 * g + reg;
                const int dr = r0 + i - r + 7, dc = min(max(kc - qc, -15), 15) + 15;
                const float bias = rpb[dr * 31 + dc];
                v = (kc >= c0 && kc < c0 + 16) ? v + bias : -1.0e30f;
            }
            s[kt][reg] = v; mx = fmaxf(mx, v);
        }
    mx = fmaxf(mx, __shfl_xor(mx, 16)); mx = fmaxf(mx, __shfl_xor(mx, 32));
    float l = 0.f;
#pragma unroll
    for (int kt = 0; kt < 16; ++kt)
#pragma unroll
        for (int reg = 0; reg < 4; ++reg) { const float p = __builtin_amdgcn_exp2f(s[kt][reg] - mx); s[kt][reg] = p; l += p; }
    l += __shfl_xor(l, 16); l += __shfl_xor(l, 32);
#pragma unroll
    for (int dt = 0; dt < 4; ++dt) o[dt] = (f32x4){0.f, 0.f, 0.f, 0.f};
#pragma unroll
    for (int u = 0; u < 8; ++u) {
        v4u pw; pw.x = cvtpk(s[2 * u][0], s[2 * u][1]); pw.y = cvtpk(s[2 * u][2], s[2 * u][3]); pw.z = cvtpk(s[2 * u + 1][0], s[2 * u + 1][1]); pw.w = cvtpk(s[2 * u + 1][2], s[2 * u + 1][3]);
        const bf16x8 pb = __builtin_bit_cast(bf16x8, pw);
        const bool loc = (u < 4);
        const int slotA = loc ? ((r0 + 4 * part + u) & 7) * 64 + cbase + 4 * g : 128 * part + 32 * (u - 4) + 4 * g, slotB = slotA + 16;
        LAS const unsigned char* vt = loc ? vtl : vtc; const int vstride = loc ? VTL_STRIDE : VTC_STRIDE;
#pragma unroll
        for (int dt = 0; dt < 4; ++dt) {
            LAS const unsigned char* rowp = vt + (16 * dt + n) * vstride;
            const v2u a_lo = *(LAS const v2u*)(rowp + slotA * 2), a_hi = *(LAS const v2u*)(rowp + slotB * 2);
            v4u aw; aw.x = a_lo.x; aw.y = a_lo.y; aw.z = a_hi.x; aw.w = a_hi.y;
            o[dt] = __builtin_amdgcn_mfma_f32_16x16x32_bf16(__builtin_bit_cast(bf16x8, aw), pb, o[dt], 0, 0, 0);
        }
    }
    m_out = mx; l_out = l;
}
template <int NCH>
__device__ __forceinline__ void vt_scatter(const bf16* vrow, int ch0, LAS unsigned char* vt, int vstride, int slot) {
    v4u x[NCH];
#pragma unroll
    for (int c = 0; c < NCH; ++c) x[c] = *(const v4u*)(vrow + 8 * (ch0 + c));
#pragma unroll
    for (int c = 0; c < NCH; ++c) {
        LAS unsigned char* p = vt + (8 * (ch0 + c)) * vstride + slot * 2;
        *(LAS unsigned short*)(p) = (unsigned short)(x[c].x & 0xffffu); *(LAS unsigned short*)(p + vstride) = (unsigned short)(x[c].x >> 16);
        *(LAS unsigned short*)(p + 2 * vstride) = (unsigned short)(x[c].y & 0xffffu); *(LAS unsigned short*)(p + 3 * vstride) = (unsigned short)(x[c].y >> 16);
        *(LAS unsigned short*)(p + 4 * vstride) = (unsigned short)(x[c].z & 0xffffu); *(LAS unsigned short*)(p + 5 * vstride) = (unsigned short)(x[c].z >> 16);
        *(LAS unsigned short*)(p + 6 * vstride) = (unsigned short)(x[c].w & 0xffffu); *(LAS unsigned short*)(p + 7 * vstride) = (unsigned short)(x[c].w >> 16);
    }
}
__device__ __forceinline__ void attn_merge_store(const Ctx& C, int part, int qb, float m, float l, f32x4 (&o)[4], int qrow0, int h) {
    LAS float* xch = (LAS float*)(C.lds + RING_OFF + NA_XCH) + (qb * 64 + C.lane) * 18;
    if (part == 1) {
        xch[0] = m; xch[1] = l;
#pragma unroll
        for (int dt = 0; dt < 4; ++dt) *(LAS f32x4*)(xch + 2 + 4 * dt) = o[dt];
    }
    __syncthreads();
    if (part == 0) {
        const float m2 = xch[0], l2 = xch[1];
        const float mt = fmaxf(m, m2), f1 = __builtin_amdgcn_exp2f(m - mt), f2 = __builtin_amdgcn_exp2f(m2 - mt);
        const float inv = 1.0f / (l * f1 + l2 * f2);
        const int n = C.lane & 15, g = C.lane >> 4;
        bf16* yp = WSP(bf16, WS_YMIX) + (size_t)(qrow0 + n) * D + 640 + 64 * h + 4 * g;
#pragma unroll
        for (int dt = 0; dt < 4; ++dt) {
            const f32x4 o2 = *(LAS f32x4*)(xch + 2 + 4 * dt);
            const f32x4 v = (o[dt] * f1 + o2 * f2) * inv;
            v2u w; w.x = cvtpk(v[0], v[1]); w.y = cvtpk(v[2], v[3]);
            *(v2u*)(yp + 16 * dt) = w;
        }
    }
}
__device__ __forceinline__ void na_band(const Ctx& C, int layer, int u0, int nu) {
    const bf16* PROJ = WSP(bf16, WS_PROJ);
    LAS unsigned char* vtl = C.lds + RING_OFF + NA_VTL; LAS unsigned char* vtc = C.lds + RING_OFF + NA_VTC; LAS float* rpb = (LAS float*)(C.lds + RING_OFF + NA_RPB);
    const int qb = C.wave & 3, part = C.wave >> 2, n = C.lane & 15, g = C.lane >> 4;
    const int cbase = (qb == 0) ? 0 : (qb == 1) ? 8 : (qb == 2) ? 24 : 32;
    int cur_bh = -1, have_hi = 0;
    for (int uu = 0; uu < nu; ++uu) {
        const int u = u0 + uu, bh = u >> 6, r = u & 63, b = bh / 6, h = bh % 6;
        const int r0 = min(max(r - 4, 0), 56);
        const int qrow0 = b * SEQ + r * 64 + 16 * qb;
        bf16x8 qf[2];
        { const bf16x8* qp = (const bf16x8*)(PROJ + (size_t)(qrow0 + n) * NPROJP + C_NQ + 64 * h + 8 * g); qf[0] = qp[0]; qf[1] = qp[4]; }
        bf16x8 kf[8][2];
        load_kfrags<true, 8, 0, 8>(kf, PROJ + C_NK + 64 * h, b * SEQ + (r0 + 4 * part) * 64 + cbase, C.lane);
        const bool newbh = (bh != cur_bh);
        const int lo = newbh ? r0 : max(r0, have_hi);
        const int vkey = C.tid & 63, vch = C.tid >> 6;
        v4u vpre = {0u, 0u, 0u, 0u};
        if (lo < r0 + 8) vpre = *(const v4u*)(PROJ + (size_t)(b * SEQ + (r0 + 7) * 64 + vkey) * NPROJP + C_NV + 64 * h + 8 * vch);
        __syncthreads();
        if (newbh) {
            vt_scatter<4>(PROJ + (size_t)(RLAT + b * CTXL + (C.tid & 255)) * NPROJP + C_NV + 64 * h, 4 * (C.tid >> 8), vtc, VTC_STRIDE, C.tid & 255);
            const float* rp = C.in[13] + (size_t)(layer * 6 + h) * 465; for (int i = C.tid; i < 465; i += NTHR) rpb[i] = rp[i] * LOG2E;
        }
        for (int row = lo; row < r0 + 8; ++row) {
            v4u x = vpre;
            if (row != r0 + 7) x = *(const v4u*)(PROJ + (size_t)(b * SEQ + row * 64 + vkey) * NPROJP + C_NV + 64 * h + 8 * vch);
            LAS unsigned char* p = vtl + (8 * vch) * VTL_STRIDE + ((row & 7) * 64 + vkey) * 2;
            *(LAS unsigned short*)(p) = (unsigned short)(x.x & 0xffffu); *(LAS unsigned short*)(p + VTL_STRIDE) = (unsigned short)(x.x >> 16);
            *(LAS unsigned short*)(p + 2 * VTL_STRIDE) = (unsigned short)(x.y & 0xffffu); *(LAS unsigned short*)(p + 3 * VTL_STRIDE) = (unsigned short)(x.y >> 16);
            *(LAS unsigned short*)(p + 4 * VTL_STRIDE) = (unsigned short)(x.z & 0xffffu); *(LAS unsigned short*)(p + 5 * VTL_STRIDE) = (unsigned short)(x.z >> 16);
            *(LAS unsigned short*)(p + 6 * VTL_STRIDE) = (unsigned short)(x.w & 0xffffu); *(LAS unsigned short*)(p + 7 * VTL_STRIDE) = (unsigned short)(x.w >> 16);
        }
        cur_bh = bh; have_hi = r0 + 8;
        __syncthreads();
        float m, l; f32x4 o[4];
        attn_wave_mixed(kf, PROJ + C_NK + 64 * h, RLAT + b * CTXL + 128 * part, qf, vtl, vtc, rpb, part, r, r0, 16 * qb + n, cbase, m, l, o, C.lane);
        attn_merge_store(C, part, qb, m, l, o, qrow0, h);
    }
}
constexpr int VT2_ROWS = 10, VT2_STRIDE = VT2_ROWS * 64 * 2 + 16;
constexpr int NA2_VTL = 0, NA2_VTC = 64 * VT2_STRIDE, NA2_RPB = NA2_VTC + 64 * VTC_STRIDE;
static_assert(NA2_RPB + (480 + 465) * 4 <= RING_BYTES && (VT2_STRIDE / 4) % 64 == 4, "NA2 LDS map");
template <bool LOCAL>
__device__ __forceinline__ void na2_scores(f32x4 (&s)[16], const bf16x8 (&kfA)[8][2], const bf16* Kbase, int krow0, const bf16x8 (&qf)[2], int lane) {
#pragma unroll
    for (int kt = 0; kt < 8; ++kt) { f32x4 acc = {0.f, 0.f, 0.f, 0.f};
        acc = __builtin_amdgcn_mfma_f32_16x16x32_bf16(kfA[kt][0], qf[0], acc, 0, 0, 0); acc = __builtin_amdgcn_mfma_f32_16x16x32_bf16(kfA[kt][1], qf[1], acc, 0, 0, 0); s[kt] = acc; }
    __builtin_amdgcn_sched_barrier(0);
    bf16x8 kfB[16][2];
    load_kfrags<LOCAL, 16, 8, 16>(kfB, Kbase, krow0, lane);
#pragma unroll
    for (int kt = 8; kt < 16; ++kt) { f32x4 acc = {0.f, 0.f, 0.f, 0.f};
        acc = __builtin_amdgcn_mfma_f32_16x16x32_bf16(kfB[kt][0], qf[0], acc, 0, 0, 0); acc = __builtin_amdgcn_mfma_f32_16x16x32_bf16(kfB[kt][1], qf[1], acc, 0, 0, 0); s[kt] = acc; }
    __builtin_amdgcn_sched_barrier(0);
}
__device__ __forceinline__ void na_band2(const Ctx& C, int layer, int u0, int nu) {
    const bf16* PROJ = WSP(bf16, WS_PROJ);
    LAS unsigned char* vtl = C.lds + RING_OFF + NA2_VTL; LAS unsigned char* vtc = C.lds + RING_OFF + NA2_VTC; LAS float* rpb = (LAS float*)(C.lds + RING_OFF + NA2_RPB);
    const int qb = C.wave & 3, grp = C.wave >> 2, n = C.lane & 15, g = C.lane >> 4;
    const int cbase = (qb == 0) ? 0 : (qb == 1) ? 8 : (qb == 2) ? 24 : 32;
    const float SC = 0.125f * LOG2E;
    int boff[2][4]; float bscl[2][4];
    { const int qc = 16 * qb + n, c0 = min(max(qc - 8, 0), 48);
#pragma unroll
      for (int hh = 0; hh < 2; ++hh)
#pragma unroll
        for (int reg = 0; reg < 4; ++reg) { const int kcol = cbase + 16 * hh + 4 * g + reg; const bool ok = (kcol >= c0) && (kcol < c0 + 16);
            boff[hh][reg] = ok ? (min(max(kcol - qc, -15), 15) + 15) * 4 : 480 * 4; bscl[hh][reg] = ok ? SC : 0.f; } }
    int cur_bh = -1, have_hi = 0;
    for (int uu = 0; uu < nu; uu += 2) {
        const int ua = u0 + uu, bh = ua >> 6, ra = ua & 63, b = bh / 6, h = bh % 6;
        const int r0a = min(max(ra - 4, 0), 56), r0b = min(max(ra + 1 - 4, 0), 56);
        const int r = ra + grp, r0 = grp ? r0b : r0a;
        const int qrow0 = b * SEQ + r * 64 + 16 * qb;
        const bool newbh = (bh != cur_bh);
        const int lo = newbh ? r0a : max(r0a, have_hi), hi = r0b + 8;
        const int vkey = C.tid & 63, vch = C.tid >> 6;
        const v4u vpa = *(const v4u*)(PROJ + (size_t)(b * SEQ + (hi - 2) * 64 + vkey) * NPROJP + C_NV + 64 * h + 8 * vch);
        const v4u vpb = *(const v4u*)(PROJ + (size_t)(b * SEQ + (hi - 1) * 64 + vkey) * NPROJP + C_NV + 64 * h + 8 * vch);
        bf16x8 qf[2];
        { const bf16x8* qp = (const bf16x8*)(PROJ + (size_t)(qrow0 + n) * NPROJP + C_NQ + 64 * h + 8 * g); qf[0] = qp[0]; qf[1] = qp[4]; }
        bf16x8 kf[8][2];
        load_kfrags<true, 8, 0, 8>(kf, PROJ + C_NK + 64 * h, b * SEQ + r0 * 64 + cbase, C.lane);
        __syncthreads();
        if (newbh) {
            vt_scatter<4>(PROJ + (size_t)(RLAT + b * CTXL + (C.tid & 255)) * NPROJP + C_NV + 64 * h, 4 * (C.tid >> 8), vtc, VTC_STRIDE, C.tid & 255);
            const float* rp = C.in[13] + (size_t)(layer * 6 + h) * 465; for (int i = C.tid; i < 465; i += NTHR) rpb[i] = rp[i] * LOG2E;
            for (int i = C.tid; i < 15 * 31; i += NTHR) rpb[480 + i] = -1.0e30f;
        }
        for (int row = lo; row < hi; ++row) {
            v4u x;
            if (row == hi - 2) x = vpa; else if (row == hi - 1) x = vpb; else x = *(const v4u*)(PROJ + (size_t)(b * SEQ + row * 64 + vkey) * NPROJP + C_NV + 64 * h + 8 * vch);
            LAS unsigned char* p = vtl + (8 * vch) * VT2_STRIDE + ((row % VT2_ROWS) * 64 + vkey) * 2;
            *(LAS unsigned short*)(p) = (unsigned short)(x.x & 0xffffu); *(LAS unsigned short*)(p + VT2_STRIDE) = (unsigned short)(x.x >> 16);
            *(LAS unsigned short*)(p + 2 * VT2_STRIDE) = (unsigned short)(x.y & 0xffffu); *(LAS unsigned short*)(p + 3 * VT2_STRIDE) = (unsigned short)(x.y >> 16);
            *(LAS unsigned short*)(p + 4 * VT2_STRIDE) = (unsigned short)(x.z & 0xffffu); *(LAS unsigned short*)(p + 5 * VT2_STRIDE) = (unsigned short)(x.z >> 16);
            *(LAS unsigned short*)(p + 6 * VT2_STRIDE) = (unsigned short)(x.w & 0xffffu); *(LAS unsigned short*)(p + 7 * VT2_STRIDE) = (unsigned short)(x.w >> 16);
        }
        cur_bh = bh; have_hi = hi;
        __syncthreads();
        f32x4 s[16];
        na2_scores<true>(s, kf, PROJ + C_NK + 64 * h, b * SEQ + r0 * 64 + cbase, qf, C.lane);
        bf16x8 kc[8][2];
        load_kfrags<false, 8, 0, 8>(kc, PROJ + C_NK + 64 * h, RLAT + b * CTXL, C.lane);
        float mx = -1.0e30f;
        { LAS const unsigned char* rb = (LAS const unsigned char*)rpb + (r0 - r + 7) * 124;
#pragma unroll
          for (int kt = 0; kt < 16; ++kt)
#pragma unroll
            for (int reg = 0; reg < 4; ++reg) {
                const float bias = *(LAS const float*)(rb + boff[kt & 1][reg] + (kt >> 1) * 124);
                const float v = s[kt][reg] * bscl[kt & 1][reg] + bias;
                s[kt][reg] = v; mx = fmaxf(mx, v);
            } }
        mx = fmaxf(mx, __shfl_xor(mx, 16)); mx = fmaxf(mx, __shfl_xor(mx, 32));
        float l = 0.f;
#pragma unroll
        for (int kt = 0; kt < 16; ++kt)
#pragma unroll
            for (int reg = 0; reg < 4; ++reg) { const float p = __builtin_amdgcn_exp2f(s[kt][reg] - mx); s[kt][reg] = p; l += p; }
        f32x4 o[4];
#pragma unroll
        for (int dt = 0; dt < 4; ++dt) o[dt] = (f32x4){0.f, 0.f, 0.f, 0.f};
#pragma unroll
        for (int u = 0; u < 8; ++u) {
            v4u pw; pw.x = cvtpk(s[2 * u][0], s[2 * u][1]); pw.y = cvtpk(s[2 * u][2], s[2 * u][3]); pw.z = cvtpk(s[2 * u + 1][0], s[2 * u + 1][1]); pw.w = cvtpk(s[2 * u + 1][2], s[2 * u + 1][3]);
            const bf16x8 pb = __builtin_bit_cast(bf16x8, pw);
            const int slotA = ((r0 + u) % VT2_ROWS) * 64 + cbase + 4 * g, slotB = slotA + 16;
#pragma unroll
            for (int dt = 0; dt < 4; ++dt) {
                LAS const unsigned char* rowp = vtl + (16 * dt + n) * VT2_STRIDE;
                const v2u a_lo = *(LAS const v2u*)(rowp + slotA * 2), a_hi = *(LAS const v2u*)(rowp + slotB * 2);
                v4u aw; aw.x = a_lo.x; aw.y = a_lo.y; aw.z = a_hi.x; aw.w = a_hi.y;
                o[dt] = __builtin_amdgcn_mfma_f32_16x16x32_bf16(__builtin_bit_cast(bf16x8, aw), pb, o[dt], 0, 0, 0);
            }
        }
        na2_scores<false>(s, kc, PROJ + C_NK + 64 * h, RLAT + b * CTXL, qf, C.lane);
        float mx2 = -1.0e30f;
#pragma unroll
        for (int kt = 0; kt < 16; ++kt)
#pragma unroll
            for (int reg = 0; reg < 4; ++reg) { const float v = s[kt][reg] * SC; s[kt][reg] = v; mx2 = fmaxf(mx2, v); }
        mx2 = fmaxf(mx2, __shfl_xor(mx2, 16)); mx2 = fmaxf(mx2, __shfl_xor(mx2, 32));
        const float mt = fmaxf(mx, mx2), f1 = __builtin_amdgcn_exp2f(mx - mt);
        l *= f1;
#pragma unroll
        for (int dt = 0; dt < 4; ++dt) o[dt] = o[dt] * f1;
#pragma unroll
        for (int kt = 0; kt < 16; ++kt)
#pragma unroll
            for (int reg = 0; reg < 4; ++reg) { const float p = __builtin_amdgcn_exp2f(s[kt][reg] - mt); s[kt][reg] = p; l += p; }
        l += __shfl_xor(l, 16); l += __shfl_xor(l, 32);
#pragma unroll
        for (int u = 0; u < 8; ++u) {
            v4u pw; pw.x = cvtpk(s[2 * u][0], s[2 * u][1]); pw.y = cvtpk(s[2 * u][2], s[2 * u][3]); pw.z = cvtpk(s[2 * u + 1][0], s[2 * u + 1][1]); pw.w = cvtpk(s[2 * u + 1][2], s[2 * u + 1][3]);
            const bf16x8 pb = __builtin_bit_cast(bf16x8, pw);
            const int slotA = 32 * u + 4 * g, slotB = slotA + 16;
#pragma unroll
            for (int dt = 0; dt < 4; ++dt) {
                LAS const unsigned char* rowp = vtc + (16 * dt + n) * VTC_STRIDE;
                const v2u a_lo = *(LAS const v2u*)(rowp + slotA * 2), a_hi = *(LAS const v2u*)(rowp + slotB * 2);
                v4u aw; aw.x = a_lo.x; aw.y = a_lo.y; aw.z = a_hi.x; aw.w = a_hi.y;
                o[dt] = __builtin_amdgcn_mfma_f32_16x16x32_bf16(__builtin_bit_cast(bf16x8, aw), pb, o[dt], 0, 0, 0);
            }
        }
        const float inv = 1.0f / l;
        bf16* yp = WSP(bf16, WS_YMIX) + (size_t)(qrow0 + n) * D + 640 + 64 * h + 4 * g;
#pragma unroll
        for (int dt = 0; dt < 4; ++dt) { const f32x4 v = o[dt] * inv; v2u w; w.x = cvtpk(v[0], v[1]); w.y = cvtpk(v[2], v[3]); *(v2u*)(yp + 16 * dt) = w; }
    }
    __syncthreads();
}
__device__ __forceinline__ void ctxattn_unit(const Ctx& C, int b, int h, int qblk) {
    const bf16* PROJ = WSP(bf16, WS_PROJ);
    LAS unsigned char* vtc = C.lds + RING_OFF + NA_VTC; LAS float* rpb = (LAS float*)(C.lds + RING_OFF + NA_RPB);
    __syncthreads();
    vt_scatter<4>(PROJ + (size_t)(RLAT + b * CTXL + (C.tid & 255)) * NPROJP + C_NV + 64 * h, 4 * (C.tid >> 8), vtc, VTC_STRIDE, C.tid & 255);
    __syncthreads();
    const int qb = C.wave & 3, part = C.wave >> 2, n = C.lane & 15, g = C.lane >> 4;
    const int qrow0 = RLAT + b * CTXL + 64 * qblk + 16 * qb;
    bf16x8 qf[2];
    { const bf16x8* qp = (const bf16x8*)(PROJ + (size_t)(qrow0 + n) * NPROJP + C_NQ + 64 * h + 8 * g); qf[0] = qp[0]; qf[1] = qp[4]; }
    float m, l; f32x4 o[4];
    bf16x8 kf[8][2];
    load_kfrags<false, 8>(kf, PROJ + C_NK + 64 * h, RLAT + b * CTXL + 128 * part, C.lane);
    attn_wave_core<false, 8>(kf, PROJ + C_NK + 64 * h, RLAT + b * CTXL + 128 * part, qf, vtc + 256 * part, VTC_STRIDE, rpb, 0, 0, 0, 0, m, l, o, C.lane);
    attn_merge_store(C, part, qb, m, l, o, qrow0, h);
}

constexpr size_t WS_UT = WS_OBUF;
constexpr size_t WS_SB = WS_OBUF + 26 * MiB;
constexpr int RT_STRIDE = 272;
__device__ __forceinline__ float logsig(float x) { return -log1pf(expf(-x)); }
__device__ __forceinline__ int ret_row0(int b, int c) { return (c < 2) ? RLAT + b * CTXL + 128 * c : b * SEQ + 128 * (c - 2); }

__device__ __forceinline__ void ret_a_unit(const Ctx& C, int layer, int b, int h, int c) {
    const bf16* PROJ = WSP(bf16, WS_PROJ);
    LAS unsigned char* kt = C.lds + RING_OFF; LAS unsigned char* vft = kt + 64 * RT_STRIDE; LAS unsigned char* vbt = vft + 64 * RT_STRIDE;
    const float lgf = logsig(C.in[10][(layer * 2 + 0) * 6 + h]), lgb = logsig(C.in[10][(layer * 2 + 1) * 6 + h]);
    const int row0 = ret_row0(b, c);
    __syncthreads();
    {
        const int j = C.tid & 127, q4 = C.tid >> 7;
        const bf16* pr = PROJ + (size_t)(row0 + j) * NPROJP + 64 * h + 16 * q4;
        const v4u k0 = *(const v4u*)(pr + C_RK), k1 = *(const v4u*)(pr + C_RK + 8), v0 = *(const v4u*)(pr + C_RV), v1 = *(const v4u*)(pr + C_RV + 8);
        const float wf = expf(lgf * (float)(127 - j)), wb = expf(lgb * (float)j);
        const unsigned kw[8] = {k0.x, k0.y, k0.z, k0.w, k1.x, k1.y, k1.z, k1.w}, vw[8] = {v0.x, v0.y, v0.z, v0.w, v1.x, v1.y, v1.z, v1.w};
#pragma unroll
        for (int i = 0; i < 8; ++i) {
            const int d = 16 * q4 + 2 * i;
            *(LAS unsigned short*)(kt + d * RT_STRIDE + 2 * j) = (unsigned short)(kw[i] & 0xffffu); *(LAS unsigned short*)(kt + (d + 1) * RT_STRIDE + 2 * j) = (unsigned short)(kw[i] >> 16);
            const float a = bflo(vw[i]), bb = bfhi(vw[i]);
            *(LAS unsigned short*)(vft + d * RT_STRIDE + 2 * j) = (unsigned short)f2bf(a * wf); *(LAS unsigned short*)(vft + (d + 1) * RT_STRIDE + 2 * j) = (unsigned short)f2bf(bb * wf);
            *(LAS unsigned short*)(vbt + d * RT_STRIDE + 2 * j) = (unsigned short)f2bf(a * wb); *(LAS unsigned short*)(vbt + (d + 1) * RT_STRIDE + 2 * j) = (unsigned short)f2bf(bb * wb);
        }
    }
    __syncthreads();
    const int dir = C.wave >> 2, dt = C.wave & 3, n = C.lane & 15, g = C.lane >> 4;
    LAS const unsigned char* vt = dir ? vbt : vft;
    f32x4 acc[4];
#pragma unroll
    for (int et = 0; et < 4; ++et) acc[et] = (f32x4){0.f, 0.f, 0.f, 0.f};
#pragma unroll
    for (int s = 0; s < 4; ++s) {
        const bf16x8 a = *(LAS const bf16x8*)(kt + (16 * dt + n) * RT_STRIDE + (32 * s + 8 * g) * 2);
#pragma unroll
        for (int et = 0; et < 4; ++et) {
            const bf16x8 bf = *(LAS const bf16x8*)(vt + (16 * et + n) * RT_STRIDE + (32 * s + 8 * g) * 2);
            acc[et] = __builtin_amdgcn_mfma_f32_16x16x32_bf16(a, bf, acc[et], 0, 0, 0);
        }
    }
    float* U = WSP(float, WS_UT) + ((size_t)((dir * 24 + b * 6 + h) * 34 + c)) * 4096;
#pragma unroll
    for (int et = 0; et < 4; ++et) *(f32x4*)(U + (16 * et + n) * 64 + 16 * dt + 4 * g) = acc[et];
}
typedef float f32x2v __attribute__((ext_vector_type(2)));
__device__ __forceinline__ void ret_scan(const Ctx& C, int layer) {
    for (int task = C.gtid; task < 48 * 2048; task += C.NT) {
        const int dir = task / (24 * 2048), rem = task % (24 * 2048), bh = rem >> 11, p = rem & 2047, h = bh % 6;
        const float dec = expf(128.0f * logsig(C.in[10][(layer * 2 + dir) * 6 + h]));
        const float* __restrict__ U = WSP(float, WS_UT) + ((size_t)(dir * 24 + bh) * 34) * 4096 + 2 * p;
        bf16* __restrict__ SB = WSP(bf16, WS_SB) + ((size_t)(dir * 24 + bh) * 34) * 4096 + 2 * p;
        f32x2v u[34];
#pragma unroll
        for (int k = 0; k < 34; ++k) { const int c = dir ? ((k < 2) ? 1 - k : 35 - k) : k; u[k] = *(const f32x2v*)(U + (size_t)c * 4096); }
        float s0 = 0.f, s1 = 0.f;
#pragma unroll
        for (int k = 0; k < 34; ++k) {
            const int c = dir ? ((k < 2) ? 1 - k : 35 - k) : k;
            *(unsigned*)(SB + (size_t)c * 4096) = pk2(s0, s1);
            s0 = dec * s0 + u[k].x; s1 = dec * s1 + u[k].y;
        }
    }
}
constexpr int RC_KS = 144;
constexpr int RC_VT = 0, RC_K = 64 * RT_STRIDE, RC_SB = RC_K + 128 * RC_KS, RC_TAB = RC_SB + 2 * 64 * RC_KS;
static_assert(RC_TAB + 1024 <= RING_BYTES, "retC LDS map");
struct RcLoads { bf16x8 qf[2]; v2u gw[4]; v4u v0, v1, k0, k1, s0, s1; };
__device__ __forceinline__ void rc_load(const Ctx& C, int b, int h, int c, RcLoads& L) {
    const bf16* PROJ = WSP(bf16, WS_PROJ);
    const int row0 = ret_row0(b, c);
    const int n = C.lane & 15, g = C.lane >> 4, i = 16 * C.wave + n, rowi = row0 + i;
    { const bf16x8* qp = (const bf16x8*)(PROJ + (size_t)rowi * NPROJP + C_RQ + 64 * h + 8 * g); L.qf[0] = qp[0]; L.qf[1] = qp[4]; }
    { const bf16* gp = PROJ + (size_t)rowi * NPROJP + C_RG + 64 * h + 4 * g;
#pragma unroll
      for (int et = 0; et < 4; ++et) L.gw[et] = *(const v2u*)(gp + 16 * et); }
    const int vj = C.tid & 127, vq4 = C.tid >> 7;
    const bf16* vpr = PROJ + (size_t)(row0 + vj) * NPROJP + 64 * h + 16 * vq4;
    L.v0 = *(const v4u*)(vpr + C_RV); L.v1 = *(const v4u*)(vpr + C_RV + 8);
    L.k0 = *(const v4u*)(vpr + C_RK); L.k1 = *(const v4u*)(vpr + C_RK + 8);
    const int se = C.tid & 63, sq = (C.tid >> 6) & 3, sd = C.tid >> 8;
    const bf16* spr = WSP(bf16, WS_SB) + ((size_t)((sd * 24 + b * 6 + h) * 34 + c)) * 4096 + se * 64 + 16 * sq;
    L.s0 = *(const v4u*)(spr); L.s1 = *(const v4u*)(spr + 8);
}
__device__ __forceinline__ void ret_c_unit(const Ctx& C, int layer, int b, int h, int c, const RcLoads& L) {
    LAS unsigned char* vt = C.lds + RING_OFF + RC_VT; LAS unsigned char* kim = C.lds + RING_OFF + RC_K; LAS unsigned char* sim = C.lds + RING_OFF + RC_SB;
    LAS float* tabf = (LAS float*)(C.lds + RING_OFF + RC_TAB);
    const float lgf = logsig(C.in[10][(layer * 2 + 0) * 6 + h]), lgb = logsig(C.in[10][(layer * 2 + 1) * 6 + h]);
    const int row0 = ret_row0(b, c);
    const int n = C.lane & 15, g = C.lane >> 4, i = 16 * C.wave + n, rowi = row0 + i;
    const int vj = C.tid & 127, vq4 = C.tid >> 7;
    const int se = C.tid & 63, sq = (C.tid >> 6) & 3, sd = C.tid >> 8;
    const bf16x8 qf[2] = {L.qf[0], L.qf[1]};
    const v2u gw[4] = {L.gw[0], L.gw[1], L.gw[2], L.gw[3]};
    const v4u v0 = L.v0, v1 = L.v1, k0 = L.k0, k1 = L.k1, s0 = L.s0, s1 = L.s1;
    __syncthreads();
    {
        const unsigned vw[8] = {v0.x, v0.y, v0.z, v0.w, v1.x, v1.y, v1.z, v1.w};
#pragma unroll
        for (int ii = 0; ii < 8; ++ii) { const int dd = 16 * vq4 + 2 * ii;
            *(LAS unsigned short*)(vt + dd * RT_STRIDE + 2 * vj) = (unsigned short)(vw[ii] & 0xffffu); *(LAS unsigned short*)(vt + (dd + 1) * RT_STRIDE + 2 * vj) = (unsigned short)(vw[ii] >> 16); }
        *(LAS v4u*)(kim + vj * RC_KS + 32 * vq4) = k0; *(LAS v4u*)(kim + vj * RC_KS + 32 * vq4 + 16) = k1;
        *(LAS v4u*)(sim + (sd * 64 + se) * RC_KS + 32 * sq) = s0; *(LAS v4u*)(sim + (sd * 64 + se) * RC_KS + 32 * sq + 16) = s1;
        if (C.tid < 255) { const int dl = C.tid - 127; tabf[C.tid] = (dl > 0) ? expf(lgf * (float)dl) : ((dl < 0) ? expf(lgb * (float)(-dl)) : 2.0f); }
    }
    __syncthreads();
    f32x4 st[8];
#pragma unroll
    for (int jt = 0; jt < 8; ++jt) {
        LAS const unsigned char* kp = kim + (16 * jt + n) * RC_KS + 16 * g;
        const bf16x8 ka = *(LAS const bf16x8*)(kp), kb = *(LAS const bf16x8*)(kp + 64);
        f32x4 acc = {0.f, 0.f, 0.f, 0.f};
        acc = __builtin_amdgcn_mfma_f32_16x16x32_bf16(ka, qf[0], acc, 0, 0, 0);
        acc = __builtin_amdgcn_mfma_f32_16x16x32_bf16(kb, qf[1], acc, 0, 0, 0);
        st[jt] = acc;
    }
#pragma unroll
    for (int jt = 0; jt < 8; ++jt)
#pragma unroll
        for (int reg = 0; reg < 4; ++reg) {
            const int j = 16 * jt + 4 * g + reg;
            st[jt][reg] *= tabf[127 + i - j];
        }
    f32x4 o[4];
#pragma unroll
    for (int et = 0; et < 4; ++et) o[et] = (f32x4){0.f, 0.f, 0.f, 0.f};
#pragma unroll
    for (int u = 0; u < 4; ++u) {
        v4u pw; pw.x = cvtpk(st[2 * u][0], st[2 * u][1]); pw.y = cvtpk(st[2 * u][2], st[2 * u][3]); pw.z = cvtpk(st[2 * u + 1][0], st[2 * u + 1][1]); pw.w = cvtpk(st[2 * u + 1][2], st[2 * u + 1][3]);
        const bf16x8 pb = __builtin_bit_cast(bf16x8, pw);
        const int slotA = 32 * u + 4 * g, slotB = slotA + 16;
#pragma unroll
        for (int et = 0; et < 4; ++et) {
            LAS const unsigned char* rowp = vt + (16 * et + n) * RT_STRIDE;
            const v2u a_lo = *(LAS const v2u*)(rowp + slotA * 2), a_hi = *(LAS const v2u*)(rowp + slotB * 2);
            v4u aw; aw.x = a_lo.x; aw.y = a_lo.y; aw.z = a_hi.x; aw.w = a_hi.y;
            o[et] = __builtin_amdgcn_mfma_f32_16x16x32_bf16(__builtin_bit_cast(bf16x8, aw), pb, o[et], 0, 0, 0);
        }
    }
#pragma unroll
    for (int dir = 0; dir < 2; ++dir) {
        const float scl = dir ? expf(lgb * (float)(128 - i)) : expf(lgf * (float)(i + 1));
#pragma unroll
        for (int et = 0; et < 4; ++et) {
            LAS const unsigned char* sp = sim + (dir * 64 + 16 * et + n) * RC_KS + 16 * g;
            const bf16x8 a0 = *(LAS const bf16x8*)(sp), a1 = *(LAS const bf16x8*)(sp + 64);
            f32x4 t = {0.f, 0.f, 0.f, 0.f};
            t = __builtin_amdgcn_mfma_f32_16x16x32_bf16(a0, qf[0], t, 0, 0, 0);
            t = __builtin_amdgcn_mfma_f32_16x16x32_bf16(a1, qf[1], t, 0, 0, 0);
            o[et] = o[et] + t * scl;
        }
    }
    float sm = 0.f;
#pragma unroll
    for (int et = 0; et < 4; ++et) sm += (o[et][0] + o[et][1]) + (o[et][2] + o[et][3]);
    sm += __shfl_xor(sm, 16); sm += __shfl_xor(sm, 32);
    const float mu = sm * (1.f / 64.f);
    float sq2 = 0.f;
#pragma unroll
    for (int et = 0; et < 4; ++et) { o[et] = o[et] - mu; sq2 += (o[et][0] * o[et][0] + o[et][1] * o[et][1]) + (o[et][2] * o[et][2] + o[et][3] * o[et][3]); }
    sq2 += __shfl_xor(sq2, 16); sq2 += __shfl_xor(sq2, 32);
    const float rstd = 1.0f / sqrtf(sq2 * (1.f / 64.f) + EPS);
    const float* gn = C.in[11] + layer * 384 + 64 * h;
    bf16* yp = WSP(bf16, WS_YMIX) + (size_t)rowi * D + 64 * h + 4 * g;
#pragma unroll
    for (int et = 0; et < 4; ++et) {
        const f32x4 gg = *(const f32x4*)(gn + 16 * et + 4 * g);
        const float y0 = o[et][0] * rstd * gg[0] * siluf(bflo(gw[et].x)), y1 = o[et][1] * rstd * gg[1] * siluf(bfhi(gw[et].x));
        const float y2 = o[et][2] * rstd * gg[2] * siluf(bflo(gw[et].y)), y3 = o[et][3] * rstd * gg[3] * siluf(bfhi(gw[et].y));
        v2u w; w.x = cvtpk(y0, y1); w.y = cvtpk(y2, y3);
        *(v2u*)(yp + 16 * et) = w;
    }
}

__device__ __forceinline__ void p_mix1(const Ctx& C, int layer) {
    { const int per = (1536 + C.G - 1) / C.G, u0 = C.bx * per, nu = min(per, 1536 - u0); if (nu > 0) { if ((per & 1) == 0) na_band2(C, layer, u0, nu); else na_band(C, layer, u0, nu); } }
    const int n_ctx = (layer == 0) ? 96 : 0, nu2 = n_ctx + 816;
    for (int u = C.bx; u < nu2; u += C.G) {
        if (u < n_ctx) { const int bh = u >> 2; ctxattn_unit(C, bh / 6, bh % 6, u & 3); }
        else { const int v = u - n_ctx, bh = v / 34; ret_a_unit(C, layer, bh / 6, bh % 6, v % 34); }
    }
    __syncthreads();
}
__device__ __forceinline__ void p_mix2(const Ctx& C, int layer) {
    ret_scan(C, layer);
    const bf16* PROJ = WSP(bf16, WS_PROJ); bf16* Y = WSP(bf16, WS_YMIX);
    const float* cw = C.in[12] + layer * 3 * 256;
    const int nrows = (layer == 0) ? RALL : RLAT;
    for (int idx = C.gtid; idx < nrows * 32; idx += C.NT) {
        const int m = idx >> 5, ch = (idx & 31) * 8;
        int tpos, len; if (m < RLAT) { tpos = m & 4095; len = SEQ; } else { tpos = (m - RLAT) & 255; len = CTXL; }
        const bf16* p = PROJ + (size_t)m * NPROJP + ch;
        const v4u zero = {0u, 0u, 0u, 0u};
        const v4u cb = *(const v4u*)(p + C_CB), cc1 = *(const v4u*)(p + C_CC), cx1 = *(const v4u*)(p + C_CX);
        const v4u cc0 = (tpos > 0) ? *(const v4u*)(p + C_CC - NPROJP) : zero, cx0 = (tpos > 0) ? *(const v4u*)(p + C_CX - NPROJP) : zero;
        const v4u cc2 = (tpos < len - 1) ? *(const v4u*)(p + C_CC + NPROJP) : zero, cx2 = (tpos < len - 1) ? *(const v4u*)(p + C_CX + NPROJP) : zero;
        const f32x4 w0a = *(const f32x4*)(cw + ch), w0b = *(const f32x4*)(cw + ch + 4), w1a = *(const f32x4*)(cw + 256 + ch), w1b = *(const f32x4*)(cw + 256 + ch + 4), w2a = *(const f32x4*)(cw + 512 + ch), w2b = *(const f32x4*)(cw + 512 + ch + 4);
        float y[8];
#pragma unroll
        for (int i = 0; i < 4; ++i) {
            const float wl0 = (i < 2) ? w0a[2 * i] : w0b[2 * i - 4], wh0 = (i < 2) ? w0a[2 * i + 1] : w0b[2 * i - 3];
            const float wl1 = (i < 2) ? w1a[2 * i] : w1b[2 * i - 4], wh1 = (i < 2) ? w1a[2 * i + 1] : w1b[2 * i - 3];
            const float wl2 = (i < 2) ? w2a[2 * i] : w2b[2 * i - 4], wh2 = (i < 2) ? w2a[2 * i + 1] : w2b[2 * i - 3];
            y[2 * i] = bflo(cb[i]) * (wl0 * bflo(cc0[i]) * bflo(cx0[i]) + wl1 * bflo(cc1[i]) * bflo(cx1[i]) + wl2 * bflo(cc2[i]) * bflo(cx2[i]));
            y[2 * i + 1] = bfhi(cb[i]) * (wh0 * bfhi(cc0[i]) * bfhi(cx0[i]) + wh1 * bfhi(cc1[i]) * bfhi(cx1[i]) + wh2 * bfhi(cc2[i]) * bfhi(cx2[i]));
        }
        v4u o; o.x = cvtpk(y[0], y[1]); o.y = cvtpk(y[2], y[3]); o.z = cvtpk(y[4], y[5]); o.w = cvtpk(y[6], y[7]);
        *(v4u*)(Y + (size_t)m * D + 384 + ch) = o;
    }
}
__device__ __forceinline__ void rc_unit_of(int layer, int u, int& bh, int& c) { if (layer == 0) { bh = u / 34; c = u % 34; } else { bh = u >> 5; c = 2 + (u & 31); } }
__device__ __forceinline__ void p_mix3(const Ctx& C, int layer) {
    const int nu = (layer == 0) ? 816 : 768;
    int u0 = C.bx;
    if (u0 < nu) {
        RcLoads La, Lb; int bh0, c0, bh1, c1;
        rc_unit_of(layer, u0, bh0, c0); rc_load(C, bh0 / 6, bh0 % 6, c0, La);
        for (;;) {
            const int u1 = u0 + C.G; const bool h1 = u1 < nu;
            if (h1) { rc_unit_of(layer, u1, bh1, c1); rc_load(C, bh1 / 6, bh1 % 6, c1, Lb); }
            ret_c_unit(C, layer, bh0 / 6, bh0 % 6, c0, La);
            if (!h1) break;
            u0 = u1 + C.G; const bool h0 = u0 < nu;
            if (h0) { rc_unit_of(layer, u0, bh0, c0); rc_load(C, bh0 / 6, bh0 % 6, c0, La); }
            ret_c_unit(C, layer, bh1 / 6, bh1 % 6, c1, Lb);
            if (!h0) break;
        }
    }
    __syncthreads();
}
__device__ __forceinline__ void p_moe_lists(const Ctx& C) {
    LAS int* L = (LAS int*)(C.lds + RING_OFF);
    const int* CNT = WSP(int, WS_CNT);
    for (int blk = C.bx; blk < 256; blk += C.G) {
        __syncthreads();
        for (int i = C.tid; i < 2048; i += NTHR) L[i] = CNT[i];
        if (C.tid < 64) L[2080 + C.tid] = WSP(int, WS_TOKE)[64 * blk + C.tid];
        __syncthreads();
        {
            const int e = C.wave; int tot = 0, pre = 0;
#pragma unroll
            for (int q = 0; q < 4; ++q) { const int k = 4 * C.lane + q; const int cnt = L[k * 8 + e]; tot += cnt; pre += (k < blk) ? cnt : 0; }
#pragma unroll
            for (int o = 1; o < 64; o <<= 1) { tot += __shfl_xor(tot, o); pre += __shfl_xor(pre, o); }
            if (C.lane == 0) { L[2048 + e] = tot; L[2064 + e] = pre; }
        }
        __syncthreads();
        if (C.tid == 0) { int base = 0; for (int e = 0; e < 8; ++e) { L[2056 + e] = base; base += (L[2048 + e] + 255) & ~255; } }
        __syncthreads();
        {
            const int e = C.wave, ee = L[2080 + C.lane], e1 = ee & 255, e2 = ee >> 8;
            const bool hit = (e1 == e) || (e2 == e);
            const unsigned long long bal = __ballot(hit);
            const int rank = __popcll(bal & ((1ull << C.lane) - 1ull));
            if (hit) L[2144 + 2 * C.lane + ((e1 == e) ? 0 : 1)] = L[2056 + e] + L[2064 + e] + rank;
        }
        __syncthreads();
        if (C.tid < 128) { const int t = C.tid >> 1, k = C.tid & 1, m = 64 * blk + t, pos = L[2144 + C.tid];
            WSP(int, WS_TOKP)[2 * m + k] = pos; WSP(float, WS_ROWW)[pos] = WSP(float, WS_TOKW)[2 * m + k]; }
        for (int j = 0; j < 8; ++j) { const int t = 8 * C.wave + j, m = 64 * blk + t;
            const v4u* src = (const v4u*)(WSP(bf16, WS_A) + (size_t)m * D) + 2 * C.lane;
            const v4u x0 = src[0], x1 = src[1];
            v4u y; y.x = pg8::pk4_fp8(bflo(x0.x), bfhi(x0.x), bflo(x0.y), bfhi(x0.y)); y.y = pg8::pk4_fp8(bflo(x0.z), bfhi(x0.z), bflo(x0.w), bfhi(x0.w));
            y.z = pg8::pk4_fp8(bflo(x1.x), bfhi(x1.x), bflo(x1.y), bfhi(x1.y)); y.w = pg8::pk4_fp8(bflo(x1.z), bfhi(x1.z), bflo(x1.w), bfhi(x1.w));
#pragma unroll
            for (int k = 0; k < 2; ++k) { v4u* dst = (v4u*)(WSP(unsigned char, WS_SORT) + (size_t)L[2144 + 2 * t + k] * D) + C.lane; dst[0] = y; } }
        if (blk == 0 && C.tid == 0) { int T = 0; int* TE = WSP(int, WS_TILE);
            for (int e = 0; e < 8; ++e) { const int nt = (L[2048 + e] + 255) >> 8; for (int k = 0; k < nt; ++k) TE[T + k] = e; T += nt; }
            TE[255] = T; }
    }
    __syncthreads();
}
__device__ __forceinline__ void p_final(const Ctx& C, float* out) {
    const float* fg = C.in[20]; const float* mod = WSP(float, WS_MOD) + 30720; const bf16* SL = WSP(bf16, WS_SLOT);
    for (int m0 = C.gw; m0 < RLAT; m0 += 2 * C.NGW) {
        int mm[2], pp[2][2]; bool ok[2];
#pragma unroll
        for (int r = 0; r < 2; ++r) { mm[r] = m0 + r * C.NGW; ok[r] = mm[r] < RLAT; const int mc = ok[r] ? mm[r] : m0; mm[r] = mc; pp[r][0] = WSP(int, WS_TOKP)[2 * mc]; pp[r][1] = WSP(int, WS_TOKP)[2 * mc + 1]; }
        f32x4 v[2][4]; float ss[2] = {0.f, 0.f};
#pragma unroll
        for (int r = 0; r < 2; ++r)
#pragma unroll
            for (int j = 0; j < 4; ++j) { const int c = 4 * C.lane + 256 * j; const int b = mm[r] >> 12;
                const f32x4 hv = *(const f32x4*)(WSP(float, WS_H) + (size_t)mm[r] * D + c), g2 = *(const f32x4*)(mod + b * 6144 + 5 * D + c);
                const v2u q1 = *(const v2u*)(SL + (size_t)pp[r][0] * D + c), q2 = *(const v2u*)(SL + (size_t)pp[r][1] * D + c);
                const f32x4 s1 = {bflo(q1.x), bfhi(q1.x), bflo(q1.y), bfhi(q1.y)}, s2 = {bflo(q2.x), bfhi(q2.x), bflo(q2.y), bfhi(q2.y)};
                v[r][j] = hv + g2 * (s1 + s2); ss[r] += (v[r][j].x * v[r][j].x + v[r][j].y * v[r][j].y) + (v[r][j].z * v[r][j].z + v[r][j].w * v[r][j].w); }
#pragma unroll
        for (int r = 0; r < 2; ++r) {
            const float rstd = 1.0f / sqrtf(wave_sum(ss[r]) * (1.0f / D) + EPS);
            if (ok[r]) {
#pragma unroll
                for (int j = 0; j < 4; ++j) { const int c = 4 * C.lane + 256 * j; __builtin_nontemporal_store(v[r][j] * rstd * *(const f32x4*)(fg + c), (f32x4*)(out + (size_t)mm[r] * D + c)); }
            }
        }
    }
}

#ifndef MK_ONE_LAUNCH
#define MK_ONE_LAUNCH 1
#endif
constexpr int NPHASES = 21;
#ifndef PROBE_DUP
#define PROBE_DUP 0u
#endif
#define REPS(k) ((((PROBE_DUP) >> (k)) & 1u) ? 2 : 1)
struct Args { const float* in[21]; float* out; unsigned char* ws; int ph_lo, ph_hi; };
__global__ void __launch_bounds__(NTHR, 2) fwd(Args args) {
    extern __shared__ __attribute__((aligned(16))) unsigned char lds_raw[];
    Ctx C;
    C.lds = (LAS unsigned char*)lds_raw;
    C.tid = threadIdx.x; C.lane = C.tid & 63; C.wave = __builtin_amdgcn_readfirstlane(C.tid >> 6);
    C.G = gridDim.x; C.bx = blockIdx.x; C.gw = C.bx * NWAVES + C.wave; C.NGW = C.G * NWAVES; C.gtid = C.bx * NTHR + C.tid; C.NT = C.G * NTHR;
    C.ws = args.ws;
#pragma unroll
    for (int i = 0; i < 21; ++i) C.in[i] = args.in[i];
    volatile LAS unsigned* MISC = (volatile LAS unsigned*)(C.lds + MISC_OFF);
    for (int u = C.tid; u < (LDS_BYTES - LDSCTL_OFF) / 4; u += NTHR) ((LAS unsigned*)(C.lds + LDSCTL_OFF))[u] = 0u;
    __syncthreads();
    const int lo = args.ph_lo, hi = args.ph_hi;
    unsigned* barw = (unsigned*)(C.ws + WS_CTL) + CW_BAR;
    XcdBarrier bar; bar.bar = barw; bar.x = 0; bar.st = nullptr;
    if (hi - lo > 1) bar = xcd_barrier_post(barw, MISC + 8);
#define IN(k) (lo <= (k) && (k) < hi)
#define SEAM(k) do { if (IN(k) && IN((k) + 1)) xcd_barrier(bar); } while (0)
    LAS unsigned char* ring = C.lds + RING_OFF;
    const float* cosT = WSP(float, WS_ROPE); const float* sinT = cosT + 1024;

    if (IN(0)) for (int rep = 0; rep < REPS(0); ++rep) { p_prologue(C); } SEAM(0);
    if (IN(1)) for (int rep = 0; rep < REPS(1); ++rep) { p_norm<false, 0>(C, 0, 0, true, true, true, false); } SEAM(1);
    if (IN(2)) for (int rep = 0; rep < REPS(2); ++rep) { pg8::Gemm g{WSP(bf16, WS_A), WSP(bf16, WS_WIN), RALL, NPROJP, D, D}; pg8::StaticOrder S; S.init(RALL, NPROJP, C.G, C.bx);
        pg8::EpiInProj E{WSP(bf16, WS_PROJ), cosT, sinT};
        pg8::gemm_phase<pg8::EpiInProj, pg8::StaticOrder, true, true>(ring, g, S, E); } SEAM(2);
    if (IN(3)) for (int rep = 0; rep < REPS(3); ++rep) { p_mix1(C, 0); } SEAM(3);
    if (IN(4)) for (int rep = 0; rep < REPS(4); ++rep) { p_mix2(C, 0); } SEAM(4);
    if (IN(5)) for (int rep = 0; rep < REPS(5); ++rep) { p_mix3(C, 0); } SEAM(5);
    if (IN(6)) for (int rep = 0; rep < REPS(6); ++rep) { { pg8::Gemm g{WSP(bf16, WS_YMIX), WSP(bf16, WS_WOUT), RLAT, D, D, D}; pg8::StaticOrder S; S.init(RLAT, D, C.G, C.bx);
        pg8::EpiResid E{WSP(float, WS_H), C.in[0], C.in[2], WSP(float, WS_MOD), 2 * D};
        pg8::gemm_phase<pg8::EpiResid, pg8::StaticOrder, true, true>(ring, g, S, E); }
        { pg8::Gemm g{WSP(bf16, WS_YMIX) + (size_t)RLAT * D, WSP(bf16, WS_WOUT), RCTX, D, 256, D}; pg8::SplitOrder S; S.init(4, C.G, C.bx);
        pg8::EpiPartial E{WSP(float, WS_PART), WSP(float, WS_MOD), 2 * D};
        pg8::gemm_phase<pg8::EpiPartial, pg8::SplitOrder, false, true>(ring, g, S, E); } } SEAM(6);
    if (IN(7)) for (int rep = 0; rep < REPS(7); ++rep) { p_norm<false, 4>(C, 0, 1, true, false, true, true); } SEAM(7);
    if (IN(8)) for (int rep = 0; rep < REPS(8); ++rep) { pg8::Gemm g{WSP(bf16, WS_A), WSP(bf16, WS_FIN), RALL, 2 * DFF, D, D}; pg8::StaticOrder S; S.init(RALL, 2 * DFF, C.G, C.bx);
        pg8::EpiSwiglu E{WSP(bf16, WS_HID)};
        pg8::gemm_phase<pg8::EpiSwiglu, pg8::StaticOrder, true, true>(ring, g, S, E); } SEAM(8);
    if (IN(9)) for (int rep = 0; rep < REPS(9); ++rep) { { pg8::Gemm g{WSP(bf16, WS_HID), WSP(bf16, WS_FOUT), RLAT, D, DFF, DFF}; pg8::StaticOrder S; S.init(RLAT, D, C.G, C.bx);
        pg8::EpiResid E{WSP(float, WS_H), WSP(float, WS_H), WSP(float, WS_H) + (size_t)RLAT * D, WSP(float, WS_MOD), 5 * D};
        pg8::gemm_phase<pg8::EpiResid, pg8::StaticOrder, true, true>(ring, g, S, E); }
        { pg8::Gemm g{WSP(bf16, WS_HID) + (size_t)RLAT * DFF, WSP(bf16, WS_FOUT), RCTX, D, 256, DFF}; pg8::SplitOrder S; S.init(11, C.G, C.bx);
        pg8::EpiPartial E{WSP(float, WS_PART), WSP(float, WS_MOD), 5 * D};
        pg8::gemm_phase<pg8::EpiPartial, pg8::SplitOrder, false, true>(ring, g, S, E); } } SEAM(9);
    if (IN(10)) for (int rep = 0; rep < REPS(10); ++rep) { p_norm<false, 11>(C, 1, 0, true, false, false, false); } SEAM(10);
    if (IN(11)) for (int rep = 0; rep < REPS(11); ++rep) { pg8::Gemm g{WSP(bf16, WS_A), WSP(bf16, WS_WIN) + (size_t)NPROJP * D, RALL, NPROJP, D, D}; pg8::StaticOrder S; S.init(RALL, NPROJP, C.G, C.bx);
        pg8::EpiInProj E{WSP(bf16, WS_PROJ), cosT, sinT};
        pg8::gemm_phase<pg8::EpiInProj, pg8::StaticOrder, true, true>(ring, g, S, E); } SEAM(11);
    if (IN(12)) for (int rep = 0; rep < REPS(12); ++rep) { p_mix1(C, 1); } SEAM(12);
    if (IN(13)) for (int rep = 0; rep < REPS(13); ++rep) { p_mix2(C, 1); } SEAM(13);
    if (IN(14)) for (int rep = 0; rep < REPS(14); ++rep) { p_mix3(C, 1); } SEAM(14);
    if (IN(15)) for (int rep = 0; rep < REPS(15); ++rep) { pg8::Gemm g{WSP(bf16, WS_YMIX), WSP(bf16, WS_WOUT) + (size_t)D * D, RLAT, D, D, D}; pg8::StaticOrder S; S.init(RLAT, D, C.G, C.bx);
        pg8::EpiResid E{WSP(float, WS_H), WSP(float, WS_H), WSP(float, WS_H) + (size_t)RLAT * D, WSP(float, WS_MOD) + 30720, 2 * D};
        pg8::gemm_phase<pg8::EpiResid, pg8::StaticOrder, true, true>(ring, g, S, E); } SEAM(15);
    if (IN(16)) for (int rep = 0; rep < REPS(16); ++rep) { p_norm<true, 0>(C, 1, 1, false, false, false, false); } SEAM(16);
    if (IN(17)) for (int rep = 0; rep < REPS(17); ++rep) { p_moe_lists(C); } SEAM(17);
    if (IN(18)) for (int rep = 0; rep < REPS(18); ++rep) { const int T = __builtin_amdgcn_readfirstlane(WSP(int, WS_TILE)[255]);
        pg8::Gemm g{WSP(bf16, WS_SORT), WSP(bf16, WS_MIN), T * 256, 2 * DFF, D / 2, D / 2}; pg8::MoeOrder S; S.init(T, 2 * DFF, C.G, C.bx, WSP(int, WS_TILE), (size_t)2 * DFF * D / 2);
        pg8::EpiSwigluF8 E{WSP(unsigned char, WS_HID)};
        pg8::gemm_phase<pg8::EpiSwigluF8, pg8::MoeOrder, true, true, true>(ring, g, S, E); } SEAM(18);
    if (IN(19)) for (int rep = 0; rep < REPS(19); ++rep) { const int T = __builtin_amdgcn_readfirstlane(WSP(int, WS_TILE)[255]);
        pg8::Gemm g{WSP(bf16, WS_HID), WSP(bf16, WS_MOUT), T * 256, D, DFF / 2, DFF / 2}; pg8::MoeOrder S; S.init(T, D, C.G, C.bx, WSP(int, WS_TILE), (size_t)D * DFF / 2);
        pg8::EpiSlots E{WSP(bf16, WS_SLOT), WSP(float, WS_ROWW)};
        pg8::gemm_phase<pg8::EpiSlots, pg8::MoeOrder, true, true, true>(ring, g, S, E); } SEAM(19);
    if (IN(20)) for (int rep = 0; rep < REPS(20); ++rep) { p_final(C, args.out); }
#undef IN
#undef SEAM
}

extern "C" void kernel_launch(void* const* d_in, const int* in_sizes, int n_in, void* d_out, int out_size, void* d_ws, size_t ws_size, hipStream_t stream) {
    static int grid = 0;
    if (grid == 0) {
        if (n_in != 21 || ws_size < WS_END) { fprintf(stderr, "kernel_launch: unexpected n_in %d or ws_size %zu (need %zu)\n", n_in, ws_size, (size_t)WS_END); grid = -1; return; }
        int dev = 0, cus = 0, per_cu = 0;
        if (hipGetDevice(&dev) != hipSuccess || hipDeviceGetAttribute(&cus, hipDeviceAttributeMultiprocessorCount, dev) != hipSuccess) { grid = -1; return; }
        if (hipFuncSetAttribute((const void*)fwd, hipFuncAttributeMaxDynamicSharedMemorySize, LDS_BYTES) != hipSuccess) { fprintf(stderr, "kernel_launch: hipFuncSetAttribute failed\n"); grid = -1; return; }
        if (hipOccupancyMaxActiveBlocksPerMultiprocessor(&per_cu, (const void*)fwd, NTHR, LDS_BYTES) != hipSuccess || per_cu < 1) fprintf(stderr, "kernel_launch: occupancy query reports %d\n", per_cu);
        (void)hipGetLastError();
        grid = cus < 256 ? cus : 256;
    }
    if (grid < 0) return;
    (void)hipMemsetAsync((char*)d_ws + WS_CTL, 0, CTL_ZERO_BYTES, stream);
    Args a{};
    for (int i = 0; i < 21; ++i) a.in[i] = (const float*)d_in[i];
    a.out = (float*)d_out; a.ws = (unsigned char*)d_ws;
#if MK_ONE_LAUNCH
    a.ph_lo = 0; a.ph_hi = NPHASES;
    hipLaunchKernelGGL(fwd, dim3(grid), dim3(NTHR), LDS_BYTES, stream, a);
#else
    for (int p = 0; p < NPHASES; ++p) { a.ph_lo = p; a.ph_hi = p + 1; hipLaunchKernelGGL(fwd, dim3(grid), dim3(NTHR), LDS_BYTES, stream, a); }
#endif
}
```

```cpp
#include <hip/hip_runtime.h>
#include <cstdio>
#include <cstdint>
namespace pg8 {
#define PG8_LAS __attribute__((address_space(3)))
typedef unsigned short bf16_t;
typedef short bf16x8 __attribute__((ext_vector_type(8)));
typedef float f32x4 __attribute__((ext_vector_type(4)));
typedef unsigned u32x4 __attribute__((ext_vector_type(4)));
constexpr int BM = 256, BK = 64, HALF = 128, HTB = HALF * BK * 2  , STAGE_BYTES = 8 * HTB, NXCD = 8, WGM = 8;

__host__ __device__ __forceinline__ int lds_byte(int r, int c) { const int st = (r >> 4) * 2 + (c >> 5), rr = r & 15, cc = c & 31, ob = rr * 64 + cc * 2; return st * 1024 + (ob ^ (((ob >> 9) & 1) << 5)); }
__host__ __device__ __forceinline__ void stage_rc(int b, int& R, int& C) { const int st = b / 1024, sb = b % 1024, swz = sb ^ (((sb >> 9) & 1) << 5); R = (st >> 1) * 16 + swz / 64; C = (st & 1) * 32 + (swz % 64) / 2; }
__host__ __device__ __forceinline__ int perm32(int rho) { const int n = rho >> 4, i = rho & 15; return 8 * (i >> 2) + 4 * n + (i & 3); }

struct Unit { int pm, pn, ks; };
struct Gemm { const bf16_t* A; const bf16_t* Bt; int M, N, K, ld; };

struct StaticOrder {
    int nM, nN, nwg, G, c;
    __host__ __device__ void init(int M, int N, int G_, int c_) { nM = M / BM; nN = N / BM; nwg = nM * nN; G = G_; c = c_; }
    __host__ __device__ bool next(int i, Unit& u) const {
        const long L = (long)i * G + c; if (L >= nwg) return false;
        int wgid = (int)L; { const int q = nwg / NXCD, r = nwg % NXCD, xcd = wgid % NXCD, off = wgid / NXCD; wgid = (xcd < r ? xcd * (q + 1) : r * (q + 1) + (xcd - r) * q) + off; }
        const int nig = WGM * nN, gid = wgid / nig, fm = gid * WGM, gsz = (nM - fm) < WGM ? (nM - fm) : WGM;
        u.pm = fm + ((wgid % nig) % gsz); u.pn = (wgid % nig) / gsz; u.ks = 0; return true;
    }
    __device__ __forceinline__ void a_ready(const Unit&) const {}
    __device__ __forceinline__ void done(const Unit&) const {}
    __device__ __forceinline__ const bf16_t* bt(const Gemm& g, const Unit&) const { return g.Bt; }
};

__device__ __forceinline__ unsigned cvt_pk_bf16(float lo, float hi) { unsigned r; asm volatile("v_cvt_pk_bf16_f32 %0, %1, %2" : "=v"(r) : "v"(lo), "v"(hi)); return r; }
typedef float f32x2 __attribute__((ext_vector_type(2)));

typedef int i32x4_t __attribute__((ext_vector_type(4)));
typedef int i32x8_t __attribute__((ext_vector_type(8)));
__device__ __forceinline__ i32x8_t cat8(bf16x8 lo, bf16x8 hi) { const i32x4_t l = __builtin_bit_cast(i32x4_t, lo), h = __builtin_bit_cast(i32x4_t, hi); return __builtin_shufflevector(l, h, 0, 1, 2, 3, 4, 5, 6, 7); }
template <class Epi, class Sched, bool ALIGN_EPI = false, bool SP2 = false, bool FP8 = false>
__device__ __forceinline__ void gemm_phase(PG8_LAS unsigned char* lds, const Gemm g, const Sched& S, const Epi& E) {
    const int tid = threadIdx.x, wid = __builtin_amdgcn_readfirstlane(tid >> 6), lane = tid & 63, wr = wid >> 2, wc = wid & 3, fr = lane & 15, fq = lane >> 4;
    const int K = g.K, nt = K / BK, LD = g.ld;
    unsigned voffA[2], voffB[2];
#pragma unroll
    for (int i = 0; i < 2; ++i) { int R, C; stage_rc(tid * 16 + i * 8192, R, C); const int Rb = Epi::PERM ? ((R & ~31) + perm32(R & 31)) : R;
        voffA[i] = (unsigned)(R * LD + C) * 2u; voffB[i] = (unsigned)(Rb * LD + C) * 2u; }
    const size_t kstep = (size_t)(BK * 2);
    const size_t hstep = (size_t)HALF * LD * 2;
    const size_t tstep = 2 * hstep;
    const unsigned ldsw = (unsigned)wid * 1024u;
    const int aoff = lds_byte(wr * 64 + fr, fq * 8), boff = lds_byte(wc * 32 + fr, fq * 8);
#define PG8_SA(b, h) (((b) * 2 + (h)) * HTB)
#define PG8_SB(b, h) ((4 + (b) * 2 + (h)) * HTB)
#define PG8_STAGE(bufoff, gbase, voff) do { _Pragma("unroll") for (int _i = 0; _i < 2; ++_i) \
        __builtin_amdgcn_global_load_lds((const unsigned*)((const char*)(gbase) + (voff)[_i]), (PG8_LAS unsigned*)(lds + (bufoff) + ldsw + _i * 8192), 16, 0, 0); } while (0)
#define PG8_LDA(dst, b, h) do { if constexpr (FP8) { _Pragma("unroll") for (int m = 0; m < 4; ++m) dst##_8[m] = cat8(*(const PG8_LAS bf16x8*)(lds + PG8_SA(b, h) + aoff + m * 2048), *(const PG8_LAS bf16x8*)(lds + PG8_SA(b, h) + aoff + m * 2048 + 1024)); } \
    else { _Pragma("unroll") for (int m = 0; m < 4; ++m) _Pragma("unroll") for (int k = 0; k < 2; ++k) dst[m][k] = *(const PG8_LAS bf16x8*)(lds + PG8_SA(b, h) + aoff + m * 2048 + k * 1024); } } while (0)
#define PG8_LDB(dst, b, h) do { if constexpr (FP8) { _Pragma("unroll") for (int n = 0; n < 2; ++n) dst##_8[n] = cat8(*(const PG8_LAS bf16x8*)(lds + PG8_SB(b, h) + boff + n * 2048), *(const PG8_LAS bf16x8*)(lds + PG8_SB(b, h) + boff + n * 2048 + 1024)); } \
    else { _Pragma("unroll") for (int n = 0; n < 2; ++n) _Pragma("unroll") for (int k = 0; k < 2; ++k) dst[n][k] = *(const PG8_LAS bf16x8*)(lds + PG8_SB(b, h) + boff + n * 2048 + k * 1024); } } while (0)
#define PG8_MMA(ai, bj, At, Bt) do { __builtin_amdgcn_s_setprio(1); _Pragma("unroll") for (int m = 0; m < 4; ++m) _Pragma("unroll") for (int n = 0; n < 2; ++n) { \
        if constexpr (FP8) { asm volatile("v_mfma_scale_f32_16x16x128_f8f6f4 %0, %1, %2, %0, %3, %4 op_sel_hi:[0,0,0]" : "+v"(acc[ai][bj][m][n]) : "v"(Bt##_8[n]), "v"(At##_8[m]), "v"(f8_scale_w), "v"(f8_scale_a)); } \
        else { _Pragma("unroll") for (int k = 0; k < 2; ++k) acc[ai][bj][m][n] = __builtin_amdgcn_mfma_f32_16x16x32_bf16(Bt[n][k], At[m][k], acc[ai][bj][m][n], 0, 0, 0); } } __builtin_amdgcn_s_setprio(0); } while (0)
#define PG8_WAIT_V(n) asm volatile("s_waitcnt vmcnt(" #n ")" ::: "memory")
#define PG8_WAIT_L(n) asm volatile("s_waitcnt lgkmcnt(" #n ")" ::: "memory")
#define PG8_BAR __builtin_amdgcn_s_barrier()
#define PG8_SCHED __builtin_amdgcn_sched_barrier(0)
    Unit cur, nxt; int ui = 0;
    if (!S.next(0, cur)) return;
    f32x4 acc[2][2][4][2];
#pragma unroll
    for (int a = 0; a < 2; ++a)
#pragma unroll
        for (int b = 0; b < 2; ++b)
#pragma unroll
            for (int m = 0; m < 4; ++m)
#pragma unroll
                for (int n = 0; n < 2; ++n) acc[a][b][m][n] = (f32x4){0.f, 0.f, 0.f, 0.f};
    bf16x8 At[4][2], B0[2][2], B1[2][2]; i32x8_t At_8[4], B0_8[2], B1_8[2];
    const int f8_scale_w = 0x79797979, f8_scale_a = 0x7f7f7f7f;
    const char* cA = (const char*)g.A + (size_t)cur.pm * tstep + (size_t)cur.ks * K * 2; const char* cB = (const char*)S.bt(g, cur) + (size_t)cur.pn * tstep + (size_t)cur.ks * K * 2;
    S.a_ready(cur);
    if constexpr (SP2) {
        PG8_STAGE(PG8_SB(0, 0), cB, voffB); PG8_STAGE(PG8_SB(0, 1), cB + hstep, voffB); PG8_STAGE(PG8_SA(0, 0), cA, voffA); PG8_STAGE(PG8_SA(0, 1), cA + hstep, voffA);
        if (wr == 1) PG8_BAR;
        PG8_WAIT_V(2); PG8_BAR;
        PG8_STAGE(PG8_SB(1, 0), cB + kstep, voffB); PG8_STAGE(PG8_SA(1, 0), cA + kstep, voffA); PG8_STAGE(PG8_SB(1, 1), cB + hstep + kstep, voffB);
        PG8_WAIT_V(6); PG8_BAR;
    } else {
        PG8_STAGE(PG8_SB(0, 0), cB, voffB); PG8_STAGE(PG8_SA(0, 0), cA, voffA); PG8_STAGE(PG8_SB(0, 1), cB + hstep, voffB); PG8_STAGE(PG8_SA(0, 1), cA + hstep, voffA);
        if (wr == 1) PG8_BAR;
        PG8_WAIT_V(4); PG8_BAR;
        PG8_STAGE(PG8_SB(1, 0), cB + kstep, voffB); PG8_STAGE(PG8_SA(1, 0), cA + kstep, voffA); PG8_STAGE(PG8_SB(1, 1), cB + hstep + kstep, voffB);
        PG8_WAIT_V(6); PG8_BAR;
    }
    for (;;) {
        const bool has_next = S.next(ui + 1, nxt);
        const char* nA = has_next ? (const char*)g.A + (size_t)nxt.pm * tstep + (size_t)nxt.ks * K * 2 : cA; const char* nB = has_next ? (const char*)S.bt(g, nxt) + (size_t)nxt.pn * tstep + (size_t)nxt.ks * K * 2 : cB;
#pragma clang loop unroll(disable)
        for (int t = 0; t < nt; t += 2) {
            const bool last = (t == nt - 2);
            const char* a1 = cA + (size_t)(t + 1) * kstep;
            const char* a2 = last ? nA : cA + (size_t)(t + 2) * kstep; const char* b2 = last ? nB : cB + (size_t)(t + 2) * kstep;
            const char* a3 = a2 + kstep; const char* b3 = b2 + kstep;
            if (last && has_next) S.a_ready(nxt);
            if constexpr (SP2) {
            PG8_LDB(B0, 0, 0); PG8_LDB(B1, 0, 1); PG8_SCHED; PG8_LDA(At, 0, 0); PG8_STAGE(PG8_SA(1, 1), a1 + hstep, voffA);
            PG8_WAIT_V(8); PG8_WAIT_L(0); PG8_BAR; PG8_MMA(0, 0, At, B0); PG8_MMA(0, 1, At, B1); PG8_BAR; PG8_SCHED;
            PG8_LDA(At, 0, 1); PG8_STAGE(PG8_SB(0, 0), b2, voffB); PG8_STAGE(PG8_SB(0, 1), b2 + hstep, voffB); PG8_STAGE(PG8_SA(0, 0), a2, voffA);
            PG8_WAIT_V(8); PG8_WAIT_L(0); PG8_BAR; PG8_MMA(1, 0, At, B0); PG8_MMA(1, 1, At, B1); PG8_BAR; PG8_SCHED;
            PG8_LDB(B0, 1, 0); PG8_LDB(B1, 1, 1); PG8_SCHED; PG8_LDA(At, 1, 0); PG8_STAGE(PG8_SA(0, 1), a2 + hstep, voffA);
            PG8_WAIT_V(8); PG8_WAIT_L(0); PG8_BAR; PG8_MMA(0, 0, At, B0); PG8_MMA(0, 1, At, B1); PG8_BAR; PG8_SCHED;
            PG8_LDA(At, 1, 1); PG8_STAGE(PG8_SB(1, 0), b3, voffB); PG8_STAGE(PG8_SB(1, 1), b3 + hstep, voffB); PG8_STAGE(PG8_SA(1, 0), a3, voffA);
            PG8_WAIT_V(8); PG8_WAIT_L(0); PG8_BAR; PG8_MMA(1, 0, At, B0); PG8_MMA(1, 1, At, B1); PG8_BAR; PG8_SCHED;
            } else {
            PG8_LDB(B0, 0, 0); PG8_SCHED; PG8_LDA(At, 0, 0); PG8_STAGE(PG8_SA(1, 1), a1 + hstep, voffA);
            PG8_WAIT_L(8); PG8_BAR; PG8_WAIT_L(0); PG8_MMA(0, 0, At, B0); PG8_BAR; PG8_SCHED;
            PG8_LDB(B1, 0, 1); PG8_STAGE(PG8_SB(0, 0), b2, voffB);
            PG8_BAR; PG8_WAIT_L(0); PG8_MMA(0, 1, At, B1); PG8_BAR;
            PG8_LDA(At, 0, 1); PG8_STAGE(PG8_SA(0, 0), a2, voffA);
            PG8_BAR; PG8_WAIT_L(0); PG8_MMA(1, 0, At, B0); PG8_BAR; PG8_SCHED;
            PG8_STAGE(PG8_SB(0, 1), b2 + hstep, voffB);
            PG8_WAIT_V(6); PG8_BAR; PG8_MMA(1, 1, At, B1); PG8_BAR;
            PG8_LDB(B0, 1, 0); PG8_SCHED; PG8_LDA(At, 1, 0); PG8_STAGE(PG8_SA(0, 1), a2 + hstep, voffA);
            PG8_WAIT_L(8); PG8_BAR; PG8_WAIT_L(0); PG8_MMA(0, 0, At, B0); PG8_BAR; PG8_SCHED;
            PG8_LDB(B1, 1, 1); PG8_STAGE(PG8_SB(1, 0), b3, voffB);
            PG8_BAR; PG8_WAIT_L(0); PG8_MMA(0, 1, At, B1); PG8_BAR;
            PG8_LDA(At, 1, 1); PG8_STAGE(PG8_SA(1, 0), a3, voffA);
            PG8_BAR; PG8_WAIT_L(0); PG8_MMA(1, 0, At, B0); PG8_BAR; PG8_SCHED;
            PG8_STAGE(PG8_SB(1, 1), b3 + hstep, voffB);
            PG8_WAIT_V(6); PG8_BAR; PG8_MMA(1, 1, At, B1); PG8_BAR;
            }
        }
        if constexpr (ALIGN_EPI) { if (wr == 0) PG8_BAR; }
        if constexpr (FP8) asm volatile("s_nop 15\n\ts_nop 15" ::: "memory");
        if constexpr (!Epi::AFTER_DRAIN) { E(acc, cur, wr, wc, fr, fq); S.done(cur); }
        if (!has_next) break;
#pragma unroll
        for (int a = 0; a < 2; ++a)
#pragma unroll
            for (int b = 0; b < 2; ++b)
#pragma unroll
                for (int m = 0; m < 4; ++m)
#pragma unroll
                    for (int n = 0; n < 2; ++n) acc[a][b][m][n] = (f32x4){0.f, 0.f, 0.f, 0.f};
        cur = nxt; cA = nA; cB = nB; ++ui;
        if constexpr (ALIGN_EPI) { if (wr == 1) PG8_BAR; }
    }
    PG8_WAIT_V(0);
    if constexpr (!ALIGN_EPI) { if (wr == 0) PG8_BAR; }
    PG8_BAR;
    if constexpr (Epi::AFTER_DRAIN) { E.fused(acc, cur, wr, wc, fr, fq, lds, wid, lane); S.done(cur); }
#undef PG8_SA
#undef PG8_SB
#undef PG8_STAGE
#undef PG8_LDA
#undef PG8_LDB
#undef PG8_MMA
#undef PG8_WAIT_V
#undef PG8_WAIT_L
#undef PG8_BAR
#undef PG8_SCHED
}
}


constexpr int NWAVES = 8, NTHR = 512;
constexpr int D = 1024, NB = 4, SEQ = 4096, CTXL = 256, RLAT = NB * SEQ, RCTX = NB * CTXL, RALL = RLAT + RCTX;
constexpr int NPROJ = 3456, NPROJP = 3584, DFF = 2816, NE = 8;
constexpr int C_RQ = 0, C_RK = 384, C_RV = 768, C_RG = 1152, C_CB = 1536, C_CC = 1792, C_CX = 2048, C_NQ = 2304, C_NK = 2688, C_NV = 3072;
constexpr int MOE_ROWS = 2 * RLAT + NE * 256;
constexpr float EPS = 1e-6f;

constexpr size_t MiB = 1u << 20, KiB = 1u << 10;
constexpr size_t WS_CTL = 0, CTL_ZERO_BYTES = 1 * MiB;
constexpr size_t WS_MODP = 1 * MiB;
constexpr size_t WS_MOD = 3 * MiB;
constexpr size_t WS_ROWW = 3 * MiB + 256 * KiB;
constexpr size_t WS_ROPE = 3 * MiB + 512 * KiB;
constexpr size_t WS_CNT = WS_ROPE + 16 * KiB;
constexpr size_t WS_TILE = WS_ROPE + 32 * KiB;
constexpr size_t WS_TOKE = WS_ROPE + 64 * KiB;
constexpr size_t WS_TOKW = WS_ROPE + 128 * KiB;
constexpr size_t WS_TOKP = WS_ROPE + 256 * KiB;
constexpr size_t WS_WIN = 4 * MiB;
constexpr size_t WS_WOUT = 18 * MiB;
constexpr size_t WS_FIN = 22 * MiB;
constexpr size_t WS_FOUT = 33 * MiB;
constexpr size_t WS_MIN = 39 * MiB;
constexpr size_t WS_MOUT = 127 * MiB;
constexpr size_t WS_H = 171 * MiB;
constexpr size_t WS_A = 239 * MiB;
constexpr size_t WS_PROJ = 273 * MiB;
constexpr size_t WS_YMIX = 392 * MiB;
constexpr size_t WS_HID = 273 * MiB;
constexpr size_t WS_OBUF = 474 * MiB;
constexpr size_t WS_SORT = 526 * MiB;
constexpr size_t WS_SLOT = 474 * MiB;
constexpr size_t WS_PART = 610 * MiB;
constexpr size_t WS_END = 654 * MiB;
constexpr int CW_BAR = 4096;

constexpr int RING_OFF = 0, RING_BYTES = 131072;
constexpr int LDSCTL_OFF = RING_BYTES, MISC_OFF = LDSCTL_OFF + 320;
constexpr int LDS_BYTES = 147456;

#define GAS __attribute__((address_space(1)))
#define LAS __attribute__((address_space(3)))
typedef unsigned short bf16;
typedef unsigned v4u __attribute__((ext_vector_type(4)));
typedef unsigned v2u __attribute__((ext_vector_type(2)));
typedef float f32x4 __attribute__((ext_vector_type(4)));
typedef GAS unsigned gu32;
#define RLX_AGENT __ATOMIC_RELAXED, __HIP_MEMORY_SCOPE_AGENT
#define LDS_WAIT() asm volatile("s_waitcnt lgkmcnt(0)" ::: "memory")
__device__ __forceinline__ unsigned f2bf(float f) { unsigned u = __builtin_bit_cast(unsigned, f); return (u + 0x7fffu + ((u >> 16) & 1u)) >> 16; }
__device__ __forceinline__ unsigned pk2(float lo, float hi) { return f2bf(lo) | (f2bf(hi) << 16); }
__device__ __forceinline__ float bf2f(unsigned short b) { return __builtin_bit_cast(float, (unsigned)b << 16); }
__device__ __forceinline__ float bflo(unsigned u) { return __builtin_bit_cast(float, u << 16); }
__device__ __forceinline__ float bfhi(unsigned u) { return __builtin_bit_cast(float, u & 0xffff0000u); }
__device__ __forceinline__ float siluf(float x) { return x * __builtin_amdgcn_rcpf(1.f + __expf(-x)); }
__device__ __forceinline__ float wave_sum(float v) {
#pragma unroll
    for (int o = 1; o < 64; o <<= 1) v += __shfl_xor(v, o);
    return v;
}
__device__ __forceinline__ float wave_max(float v) {
#pragma unroll
    for (int o = 1; o < 64; o <<= 1) v = fmaxf(v, __shfl_xor(v, o));
    return v;
}
#define XB_TMO      128
#define XB_XCNT(j)  (256  + 64 * (j))
#define XB_XSUB(j)  (1280 + 64 * (j))
#define XB_XGEN(j)  (2304 + 64 * (j))
#define XB_TOP      3328
#define XB_TOPGEN   3392
#define XCD_BAR_WORDS 3456
#define XB_SPIN_CAP (1u << 18)

__device__ __forceinline__ unsigned xb_ld(unsigned* p)              { return __hip_atomic_load(p, __ATOMIC_RELAXED, __HIP_MEMORY_SCOPE_AGENT); }
__device__ __forceinline__ unsigned xb_add(unsigned* p, unsigned v) { return __hip_atomic_fetch_add(p, v, __ATOMIC_RELAXED, __HIP_MEMORY_SCOPE_AGENT); }
__device__ __forceinline__ unsigned xb_xcc_id() { return (unsigned)__builtin_amdgcn_s_getreg((3 << 11) | 20) & 0xFu; }
#define XB_SPIN(cond, bar) do { unsigned _sp = 0; while (cond) { __builtin_amdgcn_s_sleep(1); \
    if ((++_sp & 255u) == 0u) { if (xb_ld(&(bar)[XB_TMO])) break; if (_sp > XB_SPIN_CAP) { atomicAdd(&(bar)[XB_TMO], 1u); break; } } } } while (0)

struct XcdBarrier {
    unsigned* bar; unsigned x;
    volatile LAS unsigned* st;
};

__device__ __forceinline__ XcdBarrier xcd_barrier_post(unsigned* bar, volatile LAS unsigned* st) {
    XcdBarrier b; b.bar = bar; b.x = xb_xcc_id(); b.st = st;
    if (threadIdx.x == 0) (void)xb_add(&bar[XB_XCNT(b.x)], 1u);
    return b;
}
__device__ __forceinline__ void xcd_barrier_complete(unsigned* bar, unsigned x, unsigned& nloc, unsigned& nx) {
    const unsigned G = gridDim.x * gridDim.y * gridDim.z;
    unsigned sum, cnt, mine, sp = 0u;
    for (;;) {
        sum = 0u; cnt = 0u; mine = 0u;
#pragma unroll
        for (unsigned j = 0; j < 16; ++j) { const unsigned c = xb_ld(&bar[XB_XCNT(j)]); sum += c; cnt += (c > 0u) ? 1u : 0u; mine = (j == x) ? c : mine; }
        if (sum == G) break;
        __builtin_amdgcn_s_sleep(1);
        if ((++sp & 255u) == 0u) { if (xb_ld(&bar[XB_TMO])) break; if (sp > XB_SPIN_CAP) { atomicAdd(&bar[XB_TMO], 1u); break; } }
    }
    nloc = mine > 0u ? mine : 1u; nx = cnt > 0u ? cnt : 1u;
}

__device__ __forceinline__ void xcd_barrier(const XcdBarrier& b) {
    asm volatile("s_waitcnt vmcnt(0)" ::: "memory");
    __syncthreads();
    if (threadIdx.x == 0) {
        unsigned* bar = b.bar;
        __builtin_amdgcn_s_waitcnt(0);
        unsigned nloc = b.st[0], nx = b.st[1];
        if (nloc == 0u) { xcd_barrier_complete(bar, b.x, nloc, nx); b.st[0] = nloc; b.st[1] = nx; }
        const unsigned old = xb_add(&bar[XB_XSUB(b.x)], 1u);
        const unsigned gen = old / nloc;
        if (old + 1u == (gen + 1u) * nloc) {
            __builtin_amdgcn_fence(__ATOMIC_RELEASE, "agent");
            asm volatile("s_waitcnt vmcnt(0)" ::: "memory");
            const unsigned og = xb_add(&bar[XB_TOP], 1u);
            const unsigned tg = og / nx;
            if (og + 1u == (tg + 1u) * nx) xb_add(&bar[XB_TOPGEN], 1u);
            else XB_SPIN(xb_ld(&bar[XB_TOPGEN]) == tg, bar);
            __builtin_amdgcn_fence(__ATOMIC_ACQUIRE, "agent");
            xb_add(&bar[XB_XGEN(b.x)], 1u);
            asm volatile("s_waitcnt vmcnt(0)" ::: "memory");
        } else {
            XB_SPIN(xb_ld(&bar[XB_XGEN(b.x)]) == gen, bar);
            __builtin_amdgcn_fence(__ATOMIC_ACQUIRE, "agent");
            asm volatile("s_waitcnt vmcnt(0)" ::: "memory");
        }
    }
    __syncthreads();
}


namespace pg8 {
struct EpiInProj {
    static constexpr bool PERM = true, AFTER_DRAIN = false;
    bf16_t* O; const float* cosT; const float* sinT;
    __device__ __forceinline__ void operator()(const f32x4 (&acc)[2][2][4][2], const Unit& u, int wr, int wc, int fr, int fq) const {
        const bool rope = (u.pn <= 2) && (u.pm < 64);
        const int row0 = u.pm * BM + wr * 64 + fr, col0 = u.pn * BM + wc * 32 + 8 * fq;
        const float sgn = (fq < 2) ? -1.f : 1.f;
#pragma unroll
        for (int ai = 0; ai < 2; ++ai)
#pragma unroll
            for (int m = 0; m < 4; ++m) {
                const int row = row0 + ai * HALF + m * 16;
                f32x4 cs0 = {1.f, 1.f, 1.f, 1.f}, cs1 = cs0, sn0 = {0.f, 0.f, 0.f, 0.f}, sn1 = sn0;
                if (rope) { const int t = row & 4095, pos = (wc & 1) ? (t & 63) : (t >> 6); const float* cp = cosT + pos * 16 + 8 * (fq & 1); const float* sp = sinT + pos * 16 + 8 * (fq & 1);
                    cs0 = *(const f32x4*)cp; cs1 = *(const f32x4*)(cp + 4); sn0 = *(const f32x4*)sp; sn1 = *(const f32x4*)(sp + 4); }
#pragma unroll
                for (int bj = 0; bj < 2; ++bj) {
                    f32x4 v0 = acc[ai][bj][m][0], v1 = acc[ai][bj][m][1];
                    if (rope) {
                        f32x4 p0, p1;
#pragma unroll
                        for (int j = 0; j < 4; ++j) { p0[j] = __shfl_xor(v0[j], 32); p1[j] = __shfl_xor(v1[j], 32); }
                        v0 = v0 * cs0 + (p0 * sn0) * sgn; v1 = v1 * cs1 + (p1 * sn1) * sgn;
                    }
                    const float sc = (u.pn == 2 || (u.pn == 1 && bj == 1)) ? 0.125f : 1.f;
                    v0 = v0 * sc; v1 = v1 * sc;
                    u32x4 w; w.x = cvt_pk_bf16(v0[0], v0[1]); w.y = cvt_pk_bf16(v0[2], v0[3]); w.z = cvt_pk_bf16(v1[0], v1[1]); w.w = cvt_pk_bf16(v1[2], v1[3]);
                    *(u32x4*)(O + (size_t)row * 3584 + col0 + bj * HALF) = w;
                }
            }
    }
};
struct EpiResid {
    static constexpr bool PERM = false, AFTER_DRAIN = false;
    float* H; const float* src_lat; const float* src_ctx; const float* gmod; int goff;
    __device__ __forceinline__ void operator()(const f32x4 (&acc)[2][2][4][2], const Unit& u, int wr, int wc, int fr, int fq) const {
        const int row0 = u.pm * BM + wr * 64 + fr, col0 = u.pn * BM + wc * 32 + 4 * fq;
        const int bi = (u.pm < 64) ? (u.pm >> 4) : 4;
        const float* src = (u.pm < 64) ? src_lat : src_ctx - (size_t)16384 * 1024;
        f32x4 gv[2][2];
#pragma unroll
        for (int bj = 0; bj < 2; ++bj)
#pragma unroll
            for (int n = 0; n < 2; ++n) gv[bj][n] = *(const f32x4*)(gmod + bi * 6144 + goff + col0 + bj * HALF + n * 16);
#pragma unroll
        for (int ai = 0; ai < 2; ++ai)
            {
                f32x4 sv[4][2][2];
#pragma unroll
                for (int m = 0; m < 4; ++m)
#pragma unroll
                    for (int bj = 0; bj < 2; ++bj)
#pragma unroll
                        for (int n = 0; n < 2; ++n) sv[m][bj][n] = *(const f32x4*)(src + (size_t)(row0 + ai * HALF + m * 16) * 1024 + col0 + bj * HALF + n * 16);
                asm volatile("" ::: "memory");
#pragma unroll
                for (int m = 0; m < 4; ++m)
#pragma unroll
                    for (int bj = 0; bj < 2; ++bj)
#pragma unroll
                        for (int n = 0; n < 2; ++n) *(f32x4*)(H + (size_t)(row0 + ai * HALF + m * 16) * 1024 + col0 + bj * HALF + n * 16) = sv[m][bj][n] + gv[bj][n] * acc[ai][bj][m][n];
                asm volatile("" ::: "memory");
            }
    }
};
struct EpiSwiglu {
    static constexpr bool PERM = true, AFTER_DRAIN = false;
    bf16_t* O;
    __device__ __forceinline__ void operator()(const f32x4 (&acc)[2][2][4][2], const Unit& u, int wr, int wc, int fr, int fq) const {
        const int row0 = u.pm * BM + wr * 64 + fr, col0 = u.pn * HALF + wc * 32 + 8 * fq;
#pragma unroll
        for (int ai = 0; ai < 2; ++ai)
#pragma unroll
            for (int m = 0; m < 4; ++m) {
                float hv[8];
#pragma unroll
                for (int n = 0; n < 2; ++n)
#pragma unroll
                    for (int j = 0; j < 4; ++j) { const float g = acc[ai][0][m][n][j], up = acc[ai][1][m][n][j]; hv[n * 4 + j] = g * __builtin_amdgcn_rcpf(1.f + __expf(-g)) * up; }
                u32x4 w; w.x = cvt_pk_bf16(hv[0], hv[1]); w.y = cvt_pk_bf16(hv[2], hv[3]); w.z = cvt_pk_bf16(hv[4], hv[5]); w.w = cvt_pk_bf16(hv[6], hv[7]);
                *(u32x4*)(O + (size_t)(row0 + ai * HALF + m * 16) * 2816 + col0) = w;
            }
    }
};
__device__ __forceinline__ unsigned pk4_fp8(float a, float b, float c2, float d) {
    a = fminf(fmaxf(a, -448.f), 448.f); b = fminf(fmaxf(b, -448.f), 448.f); c2 = fminf(fmaxf(c2, -448.f), 448.f); d = fminf(fmaxf(d, -448.f), 448.f);
    unsigned w = 0; w = __builtin_amdgcn_cvt_pk_fp8_f32(a, b, w, false); w = __builtin_amdgcn_cvt_pk_fp8_f32(c2, d, w, true); return w;
}
struct EpiSwigluF8 {
    static constexpr bool PERM = true, AFTER_DRAIN = false;
    unsigned char* O;
    __device__ __forceinline__ void operator()(const f32x4 (&acc)[2][2][4][2], const Unit& u, int wr, int wc, int fr, int fq) const {
        const int row0 = u.pm * BM + wr * 64 + fr, col0 = u.pn * HALF + wc * 32 + 8 * fq;
#pragma unroll
        for (int ai = 0; ai < 2; ++ai)
#pragma unroll
            for (int m = 0; m < 4; ++m) {
                float hv[8];
#pragma unroll
                for (int n = 0; n < 2; ++n)
#pragma unroll
                    for (int j = 0; j < 4; ++j) { const float g = acc[ai][0][m][n][j], up = acc[ai][1][m][n][j]; hv[n * 4 + j] = g * __builtin_amdgcn_rcpf(1.f + __expf(-g)) * up; }
                typedef unsigned u32x2 __attribute__((ext_vector_type(2)));
                u32x2 w; w.x = pk4_fp8(hv[0], hv[1], hv[2], hv[3]); w.y = pk4_fp8(hv[4], hv[5], hv[6], hv[7]);
                *(u32x2*)(O + (size_t)(row0 + ai * HALF + m * 16) * 2816 + col0) = w;
            }
    }
};
struct EpiSlots {
    static constexpr bool PERM = true, AFTER_DRAIN = false;
    bf16_t* S; const float* roww;
    __device__ __forceinline__ void operator()(const f32x4 (&acc)[2][2][4][2], const Unit& u, int wr, int wc, int fr, int fq) const {
        const int row0 = u.pm * BM + wr * 64 + fr, col0 = u.pn * BM + wc * 32 + 8 * fq;
#pragma unroll
        for (int ai = 0; ai < 2; ++ai)
#pragma unroll
            for (int m = 0; m < 4; ++m) { const int row = row0 + ai * HALF + m * 16; const float w = roww[row]; bf16_t* rowp = S + (size_t)row * 1024 + col0;
#pragma unroll
                for (int bj = 0; bj < 2; ++bj) { const f32x4 v0 = acc[ai][bj][m][0] * w, v1 = acc[ai][bj][m][1] * w;
                    u32x4 q; q.x = cvt_pk_bf16(v0[0], v0[1]); q.y = cvt_pk_bf16(v0[2], v0[3]); q.z = cvt_pk_bf16(v1[0], v1[1]); q.w = cvt_pk_bf16(v1[2], v1[3]);
                    *(u32x4*)(rowp + bj * HALF) = q; } }
    }
};
struct EpiPartial {
    static constexpr bool PERM = false, AFTER_DRAIN = false;
    float* P; const float* gmod; int goff;
    __device__ __forceinline__ void operator()(const f32x4 (&acc)[2][2][4][2], const Unit& u, int wr, int wc, int fr, int fq) const {
        const int row0 = u.pm * BM + wr * 64 + fr, col0 = u.pn * BM + wc * 32 + 4 * fq;
        f32x4 gv[2][2];
#pragma unroll
        for (int bj = 0; bj < 2; ++bj)
#pragma unroll
            for (int n = 0; n < 2; ++n) gv[bj][n] = *(const f32x4*)(gmod + 4 * 6144 + goff + col0 + bj * HALF + n * 16);
        float* base = P + (size_t)u.ks * 1024 * 1024;
#pragma unroll
        for (int ai = 0; ai < 2; ++ai)
#pragma unroll
            for (int m = 0; m < 4; ++m) { float* rowp = base + (size_t)(row0 + ai * HALF + m * 16) * 1024 + col0;
#pragma unroll
                for (int bj = 0; bj < 2; ++bj)
#pragma unroll
                    for (int n = 0; n < 2; ++n) *(f32x4*)(rowp + bj * HALF + n * 16) = gv[bj][n] * acc[ai][bj][m][n]; }
    }
};
struct SplitOrder {
    int nS, G, c;
    __device__ void init(int nS_, int G_, int c_) { nS = nS_; G = G_; c = c_; }
    __device__ bool next(int i, Unit& u) const { const int L = i * G + c; if (L >= 16 * nS) return false; u.ks = L % nS; const int t = L / nS; u.pm = t >> 2; u.pn = t & 3; return true; }
    __device__ __forceinline__ void a_ready(const Unit&) const {}
    __device__ __forceinline__ void done(const Unit&) const {}
    __device__ __forceinline__ const bf16_t* bt(const Gemm& g, const Unit&) const { return g.Bt; }
};
struct MoeOrder {
    StaticOrder so; const int* tile_e; size_t estride;
    __device__ void init(int T, int N, int G, int c, const int* te, size_t es) { so.init(T * BM, N, G, c); tile_e = te; estride = es; }
    __device__ bool next(int i, Unit& u) const { return so.next(i, u); }
    __device__ __forceinline__ void a_ready(const Unit&) const {}
    __device__ __forceinline__ void done(const Unit&) const {}
    __device__ __forceinline__ const bf16_t* bt(const Gemm& g, const Unit& u) const { const int e = __builtin_amdgcn_readfirstlane(tile_e[u.pm]); return g.Bt + (size_t)e * estride; }
};
}

struct Ctx {
    LAS unsigned char* lds;
    int tid, lane, wave, G, bx, gw, NGW, gtid, NT;
    unsigned char* ws;
    const float* in[21];
};
#define WSP(T, off) ((T*)(C.ws + (off)))

template <bool ILV>
__device__ __forceinline__ void transpose_item(const float* W, int K, int N, bf16* WT, LAS float* scr, int item, int lane) {
    const int nblk = N / 32, kb = item / nblk, nb = item % nblk, k0 = 64 * kb, n0 = 32 * nb;
    int drow = n0;
    if (ILV) drow = (n0 < DFF) ? (n0 / 128) * 256 + (n0 % 128) : ((n0 - DFF) / 128) * 256 + 128 + ((n0 - DFF) % 128);
#pragma unroll 8
    for (int i = 0; i < 32; ++i) { const int kk = 2 * i + (lane >> 5); scr[kk * 33 + (lane & 31)] = __builtin_nontemporal_load(&W[(size_t)(k0 + kk) * N + n0 + (lane & 31)]); }
    LDS_WAIT(); asm volatile("" ::: "memory");
    const int c = lane & 7;
#pragma unroll
    for (int j = 0; j < 4; ++j) { const int n = (lane >> 3) + 8 * j; const LAS float* s = scr + (8 * c) * 33 + n;
        v4u o; o.x = pk2(s[0 * 33], s[1 * 33]); o.y = pk2(s[2 * 33], s[3 * 33]); o.z = pk2(s[4 * 33], s[5 * 33]); o.w = pk2(s[6 * 33], s[7 * 33]);
        *(v4u*)(WT + (size_t)(drow + n) * K + k0 + 8 * c) = o; }
    LDS_WAIT(); asm volatile("" ::: "memory");
}
template <bool ILV>
__device__ __forceinline__ void transpose_item_f8(const float* W, int K, int N, unsigned char* WT, LAS float* scr, int item, int lane) {
    const int nblk = N / 32, kb = item / nblk, nb = item % nblk, k0 = 64 * kb, n0 = 32 * nb;
    int drow = n0;
    if (ILV) drow = (n0 < DFF) ? (n0 / 128) * 256 + (n0 % 128) : ((n0 - DFF) / 128) * 256 + 128 + ((n0 - DFF) % 128);
#pragma unroll 8
    for (int i = 0; i < 32; ++i) { const int kk = 2 * i + (lane >> 5); scr[kk * 33 + (lane & 31)] = __builtin_nontemporal_load(&W[(size_t)(k0 + kk) * N + n0 + (lane & 31)]); }
    LDS_WAIT(); asm volatile("" ::: "memory");
    const int c = lane & 7;
#pragma unroll
    for (int j = 0; j < 4; ++j) { const int n = (lane >> 3) + 8 * j; const LAS float* s = scr + (8 * c) * 33 + n;
        v2u o; o.x = pg8::pk4_fp8(s[0 * 33] * 64.f, s[1 * 33] * 64.f, s[2 * 33] * 64.f, s[3 * 33] * 64.f); o.y = pg8::pk4_fp8(s[4 * 33] * 64.f, s[5 * 33] * 64.f, s[6 * 33] * 64.f, s[7 * 33] * 64.f);
        *(v2u*)(WT + (size_t)(drow + n) * K + k0 + 8 * c) = o; }
    LDS_WAIT(); asm volatile("" ::: "memory");
}
struct ItemDesc { const float* W; unsigned char* WT; int K, N, k0, n0, drow, f8; };
__device__ __forceinline__ ItemDesc item_desc(const Ctx& C, int it) {
    const float* w_in = C.in[8]; const float* w_out = C.in[9]; const float* ffn_in = C.in[14]; const float* ffn_out = C.in[15]; const float* moe_in = C.in[18]; const float* moe_out = C.in[19];
    constexpr int I_WIN = 16 * (NPROJ / 32), I_WOUT = 16 * 32, I_FIN = 16 * (2 * DFF / 32), I_FOUT = (DFF / 64) * 32;
    ItemDesc d; int r = it, item, ilv = 0; d.f8 = 0;
    if (r < 2 * I_WIN) { const int l = r / I_WIN; d.W = w_in + (size_t)l * D * NPROJ; d.K = D; d.N = NPROJ; d.WT = (unsigned char*)(WSP(bf16, WS_WIN) + (size_t)l * NPROJP * D); item = r % I_WIN; }
    else if ((r -= 2 * I_WIN) < 2 * I_WOUT) { const int l = r / I_WOUT; d.W = w_out + (size_t)l * D * D; d.K = D; d.N = D; d.WT = (unsigned char*)(WSP(bf16, WS_WOUT) + (size_t)l * D * D); item = r % I_WOUT; }
    else if ((r -= 2 * I_WOUT) < I_FIN) { d.W = ffn_in; d.K = D; d.N = 2 * DFF; d.WT = (unsigned char*)WSP(bf16, WS_FIN); item = r; ilv = 1; }
    else if ((r -= I_FIN) < I_FOUT) { d.W = ffn_out; d.K = DFF; d.N = D; d.WT = (unsigned char*)WSP(bf16, WS_FOUT); item = r; }
    else if ((r -= I_FOUT) < NE * I_FIN) { const int e = r / I_FIN; d.W = moe_in + (size_t)e * D * 2 * DFF; d.K = D; d.N = 2 * DFF; d.WT = WSP(unsigned char, WS_MIN) + (size_t)e * 2 * DFF * D; item = r % I_FIN; ilv = 1; d.f8 = 1; }
    else { r -= NE * I_FIN; const int e = r / I_FOUT; d.W = moe_out + (size_t)e * DFF * D; d.K = DFF; d.N = D; d.WT = WSP(unsigned char, WS_MOUT) + (size_t)e * D * DFF; item = r % I_FOUT; d.f8 = 1; }
    const int nblk = d.N / 32, kb = item / nblk, nb = item % nblk; d.k0 = 64 * kb; d.n0 = 32 * nb;
    d.drow = ilv ? ((d.n0 < DFF) ? (d.n0 / 128) * 256 + (d.n0 % 128) : ((d.n0 - DFF) / 128) * 256 + 128 + ((d.n0 - DFF) % 128)) : d.n0;
    return d;
}
__device__ __forceinline__ void item_load(const ItemDesc& d, int lane, float (&v)[32]) {
    const float* p = d.W + (size_t)(d.k0 + (lane >> 5)) * d.N + d.n0 + (lane & 31);
#pragma unroll
    for (int i = 0; i < 32; ++i) v[i] = __builtin_nontemporal_load(p + (size_t)(2 * i) * d.N);
}
__device__ __forceinline__ void item_finish(const ItemDesc& d, int lane, LAS float* scr, const float (&v)[32]) {
#pragma unroll
    for (int i = 0; i < 32; ++i) scr[(2 * i + (lane >> 5)) * 33 + (lane & 31)] = v[i];
    LDS_WAIT(); asm volatile("" ::: "memory");
    const int c = lane & 7;
    if (d.f8) {
#pragma unroll
        for (int j = 0; j < 4; ++j) { const int n = (lane >> 3) + 8 * j; const LAS float* s = scr + (8 * c) * 33 + n;
            v2u o; o.x = pg8::pk4_fp8(s[0 * 33] * 64.f, s[1 * 33] * 64.f, s[2 * 33] * 64.f, s[3 * 33] * 64.f); o.y = pg8::pk4_fp8(s[4 * 33] * 64.f, s[5 * 33] * 64.f, s[6 * 33] * 64.f, s[7 * 33] * 64.f);
            *(v2u*)(d.WT + (size_t)(d.drow + n) * d.K + d.k0 + 8 * c) = o; }
    } else {
#pragma unroll
        for (int j = 0; j < 4; ++j) { const int n = (lane >> 3) + 8 * j; const LAS float* s = scr + (8 * c) * 33 + n;
            v4u o; o.x = pk2(s[0 * 33], s[1 * 33]); o.y = pk2(s[2 * 33], s[3 * 33]); o.z = pk2(s[4 * 33], s[5 * 33]); o.w = pk2(s[6 * 33], s[7 * 33]);
            *(v4u*)((bf16*)d.WT + (size_t)(d.drow + n) * d.K + d.k0 + 8 * c) = o; }
    }
    LDS_WAIT(); asm volatile("" ::: "memory");
}
__device__ __forceinline__ void p_prologue(const Ctx& C) {
    const float* cvec = C.in[1]; const float* cctx = C.in[3]; const float* ada_w = C.in[4]; const float* ada_b = C.in[5];
    for (int task = C.G - 1 - C.bx; task < 48; task += C.G) {
        const int layer = task / 24, cg = task % 24, col = 256 * cg + 4 * C.lane;
        LAS float* stab = (LAS float*)(C.lds + RING_OFF + 49152);
        __syncthreads();
        for (int i = C.tid; i < 5 * D; i += NTHR) { const int r = i >> 10, k = i & 1023; stab[i] = siluf((r < 4) ? cvec[r * D + k] : cctx[k]); }
        __syncthreads();
        f32x4 acc[5];
#pragma unroll
        for (int r = 0; r < 5; ++r) acc[r] = (f32x4){0.f, 0.f, 0.f, 0.f};
#pragma unroll 16
        for (int kk = 0; kk < 128; ++kk) {
            const int k = 128 * C.wave + kk;
            const f32x4 w = __builtin_nontemporal_load((const f32x4*)(ada_w + ((size_t)layer * D + k) * 6144 + col));
#pragma unroll
            for (int r = 0; r < 5; ++r) acc[r] = acc[r] + w * stab[r * D + k];
        }
        __syncthreads();
        LAS float* red = (LAS float*)(C.lds + RING_OFF);
#pragma unroll
        for (int r = 0; r < 5; ++r) *(LAS f32x4*)(red + (C.wave * 5 + r) * 256 + 4 * C.lane) = acc[r];
        __syncthreads();
        for (int o = C.tid; o < 5 * 256; o += NTHR) {
            const int r = o >> 8, cc = o & 255;
            float s = ada_b[layer * 6144 + 256 * cg + cc];
#pragma unroll
            for (int w = 0; w < 8; ++w) s += red[(w * 5 + r) * 256 + cc];
            WSP(float, WS_MOD)[(layer * 5 + r) * 6144 + 256 * cg + cc] = s;
        }
        __syncthreads();
    }
    LAS float* scr = (LAS float*)(C.lds + RING_OFF + C.wave * 16384);
    constexpr int NITEMS = 2 * (16 * (NPROJ / 32)) + 2 * (16 * 32) + 16 * (2 * DFF / 32) + (DFF / 64) * 32 + NE * (16 * (2 * DFF / 32) + (DFF / 64) * 32);
    {
        float va[32], vb[32];
        const int nmod = (C.G > 96) ? 48 : 0, first_mod = C.G - nmod;
        const int vw = (C.bx < first_mod) ? C.gw : ((C.wave < 6) ? first_mod * NWAVES + (C.bx - first_mod) * 6 + C.wave : NITEMS), nvw = first_mod * NWAVES + nmod * 6;
        int it0 = vw;
        if (it0 < NITEMS) {
            ItemDesc d0 = item_desc(C, it0), d1 = d0; item_load(d0, C.lane, va);
            for (;;) {
                const int it1 = it0 + nvw; const bool h1 = it1 < NITEMS;
                if (h1) { d1 = item_desc(C, it1); item_load(d1, C.lane, vb); }
                item_finish(d0, C.lane, scr, va);
                if (!h1) break;
                it0 = it1 + nvw; const bool h0 = it0 < NITEMS;
                if (h0) { d0 = item_desc(C, it0); item_load(d0, C.lane, va); }
                item_finish(d1, C.lane, scr, vb);
                if (!h0) break;
            }
        }
    }
    for (int idx = C.gtid; idx < 1024; idx += C.NT) {
        const int pos = idx >> 4, i = idx & 15;
        const float inv = powf(10000.0f, -(float)i / 16.0f), ang = (float)pos * inv;
        WSP(float, WS_ROPE)[idx] = cosf(ang); WSP(float, WS_ROPE)[1024 + idx] = sinf(ang);
    }
}
template <int NP>
__device__ __forceinline__ void norm_row(const float* hrow, const float* gvec, const float* sh, const float* sc, bf16* orow, int lane, f32x4 (&a)[4], const float* prow = nullptr, float* hout = nullptr) {
    float ss = 0.f;
#pragma unroll
    for (int j = 0; j < 4; ++j) { a[j] = *(const f32x4*)(hrow + 4 * lane + 256 * j);
        if (NP > 0) {
#pragma unroll
            for (int p = 0; p < NP; ++p) a[j] = a[j] + *(const f32x4*)(prow + (size_t)p * 1024 * 1024 + 4 * lane + 256 * j);
            if (hout) *(f32x4*)(hout + 4 * lane + 256 * j) = a[j]; }
        ss += (a[j].x * a[j].x + a[j].y * a[j].y) + (a[j].z * a[j].z + a[j].w * a[j].w); }
    const float rstd = 1.0f / sqrtf(wave_sum(ss) * (1.0f / D) + EPS);
#pragma unroll
    for (int j = 0; j < 4; ++j) {
        const int c = 4 * lane + 256 * j;
        const f32x4 g = *(const f32x4*)(gvec + c), s1 = *(const f32x4*)(sc + c), s0 = *(const f32x4*)(sh + c);
        a[j] = (a[j] * rstd * g) * (s1 + 1.0f) + s0;
        v2u o; o.x = pk2(a[j].x, a[j].y); o.y = pk2(a[j].z, a[j].w);
        *(v2u*)(orow + c) = o;
    }
}
template <bool ROUTER, int NPC>
__device__ __forceinline__ void p_norm(const Ctx& C, int layer, int which, bool do_ctx, bool from_input, bool ctx_from_input, bool ctx_write_h) {
    const float* gvec = (which ? C.in[7] : C.in[6]) + layer * D;
    const float* mod = WSP(float, WS_MOD) + layer * 30720;
    const int o_sh = which ? 3 * D : 0, o_sc = which ? 4 * D : D;
    f32x4 rwr[4][4][2]; float rbr[8];
    if (ROUTER) { const float* rw = C.in[16]; const float* rb = C.in[17];
#pragma unroll
        for (int jj = 0; jj < 4; ++jj)
#pragma unroll
            for (int i = 0; i < 4; ++i) { const int k = 4 * C.lane + 256 * jj + i; rwr[jj][i][0] = *(const f32x4*)(rw + k * 8); rwr[jj][i][1] = *(const f32x4*)(rw + k * 8 + 4); }
#pragma unroll
        for (int e = 0; e < 8; ++e) rbr[e] = rb[e]; }
    LAS int* lcnt = (LAS int*)(C.lds + RING_OFF);
    for (int blk = C.bx; blk < 256; blk += C.G) {
        if (ROUTER) { if (C.tid < 8) lcnt[C.tid] = 0; __syncthreads(); }
        for (int j = 0; j < 8; ++j) {
            const int m = 64 * blk + 8 * C.wave + j, b = m >> 12;
            f32x4 a[4];
            norm_row<0>((from_input ? C.in[0] : WSP(float, WS_H)) + (size_t)m * D, gvec, mod + b * 6144 + o_sh, mod + b * 6144 + o_sc, WSP(bf16, WS_A) + (size_t)m * D, C.lane, a);
            if (ROUTER) {
                float lg[8];
#pragma unroll
                for (int e = 0; e < 8; ++e) lg[e] = 0.f;
#pragma unroll
                for (int jj = 0; jj < 4; ++jj)
#pragma unroll
                    for (int i = 0; i < 4; ++i) {
                        const float av = a[jj][i]; const f32x4 w0 = rwr[jj][i][0], w1 = rwr[jj][i][1];
                        lg[0] += av * w0.x; lg[1] += av * w0.y; lg[2] += av * w0.z; lg[3] += av * w0.w;
                        lg[4] += av * w1.x; lg[5] += av * w1.y; lg[6] += av * w1.z; lg[7] += av * w1.w;
                    }
                float r4[4], r2[2], r1;
#pragma unroll
                for (int e = 0; e < 4; ++e) { const bool hi = (C.lane & 1) != 0; const float keep = hi ? lg[e + 4] : lg[e], send = hi ? lg[e] : lg[e + 4]; r4[e] = keep + __shfl_xor(send, 1); }
#pragma unroll
                for (int e = 0; e < 2; ++e) { const bool hi = (C.lane & 2) != 0; const float keep = hi ? r4[e + 2] : r4[e], send = hi ? r4[e] : r4[e + 2]; r2[e] = keep + __shfl_xor(send, 2); }
                { const bool hi = (C.lane & 4) != 0; const float keep = hi ? r2[1] : r2[0], send = hi ? r2[0] : r2[1]; r1 = keep + __shfl_xor(send, 4); }
                r1 += __shfl_xor(r1, 8); r1 += __shfl_xor(r1, 16); r1 += __shfl_xor(r1, 32);
#pragma unroll
                for (int e = 0; e < 8; ++e) { const int src = ((e >> 2) & 1) | (((e >> 1) & 1) << 1) | ((e & 1) << 2); lg[e] = __shfl(r1, src) + rbr[e]; }
                int e1 = 0; float v1 = lg[0];
#pragma unroll
                for (int e = 1; e < 8; ++e) if (lg[e] > v1) { v1 = lg[e]; e1 = e; }
                int e2 = -1; float v2 = -3.0e38f;
#pragma unroll
                for (int e = 0; e < 8; ++e) if (e != e1 && lg[e] > v2) { v2 = lg[e]; e2 = e; }
                const float ex = __expf(v2 - v1), w1v = 1.0f / (1.0f + ex), w2v = ex * w1v;
                if (C.lane == 0) {
                    WSP(int, WS_TOKE)[m] = e1 | (e2 << 8);
                    WSP(float, WS_TOKW)[2 * m] = w1v; WSP(float, WS_TOKW)[2 * m + 1] = w2v;
                    atomicAdd((int*)(lcnt + e1), 1); atomicAdd((int*)(lcnt + e2), 1);
                }
            }
        }
        if (ROUTER) { __syncthreads(); if (C.tid < 8) WSP(int, WS_CNT)[blk * 8 + C.tid] = lcnt[C.tid]; __syncthreads(); }
    }
    if (do_ctx) {
        for (int cm = C.gw; cm < RCTX; cm += C.NGW) {
            const int m = RLAT + cm; f32x4 a[4];
            norm_row<NPC>(ctx_from_input ? C.in[2] + (size_t)cm * D : WSP(float, WS_H) + (size_t)m * D, gvec, mod + 4 * 6144 + o_sh, mod + 4 * 6144 + o_sc, WSP(bf16, WS_A) + (size_t)m * D, C.lane, a, WSP(float, WS_PART) + (size_t)cm * D, ctx_write_h ? WSP(float, WS_H) + (size_t)m * D : nullptr);
        }
    }
}
typedef short bf16x8 __attribute__((ext_vector_type(8)));
constexpr float LOG2E = 1.4426950408889634f;
constexpr int VTL_STRIDE = 1040, VTC_STRIDE = 528;
constexpr int NA_VTL = 0, NA_VTC = 64 * VTL_STRIDE, NA_RPB = NA_VTC + 64 * VTC_STRIDE, NA_XCH = 102400;
static_assert(NA_RPB + 465 * 4 <= NA_XCH && NA_XCH + 4 * 64 * 18 * 4 <= RING_BYTES, "NA LDS map");
__device__ __forceinline__ unsigned cvtpk(float lo, float hi) { unsigned r; asm volatile("v_cvt_pk_bf16_f32 %0, %1, %2" : "=v"(r) : "v"(lo), "v"(hi)); return r; }

template <bool LOCAL, int NT, int KT0 = 0, int KT1 = NT>
__device__ __forceinline__ void load_kfrags(bf16x8 (&kf)[NT][2], const bf16* Kbase, int krow0, int lane) {
    const int n = lane & 15, g = lane >> 4;
#pragma unroll
    for (int kt = KT0; kt < KT1; ++kt) {
        const int krow = LOCAL ? krow0 + (kt >> 1) * 64 + (kt & 1) * 16 + n : krow0 + 16 * kt + n;
        const bf16x8* kp = (const bf16x8*)(Kbase + (size_t)krow * NPROJP + 8 * g);
        kf[kt][0] = kp[0]; kf[kt][1] = kp[4];
    }
}
template <bool LOCAL, int NT>
__device__ __forceinline__ void attn_wave_core(const bf16x8 (&kfA)[8][2], const bf16* Kbase, int krow0, const bf16x8 (&qf)[2], LAS const unsigned char* vt, int vstride,
                                               LAS const float* rpb, int r, int r0, int qc, int cbase, float& m_out, float& l_out, f32x4 (&o)[4], int lane) {
    const int n = lane & 15, g = lane >> 4;
    f32x4 s[NT];
#pragma unroll
    for (int kt = 0; kt < 8; ++kt) {
        f32x4 acc = {0.f, 0.f, 0.f, 0.f};
        acc = __builtin_amdgcn_mfma_f32_16x16x32_bf16(kfA[kt][0], qf[0], acc, 0, 0, 0);
        acc = __builtin_amdgcn_mfma_f32_16x16x32_bf16(kfA[kt][1], qf[1], acc, 0, 0, 0);
        s[kt] = acc;
    }
    if constexpr (NT > 8) {
        __builtin_amdgcn_sched_barrier(0);
        bf16x8 kfB[NT][2];
        load_kfrags<LOCAL, NT, 8, NT>(kfB, Kbase, krow0, lane);
#pragma unroll
        for (int kt = 8; kt < NT; ++kt) {
            f32x4 acc = {0.f, 0.f, 0.f, 0.f};
            acc = __builtin_amdgcn_mfma_f32_16x16x32_bf16(kfB[kt][0], qf[0], acc, 0, 0, 0);
            acc = __builtin_amdgcn_mfma_f32_16x16x32_bf16(kfB[kt][1], qf[1], acc, 0, 0, 0);
            s[kt] = acc;
        }
        __builtin_amdgcn_sched_barrier(0);
    }
    const float SC = 0.125f * LOG2E;
    const int c0 = min(max(qc - 8, 0), 48);
    float mx = -1.0e30f;
#pragma unroll
    for (int kt = 0; kt < NT; ++kt)
#pragma unroll
        for (int reg = 0; reg < 4; ++reg) {
            float v = s[kt][reg] * SC;
            if (LOCAL) {
                const int i = kt >> 1, kc = cbase + 16 * (kt & 1) + 4 * g + reg;
                const int dr = r0 + i - r + 7, dc = min(max(kc - qc, -15), 15) + 15;
                const float bias = rpb[dr * 31 + dc];
                v = (kc >= c0 && kc < c0 + 16) ? v + bias : -1.0e30f;
            }
            s[kt][reg] = v; mx = fmaxf(mx, v);
        }
    mx = fmaxf(mx, __shfl_xor(mx, 16)); mx = fmaxf(mx, __shfl_xor(mx, 32));
    float l = 0.f;
#pragma unroll
    for (int kt = 0; kt < NT; ++kt)
#pragma unroll
        for (int reg = 0; reg < 4; ++reg) { const float p = __builtin_amdgcn_exp2f(s[kt][reg] - mx); s[kt][reg] = p; l += p; }
    l += __shfl_xor(l, 16); l += __shfl_xor(l, 32);
#pragma unroll
    for (int dt = 0; dt < 4; ++dt) o[dt] = (f32x4){0.f, 0.f, 0.f, 0.f};
#pragma unroll
    for (int u = 0; u < NT / 2; ++u) {
        v4u pw; pw.x = cvtpk(s[2 * u][0], s[2 * u][1]); pw.y = cvtpk(s[2 * u][2], s[2 * u][3]); pw.z = cvtpk(s[2 * u + 1][0], s[2 * u + 1][1]); pw.w = cvtpk(s[2 * u + 1][2], s[2 * u + 1][3]);
        const bf16x8 pb = __builtin_bit_cast(bf16x8, pw);
        const int slotA = LOCAL ? ((r0 + u) & 7) * 64 + cbase + 4 * g : 32 * u + 4 * g, slotB = slotA + 16;
#pragma unroll
        for (int dt = 0; dt < 4; ++dt) {
            LAS const unsigned char* rowp = vt + (16 * dt + n) * vstride;
            const v2u a_lo = *(LAS const v2u*)(rowp + slotA * 2), a_hi = *(LAS const v2u*)(rowp + slotB * 2);
            v4u aw; aw.x = a_lo.x; aw.y = a_lo.y; aw.z = a_hi.x; aw.w = a_hi.y;
            o[dt] = __builtin_amdgcn_mfma_f32_16x16x32_bf16(__builtin_bit_cast(bf16x8, aw), pb, o[dt], 0, 0, 0);
        }
    }
    m_out = mx; l_out = l;
}
__device__ __forceinline__ void attn_wave_mixed(const bf16x8 (&kfA)[8][2], const bf16* Kbase, int kcrow0, const bf16x8 (&qf)[2], LAS const unsigned char* vtl, LAS const unsigned char* vtc,
                                                LAS const float* rpb, int part, int r, int r0, int qc, int cbase, float& m_out, float& l_out, f32x4 (&o)[4], int lane) {
    const int n = lane & 15, g = lane >> 4;
    f32x4 s[16];
#pragma unroll
    for (int kt = 0; kt < 8; ++kt) {
        f32x4 acc = {0.f, 0.f, 0.f, 0.f};
        acc = __builtin_amdgcn_mfma_f32_16x16x32_bf16(kfA[kt][0], qf[0], acc, 0, 0, 0);
        acc = __builtin_amdgcn_mfma_f32_16x16x32_bf16(kfA[kt][1], qf[1], acc, 0, 0, 0);
        s[kt] = acc;
    }
    __builtin_amdgcn_sched_barrier(0);
    {
        bf16x8 kfB[8][2];
        load_kfrags<false, 8>(kfB, Kbase, kcrow0, lane);
#pragma unroll
        for (int kt = 0; kt < 8; ++kt) {
            f32x4 acc = {0.f, 0.f, 0.f, 0.f};
            acc = __builtin_amdgcn_mfma_f32_16x16x32_bf16(kfB[kt][0], qf[0], acc, 0, 0, 0);
            acc = __builtin_amdgcn_mfma_f32_16x16x32_bf16(kfB[kt][1], qf[1], acc, 0, 0, 0);
            s[8 + kt] = acc;
        }
    }
    __builtin_amdgcn_sched_barrier(0);
    const float SC = 0.125f * LOG2E;
    const int c0 = min(max(qc - 8, 0), 48);
    float mx = -1.0e30f;
#pragma unroll
    for (int kt = 0; kt < 16; ++kt)
#pragma unroll
        for (int reg = 0; reg < 4; ++reg) {
            float v = s[kt][reg] * SC;
            if (kt < 8) {
                const int i = 4 * part + (kt >> 1), kc = cbase + 16 * (kt & 1) + 4 * g + reg;
                const int dr = r0 + i - r + 7, dc = min(max(kc - qc, -15), 15) + 15;
                const float bias = rpb[dr * 31 + dc];
                v = (kc >= c0 && kc < c0 + 16) ? v + bias : -1.0e30f;
            }
            s[kt][reg] = v; mx = fmaxf(mx, v);
        }
    mx = fmaxf(mx, __shfl_xor(mx, 16)); mx = fmaxf(mx, __shfl_xor(mx, 32));
    float l = 0.f;
#pragma unroll
    for (int kt = 0; kt < 16; ++kt)
#pragma unroll
        for (int reg = 0; reg < 4; ++reg) { const float p = __builtin_amdgcn_exp2f(s[kt][reg] - mx); s[kt][reg] = p; l += p; }
    l += __shfl_xor(l, 16); l += __shfl_xor(l, 32);
#pragma unroll
    for (int dt = 0; dt < 4; ++dt) o[dt] = (f32x4){0.f, 0.f, 0.f, 0.f};
#pragma unroll
    for (int u = 0; u < 8; ++u) {
        v4u pw; pw.x = cvtpk(s[2 * u][0], s[2 * u][1]); pw.y = cvtpk(s[2 * u][2], s[2 * u][3]); pw.z = cvtpk(s[2 * u + 1][0], s[2 * u + 1][1]); pw.w = cvtpk(s[2 * u + 1][2], s[2 * u + 1][3]);
        const bf16x8 pb = __builtin_bit_cast(bf16x8, pw);
        const bool loc = (u < 4);
        const int slotA = loc ? ((r0 + 4 * part + u) & 7) * 64 + cbase + 4 * g : 128 * part + 32 * (u - 4) + 4 * g, slotB = slotA + 16;
        LAS const unsigned char* vt = loc ? vtl : vtc; const int vstride = loc ? VTL_STRIDE : VTC_STRIDE;
#pragma unroll
        for (int dt = 0; dt < 4; ++dt) {
            LAS const unsigned char* rowp = vt + (16 * dt + n) * vstride;
            const v2u a_lo = *(LAS const v2u*)(rowp + slotA * 2), a_hi = *(LAS const v2u*)(rowp + slotB * 2);
            v4u aw; aw.x = a_lo.x; aw.y = a_lo.y; aw.z = a_hi.x; aw.w = a_hi.y;
            o[dt] = __builtin_amdgcn_mfma_f32_16x16x32_bf16(__builtin_bit_cast(bf16x8, aw), pb, o[dt], 0, 0, 0);
        }
    }
    m_out = mx; l_out = l;
}
template <int NCH>
__device__ __forceinline__ void vt_scatter(const bf16* vrow, int ch0, LAS unsigned char* vt, int vstride, int slot) {
    v4u x[NCH];
#pragma unroll
    for (int c = 0; c < NCH; ++c) x[c] = *(const v4u*)(vrow + 8 * (ch0 + c));
#pragma unroll
    for (int c = 0; c < NCH; ++c) {
        LAS unsigned char* p = vt + (8 * (ch0 + c)) * vstride + slot * 2;
        *(LAS unsigned short*)(p) = (unsigned short)(x[c].x & 0xffffu); *(LAS unsigned short*)(p + vstride) = (unsigned short)(x[c].x >> 16);
        *(LAS unsigned short*)(p + 2 * vstride) = (unsigned short)(x[c].y & 0xffffu); *(LAS unsigned short*)(p + 3 * vstride) = (unsigned short)(x[c].y >> 16);
        *(LAS unsigned short*)(p + 4 * vstride) = (unsigned short)(x[c].z & 0xffffu); *(LAS unsigned short*)(p + 5 * vstride) = (unsigned short)(x[c].z >> 16);
        *(LAS unsigned short*)(p + 6 * vstride) = (unsigned short)(x[c].w & 0xffffu); *(LAS unsigned short*)(p + 7 * vstride) = (unsigned short)(x[c].w >> 16);
    }
}
__device__ __forceinline__ void attn_merge_store(const Ctx& C, int part, int qb, float m, float l, f32x4 (&o)[4], int qrow0, int h) {
    LAS float* xch = (LAS float*)(C.lds + RING_OFF + NA_XCH) + (qb * 64 + C.lane) * 18;
    if (part == 1) {
        xch[0] = m; xch[1] = l;
#pragma unroll
        for (int dt = 0; dt < 4; ++dt) *(LAS f32x4*)(xch + 2 + 4 * dt) = o[dt];
    }
    __syncthreads();
    if (part == 0) {
        const float m2 = xch[0], l2 = xch[1];
        const float mt = fmaxf(m, m2), f1 = __builtin_amdgcn_exp2f(m - mt), f2 = __builtin_amdgcn_exp2f(m2 - mt);
        const float inv = 1.0f / (l * f1 + l2 * f2);
        const int n = C.lane & 15, g = C.lane >> 4;
        bf16* yp = WSP(bf16, WS_YMIX) + (size_t)(qrow0 + n) * D + 640 + 64 * h + 4 * g;
#pragma unroll
        for (int dt = 0; dt < 4; ++dt) {
            const f32x4 o2 = *(LAS f32x4*)(xch + 2 + 4 * dt);
            const f32x4 v = (o[dt] * f1 + o2 * f2) * inv;
            v2u w; w.x = cvtpk(v[0], v[1]); w.y = cvtpk(v[2], v[3]);
            *(v2u*)(yp + 16 * dt) = w;
        }
    }
}
__device__ __forceinline__ void na_band(const Ctx& C, int layer, int u0, int nu) {
    const bf16* PROJ = WSP(bf16, WS_PROJ);
    LAS unsigned char* vtl = C.lds + RING_OFF + NA_VTL; LAS unsigned char* vtc = C.lds + RING_OFF + NA_VTC; LAS float* rpb = (LAS float*)(C.lds + RING_OFF + NA_RPB);
    const int qb = C.wave & 3, part = C.wave >> 2, n = C.lane & 15, g = C.lane >> 4;
    const int cbase = (qb == 0) ? 0 : (qb == 1) ? 8 : (qb == 2) ? 24 : 32;
    int cur_bh = -1, have_hi = 0;
    for (int uu = 0; uu < nu; ++uu) {
        const int u = u0 + uu, bh = u >> 6, r = u & 63, b = bh / 6, h = bh % 6;
        const int r0 = min(max(r - 4, 0), 56);
        const int qrow0 = b * SEQ + r * 64 + 16 * qb;
        bf16x8 qf[2];
        { const bf16x8* qp = (const bf16x8*)(PROJ + (size_t)(qrow0 + n) * NPROJP + C_NQ + 64 * h + 8 * g); qf[0] = qp[0]; qf[1] = qp[4]; }
        bf16x8 kf[8][2];
        load_kfrags<true, 8, 0, 8>(kf, PROJ + C_NK + 64 * h, b * SEQ + (r0 + 4 * part) * 64 + cbase, C.lane);
        const bool newbh = (bh != cur_bh);
        const int lo = newbh ? r0 : max(r0, have_hi);
        const int vkey = C.tid & 63, vch = C.tid >> 6;
        v4u vpre = {0u, 0u, 0u, 0u};
        if (lo < r0 + 8) vpre = *(const v4u*)(PROJ + (size_t)(b * SEQ + (r0 + 7) * 64 + vkey) * NPROJP + C_NV + 64 * h + 8 * vch);
        __syncthreads();
        if (newbh) {
            vt_scatter<4>(PROJ + (size_t)(RLAT + b * CTXL + (C.tid & 255)) * NPROJP + C_NV + 64 * h, 4 * (C.tid >> 8), vtc, VTC_STRIDE, C.tid & 255);
            const float* rp = C.in[13] + (size_t)(layer * 6 + h) * 465; for (int i = C.tid; i < 465; i += NTHR) rpb[i] = rp[i] * LOG2E;
        }
        for (int row = lo; row < r0 + 8; ++row) {
            v4u x = vpre;
            if (row != r0 + 7) x = *(const v4u*)(PROJ + (size_t)(b * SEQ + row * 64 + vkey) * NPROJP + C_NV + 64 * h + 8 * vch);
            LAS unsigned char* p = vtl + (8 * vch) * VTL_STRIDE + ((row & 7) * 64 + vkey) * 2;
            *(LAS unsigned short*)(p) = (unsigned short)(x.x & 0xffffu); *(LAS unsigned short*)(p + VTL_STRIDE) = (unsigned short)(x.x >> 16);
            *(LAS unsigned short*)(p + 2 * VTL_STRIDE) = (unsigned short)(x.y & 0xffffu); *(LAS unsigned short*)(p + 3 * VTL_STRIDE) = (unsigned short)(x.y >> 16);
            *(LAS unsigned short*)(p + 4 * VTL_STRIDE) = (unsigned short)(x.z & 0xffffu); *(LAS unsigned short*)(p + 5 * VTL_STRIDE) = (unsigned short)(x.z >> 16);
            *(LAS unsigned short*)(p + 6 * VTL_STRIDE) = (unsigned short)(x.w & 0xffffu); *(LAS unsigned short*)(p + 7 * VTL_STRIDE) = (unsigned short)(x.w >> 16);
        }
        cur_bh = bh; have_hi = r0 + 8;
        __syncthreads();
        float m, l; f32x4 o[4];
        attn_wave_mixed(kf, PROJ + C_NK + 64 * h, RLAT + b * CTXL + 128 * part, qf, vtl, vtc, rpb, part, r, r0, 16 * qb + n, cbase, m, l, o, C.lane);
        attn_merge_store(C, part, qb, m, l, o, qrow0, h);
    }
}
constexpr int VT2_ROWS = 10, VT2_STRIDE = VT2_ROWS * 64 * 2 + 16;
constexpr int NA2_VTL = 0, NA2_VTC = 64 * VT2_STRIDE, NA2_RPB = NA2_VTC + 64 * VTC_STRIDE;
static_assert(NA2_RPB + (480 + 465) * 4 <= RING_BYTES && (VT2_STRIDE / 4) % 64 == 4, "NA2 LDS map");
template <bool LOCAL>
__device__ __forceinline__ void na2_scores(f32x4 (&s)[16], const bf16x8 (&kfA)[8][2], const bf16* Kbase, int krow0, const bf16x8 (&qf)[2], int lane) {
#pragma unroll
    for (int kt = 0; kt < 8; ++kt) { f32x4 acc = {0.f, 0.f, 0.f, 0.f};
        acc = __builtin_amdgcn_mfma_f32_16x16x32_bf16(kfA[kt][0], qf[0], acc, 0, 0, 0); acc = __builtin_amdgcn_mfma_f32_16x16x32_bf16(kfA[kt][1], qf[1], acc, 0, 0, 0); s[kt] = acc; }
    __builtin_amdgcn_sched_barrier(0);
    bf16x8 kfB[16][2];
    load_kfrags<LOCAL, 16, 8, 16>(kfB, Kbase, krow0, lane);
#pragma unroll
    for (int kt = 8; kt < 16; ++kt) { f32x4 acc = {0.f, 0.f, 0.f, 0.f};
        acc = __builtin_amdgcn_mfma_f32_16x16x32_bf16(kfB[kt][0], qf[0], acc, 0, 0, 0); acc = __builtin_amdgcn_mfma_f32_16x16x32_bf16(kfB[kt][1], qf[1], acc, 0, 0, 0); s[kt] = acc; }
    __builtin_amdgcn_sched_barrier(0);
}
__device__ __forceinline__ void na_band2(const Ctx& C, int layer, int u0, int nu) {
    const bf16* PROJ = WSP(bf16, WS_PROJ);
    LAS unsigned char* vtl = C.lds + RING_OFF + NA2_VTL; LAS unsigned char* vtc = C.lds + RING_OFF + NA2_VTC; LAS float* rpb = (LAS float*)(C.lds + RING_OFF + NA2_RPB);
    const int qb = C.wave & 3, grp = C.wave >> 2, n = C.lane & 15, g = C.lane >> 4;
    const int cbase = (qb == 0) ? 0 : (qb == 1) ? 8 : (qb == 2) ? 24 : 32;
    const float SC = 0.125f * LOG2E;
    int boff[2][4]; float bscl[2][4];
    { const int qc = 16 * qb + n, c0 = min(max(qc - 8, 0), 48);
#pragma unroll
      for (int hh = 0; hh < 2; ++hh)
#pragma unroll
        for (int reg = 0; reg < 4; ++reg) { const int kcol = cbase + 16 * hh + 4 * g + reg; const bool ok = (kcol >= c0) && (kcol < c0 + 16);
            boff[hh][reg] = ok ? (min(max(kcol - qc, -15), 15) + 15) * 4 : 480 * 4; bscl[hh][reg] = ok ? SC : 0.f; } }
    int cur_bh = -1, have_hi = 0;
    for (int uu = 0; uu < nu; uu += 2) {
        const int ua = u0 + uu, bh = ua >> 6, ra = ua & 63, b = bh / 6, h = bh % 6;
        const int r0a = min(max(ra - 4, 0), 56), r0b = min(max(ra + 1 - 4, 0), 56);
        const int r = ra + grp, r0 = grp ? r0b : r0a;
        const int qrow0 = b * SEQ + r * 64 + 16 * qb;
        const bool newbh = (bh != cur_bh);
        const int lo = newbh ? r0a : max(r0a, have_hi), hi = r0b + 8;
        const int vkey = C.tid & 63, vch = C.tid >> 6;
        const v4u vpa = *(const v4u*)(PROJ + (size_t)(b * SEQ + (hi - 2) * 64 + vkey) * NPROJP + C_NV + 64 * h + 8 * vch);
        const v4u vpb = *(const v4u*)(PROJ + (size_t)(b * SEQ + (hi - 1) * 64 + vkey) * NPROJP + C_NV + 64 * h + 8 * vch);
        bf16x8 qf[2];
        { const bf16x8* qp = (const bf16x8*)(PROJ + (size_t)(qrow0 + n) * NPROJP + C_NQ + 64 * h + 8 * g); qf[0] = qp[0]; qf[1] = qp[4]; }
        bf16x8 kf[8][2];
        load_kfrags<true, 8, 0, 8>(kf, PROJ + C_NK + 64 * h, b * SEQ + r0 * 64 + cbase, C.lane);
        __syncthreads();
        if (newbh) {
            vt_scatter<4>(PROJ + (size_t)(RLAT + b * CTXL + (C.tid & 255)) * NPROJP + C_NV + 64 * h, 4 * (C.tid >> 8), vtc, VTC_STRIDE, C.tid & 255);
            const float* rp = C.in[13] + (size_t)(layer * 6 + h) * 465; for (int i = C.tid; i < 465; i += NTHR) rpb[i] = rp[i] * LOG2E;
            for (int i = C.tid; i < 15 * 31; i += NTHR) rpb[480 + i] = -1.0e30f;
        }
        for (int row = lo; row < hi; ++row) {
            v4u x;
            if (row == hi - 2) x = vpa; else if (row == hi - 1) x = vpb; else x = *(const v4u*)(PROJ + (size_t)(b * SEQ + row * 64 + vkey) * NPROJP + C_NV + 64 * h + 8 * vch);
            LAS unsigned char* p = vtl + (8 * vch) * VT2_STRIDE + ((row % VT2_ROWS) * 64 + vkey) * 2;
            *(LAS unsigned short*)(p) = (unsigned short)(x.x & 0xffffu); *(LAS unsigned short*)(p + VT2_STRIDE) = (unsigned short)(x.x >> 16);
            *(LAS unsigned short*)(p + 2 * VT2_STRIDE) = (unsigned short)(x.y & 0xffffu); *(LAS unsigned short*)(p + 3 * VT2_STRIDE) = (unsigned short)(x.y >> 16);
            *(LAS unsigned short*)(p + 4 * VT2_STRIDE) = (unsigned short)(x.z & 0xffffu); *(LAS unsigned short*)(p + 5 * VT2_STRIDE) = (unsigned short)(x.z >> 16);
            *(LAS unsigned short*)(p + 6 * VT2_STRIDE) = (unsigned short)(x.w & 0xffffu); *(LAS unsigned short*)(p + 7 * VT2_STRIDE) = (unsigned short)(x.w >> 16);
        }
        cur_bh = bh; have_hi = hi;
        __syncthreads();
        f32x4 s[16];
        na2_scores<true>(s, kf, PROJ + C_NK + 64 * h, b * SEQ + r0 * 64 + cbase, qf, C.lane);
        bf16x8 kc[8][2];
        load_kfrags<false, 8, 0, 8>(kc, PROJ + C_NK + 64 * h, RLAT + b * CTXL, C.lane);
        float mx = -1.0e30f;
        { LAS const unsigned char* rb = (LAS const unsigned char*)rpb + (r0 - r + 7) * 124;
#pragma unroll
          for (int kt = 0; kt < 16; ++kt)
#pragma unroll
            for (int reg = 0; reg < 4; ++reg) {
                const float bias = *(LAS const float*)(rb + boff[kt & 1][reg] + (kt >> 1) * 124);
                const float v = s[kt][reg] * bscl[kt & 1][reg] + bias;
                s[kt][reg] = v; mx = fmaxf(mx, v);
            } }
        mx = fmaxf(mx, __shfl_xor(mx, 16)); mx = fmaxf(mx, __shfl_xor(mx, 32));
        float l = 0.f;
#pragma unroll
        for (int kt = 0; kt < 16; ++kt)
#pragma unroll
            for (int reg = 0; reg < 4; ++reg) { const float p = __builtin_amdgcn_exp2f(s[kt][reg] - mx); s[kt][reg] = p; l += p; }
        f32x4 o[4];
#pragma unroll
        for (int dt = 0; dt < 4; ++dt) o[dt] = (f32x4){0.f, 0.f, 0.f, 0.f};
#pragma unroll
        for (int u = 0; u < 8; ++u) {
            v4u pw; pw.x = cvtpk(s[2 * u][0], s[2 * u][1]); pw.y = cvtpk(s[2 * u][2], s[2 * u][3]); pw.z = cvtpk(s[2 * u + 1][0], s[2 * u + 1][1]); pw.w = cvtpk(s[2 * u + 1][2], s[2 * u + 1][3]);
            const bf16x8 pb = __builtin_bit_cast(bf16x8, pw);
            const int slotA = ((r0 + u) % VT2_ROWS) * 64 + cbase + 4 * g, slotB = slotA + 16;
#pragma unroll
            for (int dt = 0; dt < 4; ++dt) {
                LAS const unsigned char* rowp = vtl + (16 * dt + n) * VT2_STRIDE;
                const v2u a_lo = *(LAS const v2u*)(rowp + slotA * 2), a_hi = *(LAS const v2u*)(rowp + slotB * 2);
                v4u aw; aw.x = a_lo.x; aw.y = a_lo.y; aw.z = a_hi.x; aw.w = a_hi.y;
                o[dt] = __builtin_amdgcn_mfma_f32_16x16x32_bf16(__builtin_bit_cast(bf16x8, aw), pb, o[dt], 0, 0, 0);
            }
        }
        na2_scores<false>(s, kc, PROJ + C_NK + 64 * h, RLAT + b * CTXL, qf, C.lane);
        float mx2 = -1.0e30f;
#pragma unroll
        for (int kt = 0; kt < 16; ++kt)
#pragma unroll
            for (int reg = 0; reg < 4; ++reg) { const float v = s[kt][reg] * SC; s[kt][reg] = v; mx2 = fmaxf(mx2, v); }
        mx2 = fmaxf(mx2, __shfl_xor(mx2, 16)); mx2 = fmaxf(mx2, __shfl_xor(mx2, 32));
        const float mt = fmaxf(mx, mx2), f1 = __builtin_amdgcn_exp2f(mx - mt);
        l *= f1;
#pragma unroll
        for (int dt = 0; dt < 4; ++dt) o[dt] = o[dt] * f1;
#pragma unroll
        for (int kt = 0; kt < 16; ++kt)
#pragma unroll
            for (int reg = 0; reg < 4; ++reg) { const float p = __builtin_amdgcn_exp2f(s[kt][reg] - mt); s[kt][reg] = p; l += p; }
        l += __shfl_xor(l, 16); l += __shfl_xor(l, 32);
#pragma unroll
        for (int u = 0; u < 8; ++u) {
            v4u pw; pw.x = cvtpk(s[2 * u][0], s[2 * u][1]); pw.y = cvtpk(s[2 * u][2], s[2 * u][3]); pw.z = cvtpk(s[2 * u + 1][0], s[2 * u + 1][1]); pw.w = cvtpk(s[2 * u + 1][2], s[2 * u + 1][3]);
            const bf16x8 pb = __builtin_bit_cast(bf16x8, pw);
            const int slotA = 32 * u + 4 * g, slotB = slotA + 16;
#pragma unroll
            for (int dt = 0; dt < 4; ++dt) {
                LAS const unsigned char* rowp = vtc + (16 * dt + n) * VTC_STRIDE;
                const v2u a_lo = *(LAS const v2u*)(rowp + slotA * 2), a_hi = *(LAS const v2u*)(rowp + slotB * 2);
                v4u aw; aw.x = a_lo.x; aw.y = a_lo.y; aw.z = a_hi.x; aw.w = a_hi.y;
                o[dt] = __builtin_amdgcn_mfma_f32_16x16x32_bf16(__builtin_bit_cast(bf16x8, aw), pb, o[dt], 0, 0, 0);
            }
        }
        const float inv = 1.0f / l;
        bf16* yp = WSP(bf16, WS_YMIX) + (size_t)(qrow0 + n) * D + 640 + 64 * h + 4 * g;
#pragma unroll
        for (int dt = 0; dt < 4; ++dt) { const f32x4 v = o[dt] * inv; v2u w; w.x = cvtpk(v[0], v[1]); w.y = cvtpk(v[2], v[3]); *(v2u*)(yp + 16 * dt) = w; }
    }
    __syncthreads();
}
__device__ __forceinline__ void ctxattn_unit(const Ctx& C, int b, int h, int qblk) {
    const bf16* PROJ = WSP(bf16, WS_PROJ);
    LAS unsigned char* vtc = C.lds + RING_OFF + NA_VTC; LAS float* rpb = (LAS float*)(C.lds + RING_OFF + NA_RPB);
    __syncthreads();
    vt_scatter<4>(PROJ + (size_t)(RLAT + b * CTXL + (C.tid & 255)) * NPROJP + C_NV + 64 * h, 4 * (C.tid >> 8), vtc, VTC_STRIDE, C.tid & 255);
    __syncthreads();
    const int qb = C.wave & 3, part = C.wave >> 2, n = C.lane & 15, g = C.lane >> 4;
    const int qrow0 = RLAT + b * CTXL + 64 * qblk + 16 * qb;
    bf16x8 qf[2];
    { const bf16x8* qp = (const bf16x8*)(PROJ + (size_t)(qrow0 + n) * NPROJP + C_NQ + 64 * h + 8 * g); qf[0] = qp[0]; qf[1] = qp[4]; }
    float m, l; f32x4 o[4];
    bf16x8 kf[8][2];
    load_kfrags<false, 8>(kf, PROJ + C_NK + 64 * h, RLAT + b * CTXL + 128 * part, C.lane);
    attn_wave_core<false, 8>(kf, PROJ + C_NK + 64 * h, RLAT + b * CTXL + 128 * part, qf, vtc + 256 * part, VTC_STRIDE, rpb, 0, 0, 0, 0, m, l, o, C.lane);
    attn_merge_store(C, part, qb, m, l, o, qrow0, h);
}

constexpr size_t WS_UT = WS_OBUF;
constexpr size_t WS_SB = WS_OBUF + 26 * MiB;
constexpr int RT_STRIDE = 272;
__device__ __forceinline__ float logsig(float x) { return -log1pf(expf(-x)); }
__device__ __forceinline__ int ret_row0(int b, int c) { return (c < 2) ? RLAT + b * CTXL + 128 * c : b * SEQ + 128 * (c - 2); }

struct RaLoads { v4u k0, k1, v0, v1; };
__device__ __forceinline__ void ra_load(const Ctx& C, int b, int h, int c, RaLoads& L) {
    const int j = C.tid & 127, q4 = C.tid >> 7;
    const bf16* pr = WSP(bf16, WS_PROJ) + (size_t)(ret_row0(b, c) + j) * NPROJP + 64 * h + 16 * q4;
    L.k0 = *(const v4u*)(pr + C_RK); L.k1 = *(const v4u*)(pr + C_RK + 8); L.v0 = *(const v4u*)(pr + C_RV); L.v1 = *(const v4u*)(pr + C_RV + 8);
}
__device__ __forceinline__ void ret_a_unit(const Ctx& C, int layer, int b, int h, int c, const RaLoads& L) {
    LAS unsigned char* kt = C.lds + RING_OFF; LAS unsigned char* vft = kt + 64 * RT_STRIDE; LAS unsigned char* vbt = vft + 64 * RT_STRIDE;
    const float lgf = logsig(C.in[10][(layer * 2 + 0) * 6 + h]), lgb = logsig(C.in[10][(layer * 2 + 1) * 6 + h]);
    __syncthreads();
    {
        const int j = C.tid & 127, q4 = C.tid >> 7;
        const v4u k0 = L.k0, k1 = L.k1, v0 = L.v0, v1 = L.v1;
        const float wf = expf(lgf * (float)(127 - j)), wb = expf(lgb * (float)j);
        const unsigned kw[8] = {k0.x, k0.y, k0.z, k0.w, k1.x, k1.y, k1.z, k1.w}, vw[8] = {v0.x, v0.y, v0.z, v0.w, v1.x, v1.y, v1.z, v1.w};
#pragma unroll
        for (int i = 0; i < 8; ++i) {
            const int d = 16 * q4 + 2 * i;
            *(LAS unsigned short*)(kt + d * RT_STRIDE + 2 * j) = (unsigned short)(kw[i] & 0xffffu); *(LAS unsigned short*)(kt + (d + 1) * RT_STRIDE + 2 * j) = (unsigned short)(kw[i] >> 16);
            const float a = bflo(vw[i]), bb = bfhi(vw[i]);
            *(LAS unsigned short*)(vft + d * RT_STRIDE + 2 * j) = (unsigned short)f2bf(a * wf); *(LAS unsigned short*)(vft + (d + 1) * RT_STRIDE + 2 * j) = (unsigned short)f2bf(bb * wf);
            *(LAS unsigned short*)(vbt + d * RT_STRIDE + 2 * j) = (unsigned short)f2bf(a * wb); *(LAS unsigned short*)(vbt + (d + 1) * RT_STRIDE + 2 * j) = (unsigned short)f2bf(bb * wb);
        }
    }
    __syncthreads();
    const int dir = C.wave >> 2, dt = C.wave & 3, n = C.lane & 15, g = C.lane >> 4;
    LAS const unsigned char* vt = dir ? vbt : vft;
    f32x4 acc[4];
#pragma unroll
    for (int et = 0; et < 4; ++et) acc[et] = (f32x4){0.f, 0.f, 0.f, 0.f};
#pragma unroll
    for (int s = 0; s < 4; ++s) {
        const bf16x8 a = *(LAS const bf16x8*)(kt + (16 * dt + n) * RT_STRIDE + (32 * s + 8 * g) * 2);
#pragma unroll
        for (int et = 0; et < 4; ++et) {
            const bf16x8 bf = *(LAS const bf16x8*)(vt + (16 * et + n) * RT_STRIDE + (32 * s + 8 * g) * 2);
            acc[et] = __builtin_amdgcn_mfma_f32_16x16x32_bf16(a, bf, acc[et], 0, 0, 0);
        }
    }
    float* U = WSP(float, WS_UT) + ((size_t)((dir * 24 + b * 6 + h) * 34 + c)) * 4096;
#pragma unroll
    for (int et = 0; et < 4; ++et) *(f32x4*)(U + (16 * et + n) * 64 + 16 * dt + 4 * g) = acc[et];
}
typedef float f32x2v __attribute__((ext_vector_type(2)));
__device__ __forceinline__ void ret_scan(const Ctx& C, int layer) {
    for (int task = C.gtid; task < 48 * 2048; task += C.NT) {
        const int dir = task / (24 * 2048), rem = task % (24 * 2048), bh = rem >> 11, p = rem & 2047, h = bh % 6;
        const float dec = expf(128.0f * logsig(C.in[10][(layer * 2 + dir) * 6 + h]));
        const float* __restrict__ U = WSP(float, WS_UT) + ((size_t)(dir * 24 + bh) * 34) * 4096 + 2 * p;
        bf16* __restrict__ SB = WSP(bf16, WS_SB) + ((size_t)(dir * 24 + bh) * 34) * 4096 + 2 * p;
        f32x2v u[34];
#pragma unroll
        for (int k = 0; k < 34; ++k) { const int c = dir ? ((k < 2) ? 1 - k : 35 - k) : k; u[k] = *(const f32x2v*)(U + (size_t)c * 4096); }
        float s0 = 0.f, s1 = 0.f;
#pragma unroll
        for (int k = 0; k < 34; ++k) {
            const int c = dir ? ((k < 2) ? 1 - k : 35 - k) : k;
            *(unsigned*)(SB + (size_t)c * 4096) = pk2(s0, s1);
            s0 = dec * s0 + u[k].x; s1 = dec * s1 + u[k].y;
        }
    }
}
constexpr int RC_KS = 144;
constexpr int RC_VT = 0, RC_K = 64 * RT_STRIDE, RC_SB = RC_K + 128 * RC_KS, RC_TAB = RC_SB + 2 * 64 * RC_KS;
static_assert(RC_TAB + 1024 <= RING_BYTES, "retC LDS map");
struct RcLoads { bf16x8 qf[2]; v2u gw[4]; v4u v0, v1, k0, k1, s0, s1; };
__device__ __forceinline__ void rc_load(const Ctx& C, int b, int h, int c, RcLoads& L) {
    const bf16* PROJ = WSP(bf16, WS_PROJ);
    const int row0 = ret_row0(b, c);
    const int n = C.lane & 15, g = C.lane >> 4, i = 16 * C.wave + n, rowi = row0 + i;
    { const bf16x8* qp = (const bf16x8*)(PROJ + (size_t)rowi * NPROJP + C_RQ + 64 * h + 8 * g); L.qf[0] = qp[0]; L.qf[1] = qp[4]; }
    { const bf16* gp = PROJ + (size_t)rowi * NPROJP + C_RG + 64 * h + 4 * g;
#pragma unroll
      for (int et = 0; et < 4; ++et) L.gw[et] = *(const v2u*)(gp + 16 * et); }
    const int vj = C.tid & 127, vq4 = C.tid >> 7;
    const bf16* vpr = PROJ + (size_t)(row0 + vj) * NPROJP + 64 * h + 16 * vq4;
    L.v0 = *(const v4u*)(vpr + C_RV); L.v1 = *(const v4u*)(vpr + C_RV + 8);
    L.k0 = *(const v4u*)(vpr + C_RK); L.k1 = *(const v4u*)(vpr + C_RK + 8);
    const int se = C.tid & 63, sq = (C.tid >> 6) & 3, sd = C.tid >> 8;
    const bf16* spr = WSP(bf16, WS_SB) + ((size_t)((sd * 24 + b * 6 + h) * 34 + c)) * 4096 + se * 64 + 16 * sq;
    L.s0 = *(const v4u*)(spr); L.s1 = *(const v4u*)(spr + 8);
}
__device__ __forceinline__ void ret_c_unit(const Ctx& C, int layer, int b, int h, int c, const RcLoads& L) {
    LAS unsigned char* vt = C.lds + RING_OFF + RC_VT; LAS unsigned char* kim = C.lds + RING_OFF + RC_K; LAS unsigned char* sim = C.lds + RING_OFF + RC_SB;
    LAS float* tabf = (LAS float*)(C.lds + RING_OFF + RC_TAB);
    const float lgf = logsig(C.in[10][(layer * 2 + 0) * 6 + h]), lgb = logsig(C.in[10][(layer * 2 + 1) * 6 + h]);
    const int row0 = ret_row0(b, c);
    const int n = C.lane & 15, g = C.lane >> 4, i = 16 * C.wave + n, rowi = row0 + i;
    const int vj = C.tid & 127, vq4 = C.tid >> 7;
    const int se = C.tid & 63, sq = (C.tid >> 6) & 3, sd = C.tid >> 8;
    const bf16x8 qf[2] = {L.qf[0], L.qf[1]};
    const v2u gw[4] = {L.gw[0], L.gw[1], L.gw[2], L.gw[3]};
    const v4u v0 = L.v0, v1 = L.v1, k0 = L.k0, k1 = L.k1, s0 = L.s0, s1 = L.s1;
    __syncthreads();
    {
        const unsigned vw[8] = {v0.x, v0.y, v0.z, v0.w, v1.x, v1.y, v1.z, v1.w};
#pragma unroll
        for (int ii = 0; ii < 8; ++ii) { const int dd = 16 * vq4 + 2 * ii;
            *(LAS unsigned short*)(vt + dd * RT_STRIDE + 2 * vj) = (unsigned short)(vw[ii] & 0xffffu); *(LAS unsigned short*)(vt + (dd + 1) * RT_STRIDE + 2 * vj) = (unsigned short)(vw[ii] >> 16); }
        *(LAS v4u*)(kim + vj * RC_KS + 32 * vq4) = k0; *(LAS v4u*)(kim + vj * RC_KS + 32 * vq4 + 16) = k1;
        *(LAS v4u*)(sim + (sd * 64 + se) * RC_KS + 32 * sq) = s0; *(LAS v4u*)(sim + (sd * 64 + se) * RC_KS + 32 * sq + 16) = s1;
        if (C.tid < 255) { const int dl = C.tid - 127; tabf[C.tid] = (dl > 0) ? expf(lgf * (float)dl) : ((dl < 0) ? expf(lgb * (float)(-dl)) : 2.0f); }
    }
    __syncthreads();
    f32x4 st[8];
#pragma unroll
    for (int jt = 0; jt < 8; ++jt) {
        LAS const unsigned char* kp = kim + (16 * jt + n) * RC_KS + 16 * g;
        const bf16x8 ka = *(LAS const bf16x8*)(kp), kb = *(LAS const bf16x8*)(kp + 64);
        f32x4 acc = {0.f, 0.f, 0.f, 0.f};
        acc = __builtin_amdgcn_mfma_f32_16x16x32_bf16(ka, qf[0], acc, 0, 0, 0);
        acc = __builtin_amdgcn_mfma_f32_16x16x32_bf16(kb, qf[1], acc, 0, 0, 0);
        st[jt] = acc;
    }
#pragma unroll
    for (int jt = 0; jt < 8; ++jt)
#pragma unroll
        for (int reg = 0; reg < 4; ++reg) {
            const int j = 16 * jt + 4 * g + reg;
            st[jt][reg] *= tabf[127 + i - j];
        }
    f32x4 o[4];
#pragma unroll
    for (int et = 0; et < 4; ++et) o[et] = (f32x4){0.f, 0.f, 0.f, 0.f};
#pragma unroll
    for (int u = 0; u < 4; ++u) {
        v4u pw; pw.x = cvtpk(st[2 * u][0], st[2 * u][1]); pw.y = cvtpk(st[2 * u][2], st[2 * u][3]); pw.z = cvtpk(st[2 * u + 1][0], st[2 * u + 1][1]); pw.w = cvtpk(st[2 * u + 1][2], st[2 * u + 1][3]);
        const bf16x8 pb = __builtin_bit_cast(bf16x8, pw);
        const int slotA = 32 * u + 4 * g, slotB = slotA + 16;
#pragma unroll
        for (int et = 0; et < 4; ++et) {
            LAS const unsigned char* rowp = vt + (16 * et + n) * RT_STRIDE;
            const v2u a_lo = *(LAS const v2u*)(rowp + slotA * 2), a_hi = *(LAS const v2u*)(rowp + slotB * 2);
            v4u aw; aw.x = a_lo.x; aw.y = a_lo.y; aw.z = a_hi.x; aw.w = a_hi.y;
            o[et] = __builtin_amdgcn_mfma_f32_16x16x32_bf16(__builtin_bit_cast(bf16x8, aw), pb, o[et], 0, 0, 0);
        }
    }
#pragma unroll
    for (int dir = 0; dir < 2; ++dir) {
        const float scl = dir ? expf(lgb * (float)(128 - i)) : expf(lgf * (float)(i + 1));
#pragma unroll
        for (int et = 0; et < 4; ++et) {
            LAS const unsigned char* sp = sim + (dir * 64 + 16 * et + n) * RC_KS + 16 * g;
            const bf16x8 a0 = *(LAS const bf16x8*)(sp), a1 = *(LAS const bf16x8*)(sp + 64);
            f32x4 t = {0.f, 0.f, 0.f, 0.f};
            t = __builtin_amdgcn_mfma_f32_16x16x32_bf16(a0, qf[0], t, 0, 0, 0);
            t = __builtin_amdgcn_mfma_f32_16x16x32_bf16(a1, qf[1], t, 0, 0, 0);
            o[et] = o[et] + t * scl;
        }
    }
    float sm = 0.f;
#pragma unroll
    for (int et = 0; et < 4; ++et) sm += (o[et][0] + o[et][1]) + (o[et][2] + o[et][3]);
    sm += __shfl_xor(sm, 16); sm += __shfl_xor(sm, 32);
    const float mu = sm * (1.f / 64.f);
    float sq2 = 0.f;
#pragma unroll
    for (int et = 0; et < 4; ++et) { o[et] = o[et] - mu; sq2 += (o[et][0] * o[et][0] + o[et][1] * o[et][1]) + (o[et][2] * o[et][2] + o[et][3] * o[et][3]); }
    sq2 += __shfl_xor(sq2, 16); sq2 += __shfl_xor(sq2, 32);
    const float rstd = 1.0f / sqrtf(sq2 * (1.f / 64.f) + EPS);
    const float* gn = C.in[11] + layer * 384 + 64 * h;
    bf16* yp = WSP(bf16, WS_YMIX) + (size_t)rowi * D + 64 * h + 4 * g;
#pragma unroll
    for (int et = 0; et < 4; ++et) {
        const f32x4 gg = *(const f32x4*)(gn + 16 * et + 4 * g);
        const float y0 = o[et][0] * rstd * gg[0] * siluf(bflo(gw[et].x)), y1 = o[et][1] * rstd * gg[1] * siluf(bfhi(gw[et].x));
        const float y2 = o[et][2] * rstd * gg[2] * siluf(bflo(gw[et].y)), y3 = o[et][3] * rstd * gg[3] * siluf(bfhi(gw[et].y));
        v2u w; w.x = cvtpk(y0, y1); w.y = cvtpk(y2, y3);
        *(v2u*)(yp + 16 * et) = w;
    }
}

__device__ __forceinline__ void p_mix1(const Ctx& C, int layer) {
    { const int per = (1536 + C.G - 1) / C.G, u0 = C.bx * per, nu = min(per, 1536 - u0); if (nu > 0) { if ((per & 1) == 0) na_band2(C, layer, u0, nu); else na_band(C, layer, u0, nu); } }
    const int n_ctx = (layer == 0) ? 96 : 0;
    for (int u = C.bx; u < n_ctx; u += C.G) { const int bh = u >> 2; ctxattn_unit(C, bh / 6, bh % 6, u & 3); }
    {
        int u0 = (C.bx + C.G - (n_ctx % C.G)) % C.G;
        if (u0 < 816) {
            RaLoads La, Lb;
            ra_load(C, (u0 / 34) / 6, (u0 / 34) % 6, u0 % 34, La);
            for (;;) {
                const int u1 = u0 + C.G; const bool h1 = u1 < 816;
                if (h1) ra_load(C, (u1 / 34) / 6, (u1 / 34) % 6, u1 % 34, Lb);
                ret_a_unit(C, layer, (u0 / 34) / 6, (u0 / 34) % 6, u0 % 34, La);
                if (!h1) break;
                u0 = u1 + C.G; const bool h0 = u0 < 816;
                if (h0) ra_load(C, (u0 / 34) / 6, (u0 / 34) % 6, u0 % 34, La);
                ret_a_unit(C, layer, (u1 / 34) / 6, (u1 / 34) % 6, u1 % 34, Lb);
                if (!h0) break;
            }
        }
    }
    __syncthreads();
}
__device__ __forceinline__ void p_mix2(const Ctx& C, int layer) {
    ret_scan(C, layer);
    const bf16* PROJ = WSP(bf16, WS_PROJ); bf16* Y = WSP(bf16, WS_YMIX);
    const float* cw = C.in[12] + layer * 3 * 256;
    const int nrows = (layer == 0) ? RALL : RLAT;
    for (int idx = C.gtid; idx < nrows * 32; idx += C.NT) {
        const int m = idx >> 5, ch = (idx & 31) * 8;
        int tpos, len; if (m < RLAT) { tpos = m & 4095; len = SEQ; } else { tpos = (m - RLAT) & 255; len = CTXL; }
        const bf16* p = PROJ + (size_t)m * NPROJP + ch;
        const v4u zero = {0u, 0u, 0u, 0u};
        const v4u cb = *(const v4u*)(p + C_CB), cc1 = *(const v4u*)(p + C_CC), cx1 = *(const v4u*)(p + C_CX);
        const v4u cc0 = (tpos > 0) ? *(const v4u*)(p + C_CC - NPROJP) : zero, cx0 = (tpos > 0) ? *(const v4u*)(p + C_CX - NPROJP) : zero;
        const v4u cc2 = (tpos < len - 1) ? *(const v4u*)(p + C_CC + NPROJP) : zero, cx2 = (tpos < len - 1) ? *(const v4u*)(p + C_CX + NPROJP) : zero;
        const f32x4 w0a = *(const f32x4*)(cw + ch), w0b = *(const f32x4*)(cw + ch + 4), w1a = *(const f32x4*)(cw + 256 + ch), w1b = *(const f32x4*)(cw + 256 + ch + 4), w2a = *(const f32x4*)(cw + 512 + ch), w2b = *(const f32x4*)(cw + 512 + ch + 4);
        float y[8];
#pragma unroll
        for (int i = 0; i < 4; ++i) {
            const float wl0 = (i < 2) ? w0a[2 * i] : w0b[2 * i - 4], wh0 = (i < 2) ? w0a[2 * i + 1] : w0b[2 * i - 3];
            const float wl1 = (i < 2) ? w1a[2 * i] : w1b[2 * i - 4], wh1 = (i < 2) ? w1a[2 * i + 1] : w1b[2 * i - 3];
            const float wl2 = (i < 2) ? w2a[2 * i] : w2b[2 * i - 4], wh2 = (i < 2) ? w2a[2 * i + 1] : w2b[2 * i - 3];
            y[2 * i] = bflo(cb[i]) * (wl0 * bflo(cc0[i]) * bflo(cx0[i]) + wl1 * bflo(cc1[i]) * bflo(cx1[i]) + wl2 * bflo(cc2[i]) * bflo(cx2[i]));
            y[2 * i + 1] = bfhi(cb[i]) * (wh0 * bfhi(cc0[i]) * bfhi(cx0[i]) + wh1 * bfhi(cc1[i]) * bfhi(cx1[i]) + wh2 * bfhi(cc2[i]) * bfhi(cx2[i]));
        }
        v4u o; o.x = cvtpk(y[0], y[1]); o.y = cvtpk(y[2], y[3]); o.z = cvtpk(y[4], y[5]); o.w = cvtpk(y[6], y[7]);
        *(v4u*)(Y + (size_t)m * D + 384 + ch) = o;
    }
}
__device__ __forceinline__ void rc_unit_of(int layer, int u, int& bh, int& c) { if (layer == 0) { bh = u / 34; c = u % 34; } else { bh = u >> 5; c = 2 + (u & 31); } }
__device__ __forceinline__ void p_mix3(const Ctx& C, int layer) {
    const int nu = (layer == 0) ? 816 : 768;
    int u0 = C.bx;
    if (u0 < nu) {
        RcLoads La, Lb; int bh0, c0, bh1, c1;
        rc_unit_of(layer, u0, bh0, c0); rc_load(C, bh0 / 6, bh0 % 6, c0, La);
        for (;;) {
            const int u1 = u0 + C.G; const bool h1 = u1 < nu;
            if (h1) { rc_unit_of(layer, u1, bh1, c1); rc_load(C, bh1 / 6, bh1 % 6, c1, Lb); }
            ret_c_unit(C, layer, bh0 / 6, bh0 % 6, c0, La);
            if (!h1) break;
            u0 = u1 + C.G; const bool h0 = u0 < nu;
            if (h0) { rc_unit_of(layer, u0, bh0, c0); rc_load(C, bh0 / 6, bh0 % 6, c0, La); }
            ret_c_unit(C, layer, bh1 / 6, bh1 % 6, c1, Lb);
            if (!h0) break;
        }
    }
    __syncthreads();
}
__device__ __forceinline__ void p_moe_lists(const Ctx& C) {
    LAS int* L = (LAS int*)(C.lds + RING_OFF);
    const int* CNT = WSP(int, WS_CNT);
    for (int blk = C.bx; blk < 256; blk += C.G) {
        __syncthreads();
        for (int i = C.tid; i < 2048; i += NTHR) L[i] = CNT[i];
        if (C.tid < 64) L[2080 + C.tid] = WSP(int, WS_TOKE)[64 * blk + C.tid];
        __syncthreads();
        {
            const int e = C.wave; int tot = 0, pre = 0;
#pragma unroll
            for (int q = 0; q < 4; ++q) { const int k = 4 * C.lane + q; const int cnt = L[k * 8 + e]; tot += cnt; pre += (k < blk) ? cnt : 0; }
#pragma unroll
            for (int o = 1; o < 64; o <<= 1) { tot += __shfl_xor(tot, o); pre += __shfl_xor(pre, o); }
            if (C.lane == 0) { L[2048 + e] = tot; L[2064 + e] = pre; }
        }
        __syncthreads();
        if (C.tid == 0) { int base = 0; for (int e = 0; e < 8; ++e) { L[2056 + e] = base; base += (L[2048 + e] + 255) & ~255; } }
        __syncthreads();
        {
            const int e = C.wave, ee = L[2080 + C.lane], e1 = ee & 255, e2 = ee >> 8;
            const bool hit = (e1 == e) || (e2 == e);
            const unsigned long long bal = __ballot(hit);
            const int rank = __popcll(bal & ((1ull << C.lane) - 1ull));
            if (hit) L[2144 + 2 * C.lane + ((e1 == e) ? 0 : 1)] = L[2056 + e] + L[2064 + e] + rank;
        }
        __syncthreads();
        if (C.tid < 128) { const int t = C.tid >> 1, k = C.tid & 1, m = 64 * blk + t, pos = L[2144 + C.tid];
            WSP(int, WS_TOKP)[2 * m + k] = pos; WSP(float, WS_ROWW)[pos] = WSP(float, WS_TOKW)[2 * m + k]; }
        for (int j = 0; j < 8; ++j) { const int t = 8 * C.wave + j, m = 64 * blk + t;
            const v4u* src = (const v4u*)(WSP(bf16, WS_A) + (size_t)m * D) + 2 * C.lane;
            const v4u x0 = src[0], x1 = src[1];
            v4u y; y.x = pg8::pk4_fp8(bflo(x0.x), bfhi(x0.x), bflo(x0.y), bfhi(x0.y)); y.y = pg8::pk4_fp8(bflo(x0.z), bfhi(x0.z), bflo(x0.w), bfhi(x0.w));
            y.z = pg8::pk4_fp8(bflo(x1.x), bfhi(x1.x), bflo(x1.y), bfhi(x1.y)); y.w = pg8::pk4_fp8(bflo(x1.z), bfhi(x1.z), bflo(x1.w), bfhi(x1.w));
#pragma unroll
            for (int k = 0; k < 2; ++k) { v4u* dst = (v4u*)(WSP(unsigned char, WS_SORT) + (size_t)L[2144 + 2 * t + k] * D) + C.lane; dst[0] = y; } }
        if (blk == 0 && C.tid == 0) { int T = 0; int* TE = WSP(int, WS_TILE);
            for (int e = 0; e < 8; ++e) { const int nt = (L[2048 + e] + 255) >> 8; for (int k = 0; k < nt; ++k) TE[T + k] = e; T += nt; }
            TE[255] = T; }
    }
    __syncthreads();
}
__device__ __forceinline__ void p_final(const Ctx& C, float* out) {
    const float* fg = C.in[20]; const float* mod = WSP(float, WS_MOD) + 30720; const bf16* SL = WSP(bf16, WS_SLOT);
    for (int m0 = C.gw; m0 < RLAT; m0 += 2 * C.NGW) {
        int mm[2], pp[2][2]; bool ok[2];
#pragma unroll
        for (int r = 0; r < 2; ++r) { mm[r] = m0 + r * C.NGW; ok[r] = mm[r] < RLAT; const int mc = ok[r] ? mm[r] : m0; mm[r] = mc; pp[r][0] = WSP(int, WS_TOKP)[2 * mc]; pp[r][1] = WSP(int, WS_TOKP)[2 * mc + 1]; }
        f32x4 v[2][4]; float ss[2] = {0.f, 0.f};
#pragma unroll
        for (int r = 0; r < 2; ++r)
#pragma unroll
            for (int j = 0; j < 4; ++j) { const int c = 4 * C.lane + 256 * j; const int b = mm[r] >> 12;
                const f32x4 hv = *(const f32x4*)(WSP(float, WS_H) + (size_t)mm[r] * D + c), g2 = *(const f32x4*)(mod + b * 6144 + 5 * D + c);
                const v2u q1 = *(const v2u*)(SL + (size_t)pp[r][0] * D + c), q2 = *(const v2u*)(SL + (size_t)pp[r][1] * D + c);
                const f32x4 s1 = {bflo(q1.x), bfhi(q1.x), bflo(q1.y), bfhi(q1.y)}, s2 = {bflo(q2.x), bfhi(q2.x), bflo(q2.y), bfhi(q2.y)};
                v[r][j] = hv + g2 * (s1 + s2); ss[r] += (v[r][j].x * v[r][j].x + v[r][j].y * v[r][j].y) + (v[r][j].z * v[r][j].z + v[r][j].w * v[r][j].w); }
#pragma unroll
        for (int r = 0; r < 2; ++r) {
            const float rstd = 1.0f / sqrtf(wave_sum(ss[r]) * (1.0f / D) + EPS);
            if (ok[r]) {
#pragma unroll
                for (int j = 0; j < 4; ++j) { const int c = 4 * C.lane + 256 * j; __builtin_nontemporal_store(v[r][j] * rstd * *(const f32x4*)(fg + c), (f32x4*)(out + (size_t)mm[r] * D + c)); }
            }
        }
    }
}

#ifndef MK_ONE_LAUNCH
#define MK_ONE_LAUNCH 1
#endif
constexpr int NPHASES = 21;
#ifndef PROBE_DUP
#define PROBE_DUP 0u
#endif
#define REPS(k) ((((PROBE_DUP) >> (k)) & 1u) ? 2 : 1)
struct Args { const float* in[21]; float* out; unsigned char* ws; int ph_lo, ph_hi; };
__global__ void __launch_bounds__(NTHR, 2) fwd(Args args) {
    extern __shared__ __attribute__((aligned(16))) unsigned char lds_raw[];
    Ctx C;
    C.lds = (LAS unsigned char*)lds_raw;
    C.tid = threadIdx.x; C.lane = C.tid & 63; C.wave = __builtin_amdgcn_readfirstlane(C.tid >> 6);
    C.G = gridDim.x; C.bx = blockIdx.x; C.gw = C.bx * NWAVES + C.wave; C.NGW = C.G * NWAVES; C.gtid = C.bx * NTHR + C.tid; C.NT = C.G * NTHR;
    C.ws = args.ws;
#pragma unroll
    for (int i = 0; i < 21; ++i) C.in[i] = args.in[i];
    volatile LAS unsigned* MISC = (volatile LAS unsigned*)(C.lds + MISC_OFF);
    for (int u = C.tid; u < (LDS_BYTES - LDSCTL_OFF) / 4; u += NTHR) ((LAS unsigned*)(C.lds + LDSCTL_OFF))[u] = 0u;
    __syncthreads();
    const int lo = args.ph_lo, hi = args.ph_hi;
    unsigned* barw = (unsigned*)(C.ws + WS_CTL) + CW_BAR;
    XcdBarrier bar; bar.bar = barw; bar.x = 0; bar.st = nullptr;
    if (hi - lo > 1) bar = xcd_barrier_post(barw, MISC + 8);
#define IN(k) (lo <= (k) && (k) < hi)
#define SEAM(k) do { if (IN(k) && IN((k) + 1)) xcd_barrier(bar); } while (0)
    LAS unsigned char* ring = C.lds + RING_OFF;
    const float* cosT = WSP(float, WS_ROPE); const float* sinT = cosT + 1024;

    if (IN(0)) for (int rep = 0; rep < REPS(0); ++rep) { p_prologue(C); } SEAM(0);
    if (IN(1)) for (int rep = 0; rep < REPS(1); ++rep) { p_norm<false, 0>(C, 0, 0, true, true, true, false); } SEAM(1);
    if (IN(2)) for (int rep = 0; rep < REPS(2); ++rep) { pg8::Gemm g{WSP(bf16, WS_A), WSP(bf16, WS_WIN), RALL, NPROJP, D, D}; pg8::StaticOrder S; S.init(RALL, NPROJP, C.G, C.bx);
        pg8::EpiInProj E{WSP(bf16, WS_PROJ), cosT, sinT};
        pg8::gemm_phase<pg8::EpiInProj, pg8::StaticOrder, true, true>(ring, g, S, E); } SEAM(2);
    if (IN(3)) for (int rep = 0; rep < REPS(3); ++rep) { p_mix1(C, 0); } SEAM(3);
    if (IN(4)) for (int rep = 0; rep < REPS(4); ++rep) { p_mix2(C, 0); } SEAM(4);
    if (IN(5)) for (int rep = 0; rep < REPS(5); ++rep) { p_mix3(C, 0); } SEAM(5);
    if (IN(6)) for (int rep = 0; rep < REPS(6); ++rep) { { pg8::Gemm g{WSP(bf16, WS_YMIX), WSP(bf16, WS_WOUT), RLAT, D, D, D}; pg8::StaticOrder S; S.init(RLAT, D, C.G, C.bx);
        pg8::EpiResid E{WSP(float, WS_H), C.in[0], C.in[2], WSP(float, WS_MOD), 2 * D};
        pg8::gemm_phase<pg8::EpiResid, pg8::StaticOrder, true, true>(ring, g, S, E); }
        { pg8::Gemm g{WSP(bf16, WS_YMIX) + (size_t)RLAT * D, WSP(bf16, WS_WOUT), RCTX, D, 256, D}; pg8::SplitOrder S; S.init(4, C.G, C.bx);
        pg8::EpiPartial E{WSP(float, WS_PART), WSP(float, WS_MOD), 2 * D};
        pg8::gemm_phase<pg8::EpiPartial, pg8::SplitOrder, false, true>(ring, g, S, E); } } SEAM(6);
    if (IN(7)) for (int rep = 0; rep < REPS(7); ++rep) { p_norm<false, 4>(C, 0, 1, true, false, true, true); } SEAM(7);
    if (IN(8)) for (int rep = 0; rep < REPS(8); ++rep) { pg8::Gemm g{WSP(bf16, WS_A), WSP(bf16, WS_FIN), RALL, 2 * DFF, D, D}; pg8::StaticOrder S; S.init(RALL, 2 * DFF, C.G, C.bx);
        pg8::EpiSwiglu E{WSP(bf16, WS_HID)};
        pg8::gemm_phase<pg8::EpiSwiglu, pg8::StaticOrder, true, true>(ring, g, S, E); } SEAM(8);
    if (IN(9)) for (int rep = 0; rep < REPS(9); ++rep) { { pg8::Gemm g{WSP(bf16, WS_HID), WSP(bf16, WS_FOUT), RLAT, D, DFF, DFF}; pg8::StaticOrder S; S.init(RLAT, D, C.G, C.bx);
        pg8::EpiResid E{WSP(float, WS_H), WSP(float, WS_H), WSP(float, WS_H) + (size_t)RLAT * D, WSP(float, WS_MOD), 5 * D};
        pg8::gemm_phase<pg8::EpiResid, pg8::StaticOrder, true, true>(ring, g, S, E); }
        { pg8::Gemm g{WSP(bf16, WS_HID) + (size_t)RLAT * DFF, WSP(bf16, WS_FOUT), RCTX, D, 256, DFF}; pg8::SplitOrder S; S.init(11, C.G, C.bx);
        pg8::EpiPartial E{WSP(float, WS_PART), WSP(float, WS_MOD), 5 * D};
        pg8::gemm_phase<pg8::EpiPartial, pg8::SplitOrder, false, true>(ring, g, S, E); } } SEAM(9);
    if (IN(10)) for (int rep = 0; rep < REPS(10); ++rep) { p_norm<false, 11>(C, 1, 0, true, false, false, false); } SEAM(10);
    if (IN(11)) for (int rep = 0; rep < REPS(11); ++rep) { pg8::Gemm g{WSP(bf16, WS_A), WSP(bf16, WS_WIN) + (size_t)NPROJP * D, RALL, NPROJP, D, D}; pg8::StaticOrder S; S.init(RALL, NPROJP, C.G, C.bx);
        pg8::EpiInProj E{WSP(bf16, WS_PROJ), cosT, sinT};
        pg8::gemm_phase<pg8::EpiInProj, pg8::StaticOrder, true, true>(ring, g, S, E); } SEAM(11);
    if (IN(12)) for (int rep = 0; rep < REPS(12); ++rep) { p_mix1(C, 1); } SEAM(12);
    if (IN(13)) for (int rep = 0; rep < REPS(13); ++rep) { p_mix2(C, 1); } SEAM(13);
    if (IN(14)) for (int rep = 0; rep < REPS(14); ++rep) { p_mix3(C, 1); } SEAM(14);
    if (IN(15)) for (int rep = 0; rep < REPS(15); ++rep) { pg8::Gemm g{WSP(bf16, WS_YMIX), WSP(bf16, WS_WOUT) + (size_t)D * D, RLAT, D, D, D}; pg8::StaticOrder S; S.init(RLAT, D, C.G, C.bx);
        pg8::EpiResid E{WSP(float, WS_H), WSP(float, WS_H), WSP(float, WS_H) + (size_t)RLAT * D, WSP(float, WS_MOD) + 30720, 2 * D};
        pg8::gemm_phase<pg8::EpiResid, pg8::StaticOrder, true, true>(ring, g, S, E); } SEAM(15);
    if (IN(16)) for (int rep = 0; rep < REPS(16); ++rep) { p_norm<true, 0>(C, 1, 1, false, false, false, false); } SEAM(16);
    if (IN(17)) for (int rep = 0; rep < REPS(17); ++rep) { p_moe_lists(C); } SEAM(17);
    if (IN(18)) for (int rep = 0; rep < REPS(18); ++rep) { const int T = __builtin_amdgcn_readfirstlane(WSP(int, WS_TILE)[255]);
        pg8::Gemm g{WSP(bf16, WS_SORT), WSP(bf16, WS_MIN), T * 256, 2 * DFF, D / 2, D / 2}; pg8::MoeOrder S; S.init(T, 2 * DFF, C.G, C.bx, WSP(int, WS_TILE), (size_t)2 * DFF * D / 2);
        pg8::EpiSwigluF8 E{WSP(unsigned char, WS_HID)};
        pg8::gemm_phase<pg8::EpiSwigluF8, pg8::MoeOrder, true, true, true>(ring, g, S, E); } SEAM(18);
    if (IN(19)) for (int rep = 0; rep < REPS(19); ++rep) { const int T = __builtin_amdgcn_readfirstlane(WSP(int, WS_TILE)[255]);
        pg8::Gemm g{WSP(bf16, WS_HID), WSP(bf16, WS_MOUT), T * 256, D, DFF / 2, DFF / 2}; pg8::MoeOrder S; S.init(T, D, C.G, C.bx, WSP(int, WS_TILE), (size_t)D * DFF / 2);
        pg8::EpiSlots E{WSP(bf16, WS_SLOT), WSP(float, WS_ROWW)};
        pg8::gemm_phase<pg8::EpiSlots, pg8::MoeOrder, true, true, true>(ring, g, S, E); } SEAM(19);
    if (IN(20)) for (int rep = 0; rep < REPS(20); ++rep) { p_final(C, args.out); }
#undef IN
#undef SEAM
}

extern "C" void kernel_launch(void* const* d_in, const int* in_sizes, int n_in, void* d_out, int out_size, void* d_ws, size_t ws_size, hipStream_t stream) {
    static int grid = 0;
    if (grid == 0) {
        if (n_in != 21 || ws_size < WS_END) { fprintf(stderr, "kernel_launch: unexpected n_in %d or ws_size %zu (need %zu)\n", n_in, ws_size, (size_t)WS_END); grid = -1; return; }
        int dev = 0, cus = 0, per_cu = 0;
        if (hipGetDevice(&dev) != hipSuccess || hipDeviceGetAttribute(&cus, hipDeviceAttributeMultiprocessorCount, dev) != hipSuccess) { grid = -1; return; }
        if (hipFuncSetAttribute((const void*)fwd, hipFuncAttributeMaxDynamicSharedMemorySize, LDS_BYTES) != hipSuccess) { fprintf(stderr, "kernel_launch: hipFuncSetAttribute failed\n"); grid = -1; return; }
        if (hipOccupancyMaxActiveBlocksPerMultiprocessor(&per_cu, (const void*)fwd, NTHR, LDS_BYTES) != hipSuccess || per_cu < 1) fprintf(stderr, "kernel_launch: occupancy query reports %d\n", per_cu);
        (void)hipGetLastError();
        grid = cus < 256 ? cus : 256;
    }
    if (grid < 0) return;
    (void)hipMemsetAsync((char*)d_ws + WS_CTL, 0, CTL_ZERO_BYTES, stream);
    Args a{};
    for (int i = 0; i < 21; ++i) a.in[i] = (const float*)d_in[i];
    a.out = (float*)d_out; a.ws = (unsigned char*)d_ws;
#if MK_ONE_LAUNCH
    a.ph_lo = 0; a.ph_hi = NPHASES;
    hipLaunchKernelGGL(fwd, dim3(grid), dim3(NTHR), LDS_BYTES, stream, a);
#else
    for (int p = 0; p < NPHASES; ++p) { a.ph_lo = p; a.ph_hi = p + 1; hipLaunchKernelGGL(fwd, dim3(grid), dim3(NTHR), LDS_BYTES, stream, a); }
#endif
}
```

```cpp
#include <hip/hip_runtime.h>
#include <cstdio>
#include <cstdint>
namespace pg8 {
#define PG8_LAS __attribute__((address_space(3)))
typedef unsigned short bf16_t;
typedef short bf16x8 __attribute__((ext_vector_type(8)));
typedef float f32x4 __attribute__((ext_vector_type(4)));
typedef unsigned u32x4 __attribute__((ext_vector_type(4)));
constexpr int BM = 256, BK = 64, HALF = 128, HTB = HALF * BK * 2  , STAGE_BYTES = 8 * HTB, NXCD = 8, WGM = 8;

__host__ __device__ __forceinline__ int lds_byte(int r, int c) { const int st = (r >> 4) * 2 + (c >> 5), rr = r & 15, cc = c & 31, ob = rr * 64 + cc * 2; return st * 1024 + (ob ^ (((ob >> 9) & 1) << 5)); }
__host__ __device__ __forceinline__ void stage_rc(int b, int& R, int& C) { const int st = b / 1024, sb = b % 1024, swz = sb ^ (((sb >> 9) & 1) << 5); R = (st >> 1) * 16 + swz / 64; C = (st & 1) * 32 + (swz % 64) / 2; }
__host__ __device__ __forceinline__ int perm32(int rho) { const int n = rho >> 4, i = rho & 15; return 8 * (i >> 2) + 4 * n + (i & 3); }

struct Unit { int pm, pn, ks; };
struct Gemm { const bf16_t* A; const bf16_t* Bt; int M, N, K, ld; };

struct StaticOrder {
    int nM, nN, nwg, G, c;
    __host__ __device__ void init(int M, int N, int G_, int c_) { nM = M / BM; nN = N / BM; nwg = nM * nN; G = G_; c = c_; }
    __host__ __device__ bool next(int i, Unit& u) const {
        const long L = (long)i * G + c; if (L >= nwg) return false;
        int wgid = (int)L; { const int q = nwg / NXCD, r = nwg % NXCD, xcd = wgid % NXCD, off = wgid / NXCD; wgid = (xcd < r ? xcd * (q + 1) : r * (q + 1) + (xcd - r) * q) + off; }
        const int nig = WGM * nN, gid = wgid / nig, fm = gid * WGM, gsz = (nM - fm) < WGM ? (nM - fm) : WGM;
        u.pm = fm + ((wgid % nig) % gsz); u.pn = (wgid % nig) / gsz; u.ks = 0; return true;
    }
    __device__ __forceinline__ void a_ready(const Unit&) const {}
    __device__ __forceinline__ void done(const Unit&) const {}
    __device__ __forceinline__ const bf16_t* bt(const Gemm& g, const Unit&) const { return g.Bt; }
};

__device__ __forceinline__ unsigned cvt_pk_bf16(float lo, float hi) { unsigned r; asm volatile("v_cvt_pk_bf16_f32 %0, %1, %2" : "=v"(r) : "v"(lo), "v"(hi)); return r; }
typedef float f32x2 __attribute__((ext_vector_type(2)));

typedef int i32x4_t __attribute__((ext_vector_type(4)));
typedef int i32x8_t __attribute__((ext_vector_type(8)));
__device__ __forceinline__ i32x8_t cat8(bf16x8 lo, bf16x8 hi) { const i32x4_t l = __builtin_bit_cast(i32x4_t, lo), h = __builtin_bit_cast(i32x4_t, hi); return __builtin_shufflevector(l, h, 0, 1, 2, 3, 4, 5, 6, 7); }
template <class Epi, class Sched, bool ALIGN_EPI = false, bool SP2 = false, bool FP8 = false>
__device__ __forceinline__ void gemm_phase(PG8_LAS unsigned char* lds, const Gemm g, const Sched& S, const Epi& E) {
    const int tid = threadIdx.x, wid = __builtin_amdgcn_readfirstlane(tid >> 6), lane = tid & 63, wr = wid >> 2, wc = wid & 3, fr = lane & 15, fq = lane >> 4;
    const int K = g.K, nt = K / BK, LD = g.ld;
    unsigned voffA[2], voffB[2];
#pragma unroll
    for (int i = 0; i < 2; ++i) { int R, C; stage_rc(tid * 16 + i * 8192, R, C); const int Rb = Epi::PERM ? ((R & ~31) + perm32(R & 31)) : R;
        voffA[i] = (unsigned)(R * LD + C) * 2u; voffB[i] = (unsigned)(Rb * LD + C) * 2u; }
    const size_t kstep = (size_t)(BK * 2);
    const size_t hstep = (size_t)HALF * LD * 2;
    const size_t tstep = 2 * hstep;
    const unsigned ldsw = (unsigned)wid * 1024u;
    const int aoff = lds_byte(wr * 64 + fr, fq * 8), boff = lds_byte(wc * 32 + fr, fq * 8);
#define PG8_SA(b, h) (((b) * 2 + (h)) * HTB)
#define PG8_SB(b, h) ((4 + (b) * 2 + (h)) * HTB)
#define PG8_STAGE(bufoff, gbase, voff) do { _Pragma("unroll") for (int _i = 0; _i < 2; ++_i) \
        __builtin_amdgcn_global_load_lds((const unsigned*)((const char*)(gbase) + (voff)[_i]), (PG8_LAS unsigned*)(lds + (bufoff) + ldsw + _i * 8192), 16, 0, 0); } while (0)
#define PG8_LDA(dst, b, h) do { if constexpr (FP8) { _Pragma("unroll") for (int m = 0; m < 4; ++m) dst##_8[m] = cat8(*(const PG8_LAS bf16x8*)(lds + PG8_SA(b, h) + aoff + m * 2048), *(const PG8_LAS bf16x8*)(lds + PG8_SA(b, h) + aoff + m * 2048 + 1024)); } \
    else { _Pragma("unroll") for (int m = 0; m < 4; ++m) _Pragma("unroll") for (int k = 0; k < 2; ++k) dst[m][k] = *(const PG8_LAS bf16x8*)(lds + PG8_SA(b, h) + aoff + m * 2048 + k * 1024); } } while (0)
#define PG8_LDB(dst, b, h) do { if constexpr (FP8) { _Pragma("unroll") for (int n = 0; n < 2; ++n) dst##_8[n] = cat8(*(const PG8_LAS bf16x8*)(lds + PG8_SB(b, h) + boff + n * 2048), *(const PG8_LAS bf16x8*)(lds + PG8_SB(b, h) + boff + n * 2048 + 1024)); } \
    else { _Pragma("unroll") for (int n = 0; n < 2; ++n) _Pragma("unroll") for (int k = 0; k < 2; ++k) dst[n][k] = *(const PG8_LAS bf16x8*)(lds + PG8_SB(b, h) + boff + n * 2048 + k * 1024); } } while (0)
#define PG8_MMA(ai, bj, At, Bt) do { __builtin_amdgcn_s_setprio(1); _Pragma("unroll") for (int m = 0; m < 4; ++m) _Pragma("unroll") for (int n = 0; n < 2; ++n) { \
        if constexpr (FP8) { asm volatile("v_mfma_scale_f32_16x16x128_f8f6f4 %0, %1, %2, %0, %3, %4 op_sel_hi:[0,0,0]" : "+v"(acc[ai][bj][m][n]) : "v"(Bt##_8[n]), "v"(At##_8[m]), "v"(f8_scale_w), "v"(f8_scale_a)); } \
        else { _Pragma("unroll") for (int k = 0; k < 2; ++k) acc[ai][bj][m][n] = __builtin_amdgcn_mfma_f32_16x16x32_bf16(Bt[n][k], At[m][k], acc[ai][bj][m][n], 0, 0, 0); } } __builtin_amdgcn_s_setprio(0); } while (0)
#define PG8_WAIT_V(n) asm volatile("s_waitcnt vmcnt(" #n ")" ::: "memory")
#define PG8_WAIT_L(n) asm volatile("s_waitcnt lgkmcnt(" #n ")" ::: "memory")
#define PG8_BAR __builtin_amdgcn_s_barrier()
#define PG8_SCHED __builtin_amdgcn_sched_barrier(0)
    Unit cur, nxt; int ui = 0;
    if (!S.next(0, cur)) return;
    f32x4 acc[2][2][4][2];
#pragma unroll
    for (int a = 0; a < 2; ++a)
#pragma unroll
        for (int b = 0; b < 2; ++b)
#pragma unroll
            for (int m = 0; m < 4; ++m)
#pragma unroll
                for (int n = 0; n < 2; ++n) acc[a][b][m][n] = (f32x4){0.f, 0.f, 0.f, 0.f};
    bf16x8 At[4][2], B0[2][2], B1[2][2]; i32x8_t At_8[4], B0_8[2], B1_8[2];
    const int f8_scale_w = 0x79797979, f8_scale_a = 0x7f7f7f7f;
    const char* cA = (const char*)g.A + (size_t)cur.pm * tstep + (size_t)cur.ks * K * 2; const char* cB = (const char*)S.bt(g, cur) + (size_t)cur.pn * tstep + (size_t)cur.ks * K * 2;
    S.a_ready(cur);
    if constexpr (SP2) {
        PG8_STAGE(PG8_SB(0, 0), cB, voffB); PG8_STAGE(PG8_SB(0, 1), cB + hstep, voffB); PG8_STAGE(PG8_SA(0, 0), cA, voffA); PG8_STAGE(PG8_SA(0, 1), cA + hstep, voffA);
        if (wr == 1) PG8_BAR;
        PG8_WAIT_V(2); PG8_BAR;
        PG8_STAGE(PG8_SB(1, 0), cB + kstep, voffB); PG8_STAGE(PG8_SA(1, 0), cA + kstep, voffA); PG8_STAGE(PG8_SB(1, 1), cB + hstep + kstep, voffB);
        PG8_WAIT_V(6); PG8_BAR;
    } else {
        PG8_STAGE(PG8_SB(0, 0), cB, voffB); PG8_STAGE(PG8_SA(0, 0), cA, voffA); PG8_STAGE(PG8_SB(0, 1), cB + hstep, voffB); PG8_STAGE(PG8_SA(0, 1), cA + hstep, voffA);
        if (wr == 1) PG8_BAR;
        PG8_WAIT_V(4); PG8_BAR;
        PG8_STAGE(PG8_SB(1, 0), cB + kstep, voffB); PG8_STAGE(PG8_SA(1, 0), cA + kstep, voffA); PG8_STAGE(PG8_SB(1, 1), cB + hstep + kstep, voffB);
        PG8_WAIT_V(6); PG8_BAR;
    }
    for (;;) {
        const bool has_next = S.next(ui + 1, nxt);
        const char* nA = has_next ? (const char*)g.A + (size_t)nxt.pm * tstep + (size_t)nxt.ks * K * 2 : cA; const char* nB = has_next ? (const char*)S.bt(g, nxt) + (size_t)nxt.pn * tstep + (size_t)nxt.ks * K * 2 : cB;
#pragma clang loop unroll(disable)
        for (int t = 0; t < nt; t += 2) {
            const bool last = (t == nt - 2);
            const char* a1 = cA + (size_t)(t + 1) * kstep;
            const char* a2 = last ? nA : cA + (size_t)(t + 2) * kstep; const char* b2 = last ? nB : cB + (size_t)(t + 2) * kstep;
            const char* a3 = a2 + kstep; const char* b3 = b2 + kstep;
            if (last && has_next) S.a_ready(nxt);
            if constexpr (SP2) {
            PG8_LDB(B0, 0, 0); PG8_LDB(B1, 0, 1); PG8_SCHED; PG8_LDA(At, 0, 0); PG8_STAGE(PG8_SA(1, 1), a1 + hstep, voffA);
            PG8_WAIT_V(8); PG8_WAIT_L(0); PG8_BAR; PG8_MMA(0, 0, At, B0); PG8_MMA(0, 1, At, B1); PG8_BAR; PG8_SCHED;
            PG8_LDA(At, 0, 1); PG8_STAGE(PG8_SB(0, 0), b2, voffB); PG8_STAGE(PG8_SB(0, 1), b2 + hstep, voffB); PG8_STAGE(PG8_SA(0, 0), a2, voffA);
            PG8_WAIT_V(8); PG8_WAIT_L(0); PG8_BAR; PG8_MMA(1, 0, At, B0); PG8_MMA(1, 1, At, B1); PG8_BAR; PG8_SCHED;
            PG8_LDB(B0, 1, 0); PG8_LDB(B1, 1, 1); PG8_SCHED; PG8_LDA(At, 1, 0); PG8_STAGE(PG8_SA(0, 1), a2 + hstep, voffA);
            PG8_WAIT_V(8); PG8_WAIT_L(0); PG8_BAR; PG8_MMA(0, 0, At, B0); PG8_MMA(0, 1, At, B1); PG8_BAR; PG8_SCHED;
            PG8_LDA(At, 1, 1); PG8_STAGE(PG8_SB(1, 0), b3, voffB); PG8_STAGE(PG8_SB(1, 1), b3 + hstep, voffB); PG8_STAGE(PG8_SA(1, 0), a3, voffA);
            PG8_WAIT_V(8); PG8_WAIT_L(0); PG8_BAR; PG8_MMA(1, 0, At, B0); PG8_MMA(1, 1, At, B1); PG8_BAR; PG8_SCHED;
            } else {
            PG8_LDB(B0, 0, 0); PG8_SCHED; PG8_LDA(At, 0, 0); PG8_STAGE(PG8_SA(1, 1), a1 + hstep, voffA);
            PG8_WAIT_L(8); PG8_BAR; PG8_WAIT_L(0); PG8_MMA(0, 0, At, B0); PG8_BAR; PG8_SCHED;
            PG8_LDB(B1, 0, 1); PG8_STAGE(PG8_SB(0, 0), b2, voffB);
            PG8_BAR; PG8_WAIT_L(0); PG8_MMA(0, 1, At, B1); PG8_BAR;
            PG8_LDA(At, 0, 1); PG8_STAGE(PG8_SA(0, 0), a2, voffA);
            PG8_BAR; PG8_WAIT_L(0); PG8_MMA(1, 0, At, B0); PG8_BAR; PG8_SCHED;
            PG8_STAGE(PG8_SB(0, 1), b2 + hstep, voffB);
            PG8_WAIT_V(6); PG8_BAR; PG8_MMA(1, 1, At, B1); PG8_BAR;
            PG8_LDB(B0, 1, 0); PG8_SCHED; PG8_LDA(At, 1, 0); PG8_STAGE(PG8_SA(0, 1), a2 + hstep, voffA);
            PG8_WAIT_L(8); PG8_BAR; PG8_WAIT_L(0); PG8_MMA(0, 0, At, B0); PG8_BAR; PG8_SCHED;
            PG8_LDB(B1, 1, 1); PG8_STAGE(PG8_SB(1, 0), b3, voffB);
            PG8_BAR; PG8_WAIT_L(0); PG8_MMA(0, 1, At, B1); PG8_BAR;
            PG8_LDA(At, 1, 1); PG8_STAGE(PG8_SA(1, 0), a3, voffA);
            PG8_BAR; PG8_WAIT_L(0); PG8_MMA(1, 0, At, B0); PG8_BAR; PG8_SCHED;
            PG8_STAGE(PG8_SB(1, 1), b3 + hstep, voffB);
            PG8_WAIT_V(6); PG8_BAR; PG8_MMA(1, 1, At, B1); PG8_BAR;
            }
        }
        if constexpr (ALIGN_EPI) { if (wr == 0) PG8_BAR; }
        if constexpr (FP8) asm volatile("s_nop 15\n\ts_nop 15" ::: "memory");
        if constexpr (!Epi::AFTER_DRAIN) { E(acc, cur, wr, wc, fr, fq); S.done(cur); }
        if (!has_next) break;
#pragma unroll
        for (int a = 0; a < 2; ++a)
#pragma unroll
            for (int b = 0; b < 2; ++b)
#pragma unroll
                for (int m = 0; m < 4; ++m)
#pragma unroll
                    for (int n = 0; n < 2; ++n) acc[a][b][m][n] = (f32x4){0.f, 0.f, 0.f, 0.f};
        cur = nxt; cA = nA; cB = nB; ++ui;
        if constexpr (ALIGN_EPI) { if (wr == 1) PG8_BAR; }
    }
    PG8_WAIT_V(0);
    if constexpr (!ALIGN_EPI) { if (wr == 0) PG8_BAR; }
    PG8_BAR;
    if constexpr (Epi::AFTER_DRAIN) { E.fused(acc, cur, wr, wc, fr, fq, lds, wid, lane); S.done(cur); }
#undef PG8_SA
#undef PG8_SB
#undef PG8_STAGE
#undef PG8_LDA
#undef PG8_LDB
#undef PG8_MMA
#undef PG8_WAIT_V
#undef PG8_WAIT_L
#undef PG8_BAR
#undef PG8_SCHED
}
}


constexpr int NWAVES = 8, NTHR = 512;
constexpr int D = 1024, NB = 4, SEQ = 4096, CTXL = 256, RLAT = NB * SEQ, RCTX = NB * CTXL, RALL = RLAT + RCTX;
constexpr int NPROJ = 3456, NPROJP = 3584, DFF = 2816, NE = 8;
constexpr int C_RQ = 0, C_RK = 384, C_RV = 768, C_RG = 1152, C_CB = 1536, C_CC = 1792, C_CX = 2048, C_NQ = 2304, C_NK = 2688, C_NV = 3072;
constexpr int MOE_ROWS = 2 * RLAT + NE * 256;
constexpr float EPS = 1e-6f;

constexpr size_t MiB = 1u << 20, KiB = 1u << 10;
constexpr size_t WS_CTL = 0, CTL_ZERO_BYTES = 1 * MiB;
constexpr size_t WS_MODP = 1 * MiB;
constexpr size_t WS_MOD = 3 * MiB;
constexpr size_t WS_ROWW = 3 * MiB + 256 * KiB;
constexpr size_t WS_ROPE = 3 * MiB + 512 * KiB;
constexpr size_t WS_CNT = WS_ROPE + 16 * KiB;
constexpr size_t WS_TILE = WS_ROPE + 32 * KiB;
constexpr size_t WS_TOKE = WS_ROPE + 64 * KiB;
constexpr size_t WS_TOKW = WS_ROPE + 128 * KiB;
constexpr size_t WS_TOKP = WS_ROPE + 256 * KiB;
constexpr size_t WS_WIN = 4 * MiB;
constexpr size_t WS_WOUT = 18 * MiB;
constexpr size_t WS_FIN = 22 * MiB;
constexpr size_t WS_FOUT = 33 * MiB;
constexpr size_t WS_MIN = 39 * MiB;
constexpr size_t WS_MOUT = 127 * MiB;
constexpr size_t WS_H = 171 * MiB;
constexpr size_t WS_A = 239 * MiB;
constexpr size_t WS_PROJ = 273 * MiB;
constexpr size_t WS_YMIX = 392 * MiB;
constexpr size_t WS_HID = 273 * MiB;
constexpr size_t WS_OBUF = 474 * MiB;
constexpr size_t WS_SORT = 526 * MiB;
constexpr size_t WS_SLOT = 474 * MiB;
constexpr size_t WS_PART = 610 * MiB;
constexpr size_t WS_END = 654 * MiB;
constexpr int CW_BAR = 4096;

constexpr int RING_OFF = 0, RING_BYTES = 157696;
constexpr int LDSCTL_OFF = RING_BYTES, MISC_OFF = LDSCTL_OFF + 320;
constexpr int LDS_BYTES = 158720;

#define GAS __attribute__((address_space(1)))
#define LAS __attribute__((address_space(3)))
typedef unsigned short bf16;
typedef unsigned v4u __attribute__((ext_vector_type(4)));
typedef unsigned v2u __attribute__((ext_vector_type(2)));
typedef float f32x4 __attribute__((ext_vector_type(4)));
typedef GAS unsigned gu32;
#define RLX_AGENT __ATOMIC_RELAXED, __HIP_MEMORY_SCOPE_AGENT
#define LDS_WAIT() asm volatile("s_waitcnt lgkmcnt(0)" ::: "memory")
__device__ __forceinline__ unsigned f2bf(float f) { unsigned u = __builtin_bit_cast(unsigned, f); return (u + 0x7fffu + ((u >> 16) & 1u)) >> 16; }
__device__ __forceinline__ unsigned pk2(float lo, float hi) { return f2bf(lo) | (f2bf(hi) << 16); }
__device__ __forceinline__ float bf2f(unsigned short b) { return __builtin_bit_cast(float, (unsigned)b << 16); }
__device__ __forceinline__ float bflo(unsigned u) { return __builtin_bit_cast(float, u << 16); }
__device__ __forceinline__ float bfhi(unsigned u) { return __builtin_bit_cast(float, u & 0xffff0000u); }
__device__ __forceinline__ float siluf(float x) { return x * __builtin_amdgcn_rcpf(1.f + __expf(-x)); }
__device__ __forceinline__ float wave_sum(float v) {
#pragma unroll
    for (int o = 1; o < 64; o <<= 1) v += __shfl_xor(v, o);
    return v;
}
__device__ __forceinline__ float wave_max(float v) {
#pragma unroll
    for (int o = 1; o < 64; o <<= 1) v = fmaxf(v, __shfl_xor(v, o));
    return v;
}
#define XB_TMO      128
#define XB_XCNT(j)  (256  + 64 * (j))
#define XB_XSUB(j)  (1280 + 64 * (j))
#define XB_XGEN(j)  (2304 + 64 * (j))
#define XB_TOP      3328
#define XB_TOPGEN   3392
#define XCD_BAR_WORDS 3456
#define XB_SPIN_CAP (1u << 18)

__device__ __forceinline__ unsigned xb_ld(unsigned* p)              { return __hip_atomic_load(p, __ATOMIC_RELAXED, __HIP_MEMORY_SCOPE_AGENT); }
__device__ __forceinline__ unsigned xb_add(unsigned* p, unsigned v) { return __hip_atomic_fetch_add(p, v, __ATOMIC_RELAXED, __HIP_MEMORY_SCOPE_AGENT); }
__device__ __forceinline__ unsigned xb_xcc_id() { return (unsigned)__builtin_amdgcn_s_getreg((3 << 11) | 20) & 0xFu; }
#define XB_SPIN(cond, bar) do { unsigned _sp = 0; while (cond) { __builtin_amdgcn_s_sleep(1); \
    if ((++_sp & 255u) == 0u) { if (xb_ld(&(bar)[XB_TMO])) break; if (_sp > XB_SPIN_CAP) { atomicAdd(&(bar)[XB_TMO], 1u); break; } } } } while (0)

struct XcdBarrier {
    unsigned* bar; unsigned x;
    volatile LAS unsigned* st;
};

__device__ __forceinline__ XcdBarrier xcd_barrier_post(unsigned* bar, volatile LAS unsigned* st) {
    XcdBarrier b; b.bar = bar; b.x = xb_xcc_id(); b.st = st;
    if (threadIdx.x == 0) (void)xb_add(&bar[XB_XCNT(b.x)], 1u);
    return b;
}
__device__ __forceinline__ void xcd_barrier_complete(unsigned* bar, unsigned x, unsigned& nloc, unsigned& nx) {
    const unsigned G = gridDim.x * gridDim.y * gridDim.z;
    unsigned sum, cnt, mine, sp = 0u;
    for (;;) {
        sum = 0u; cnt = 0u; mine = 0u;
#pragma unroll
        for (unsigned j = 0; j < 16; ++j) { const unsigned c = xb_ld(&bar[XB_XCNT(j)]); sum += c; cnt += (c > 0u) ? 1u : 0u; mine = (j == x) ? c : mine; }
        if (sum == G) break;
        __builtin_amdgcn_s_sleep(1);
        if ((++sp & 255u) == 0u) { if (xb_ld(&bar[XB_TMO])) break; if (sp > XB_SPIN_CAP) { atomicAdd(&bar[XB_TMO], 1u); break; } }
    }
    nloc = mine > 0u ? mine : 1u; nx = cnt > 0u ? cnt : 1u;
}

__device__ __forceinline__ void xcd_barrier(const XcdBarrier& b) {
    asm volatile("s_waitcnt vmcnt(0)" ::: "memory");
    __syncthreads();
    if (threadIdx.x == 0) {
        unsigned* bar = b.bar;
        __builtin_amdgcn_s_waitcnt(0);
        unsigned nloc = b.st[0], nx = b.st[1];
        if (nloc == 0u) { xcd_barrier_complete(bar, b.x, nloc, nx); b.st[0] = nloc; b.st[1] = nx; }
        const unsigned old = xb_add(&bar[XB_XSUB(b.x)], 1u);
        const unsigned gen = old / nloc;
        if (old + 1u == (gen + 1u) * nloc) {
            __builtin_amdgcn_fence(__ATOMIC_RELEASE, "agent");
            asm volatile("s_waitcnt vmcnt(0)" ::: "memory");
            const unsigned og = xb_add(&bar[XB_TOP], 1u);
            const unsigned tg = og / nx;
            if (og + 1u == (tg + 1u) * nx) xb_add(&bar[XB_TOPGEN], 1u);
            else XB_SPIN(xb_ld(&bar[XB_TOPGEN]) == tg, bar);
            __builtin_amdgcn_fence(__ATOMIC_ACQUIRE, "agent");
            xb_add(&bar[XB_XGEN(b.x)], 1u);
            asm volatile("s_waitcnt vmcnt(0)" ::: "memory");
        } else {
            XB_SPIN(xb_ld(&bar[XB_XGEN(b.x)]) == gen, bar);
            __builtin_amdgcn_fence(__ATOMIC_ACQUIRE, "agent");
            asm volatile("s_waitcnt vmcnt(0)" ::: "memory");
        }
    }
    __syncthreads();
}


namespace pg8 {
struct EpiInProj {
    static constexpr bool PERM = true, AFTER_DRAIN = false;
    bf16_t* O; const float* cosT; const float* sinT;
    __device__ __forceinline__ void operator()(const f32x4 (&acc)[2][2][4][2], const Unit& u, int wr, int wc, int fr, int fq) const {
        const bool rope = (u.pn <= 2) && (u.pm < 64);
        const int row0 = u.pm * BM + wr * 64 + fr, col0 = u.pn * BM + wc * 32 + 8 * fq;
        const float sgn = (fq < 2) ? -1.f : 1.f;
#pragma unroll
        for (int ai = 0; ai < 2; ++ai)
#pragma unroll
            for (int m = 0; m < 4; ++m) {
                const int row = row0 + ai * HALF + m * 16;
                f32x4 cs0 = {1.f, 1.f, 1.f, 1.f}, cs1 = cs0, sn0 = {0.f, 0.f, 0.f, 0.f}, sn1 = sn0;
                if (rope) { const int t = row & 4095, pos = (wc & 1) ? (t & 63) : (t >> 6); const float* cp = cosT + pos * 16 + 8 * (fq & 1); const float* sp = sinT + pos * 16 + 8 * (fq & 1);
                    cs0 = *(const f32x4*)cp; cs1 = *(const f32x4*)(cp + 4); sn0 = *(const f32x4*)sp; sn1 = *(const f32x4*)(sp + 4); }
#pragma unroll
                for (int bj = 0; bj < 2; ++bj) {
                    f32x4 v0 = acc[ai][bj][m][0], v1 = acc[ai][bj][m][1];
                    if (rope) {
                        f32x4 p0, p1;
#pragma unroll
                        for (int j = 0; j < 4; ++j) { p0[j] = __shfl_xor(v0[j], 32); p1[j] = __shfl_xor(v1[j], 32); }
                        v0 = v0 * cs0 + (p0 * sn0) * sgn; v1 = v1 * cs1 + (p1 * sn1) * sgn;
                    }
                    const float sc = (u.pn == 2 || (u.pn == 1 && bj == 1)) ? 0.125f : 1.f;
                    v0 = v0 * sc; v1 = v1 * sc;
                    u32x4 w; w.x = cvt_pk_bf16(v0[0], v0[1]); w.y = cvt_pk_bf16(v0[2], v0[3]); w.z = cvt_pk_bf16(v1[0], v1[1]); w.w = cvt_pk_bf16(v1[2], v1[3]);
                    *(u32x4*)(O + (size_t)row * 3584 + col0 + bj * HALF) = w;
                }
            }
    }
};
struct EpiResid {
    static constexpr bool PERM = false, AFTER_DRAIN = false;
    float* H; const float* src_lat; const float* src_ctx; const float* gmod; int goff;
    __device__ __forceinline__ void operator()(const f32x4 (&acc)[2][2][4][2], const Unit& u, int wr, int wc, int fr, int fq) const {
        const int row0 = u.pm * BM + wr * 64 + fr, col0 = u.pn * BM + wc * 32 + 4 * fq;
        const int bi = (u.pm < 64) ? (u.pm >> 4) : 4;
        const float* src = (u.pm < 64) ? src_lat : src_ctx - (size_t)16384 * 1024;
        f32x4 gv[2][2];
#pragma unroll
        for (int bj = 0; bj < 2; ++bj)
#pragma unroll
            for (int n = 0; n < 2; ++n) gv[bj][n] = *(const f32x4*)(gmod + bi * 6144 + goff + col0 + bj * HALF + n * 16);
#pragma unroll
        for (int ai = 0; ai < 2; ++ai)
            {
                f32x4 sv[4][2][2];
#pragma unroll
                for (int m = 0; m < 4; ++m)
#pragma unroll
                    for (int bj = 0; bj < 2; ++bj)
#pragma unroll
                        for (int n = 0; n < 2; ++n) sv[m][bj][n] = *(const f32x4*)(src + (size_t)(row0 + ai * HALF + m * 16) * 1024 + col0 + bj * HALF + n * 16);
                asm volatile("" ::: "memory");
#pragma unroll
                for (int m = 0; m < 4; ++m)
#pragma unroll
                    for (int bj = 0; bj < 2; ++bj)
#pragma unroll
                        for (int n = 0; n < 2; ++n) *(f32x4*)(H + (size_t)(row0 + ai * HALF + m * 16) * 1024 + col0 + bj * HALF + n * 16) = sv[m][bj][n] + gv[bj][n] * acc[ai][bj][m][n];
                asm volatile("" ::: "memory");
            }
    }
};
struct EpiSwiglu {
    static constexpr bool PERM = true, AFTER_DRAIN = false;
    bf16_t* O;
    __device__ __forceinline__ void operator()(const f32x4 (&acc)[2][2][4][2], const Unit& u, int wr, int wc, int fr, int fq) const {
        const int row0 = u.pm * BM + wr * 64 + fr, col0 = u.pn * HALF + wc * 32 + 8 * fq;
#pragma unroll
        for (int ai = 0; ai < 2; ++ai)
#pragma unroll
            for (int m = 0; m < 4; ++m) {
                float hv[8];
#pragma unroll
                for (int n = 0; n < 2; ++n)
#pragma unroll
                    for (int j = 0; j < 4; ++j) { const float g = acc[ai][0][m][n][j], up = acc[ai][1][m][n][j]; hv[n * 4 + j] = g * __builtin_amdgcn_rcpf(1.f + __expf(-g)) * up; }
                u32x4 w; w.x = cvt_pk_bf16(hv[0], hv[1]); w.y = cvt_pk_bf16(hv[2], hv[3]); w.z = cvt_pk_bf16(hv[4], hv[5]); w.w = cvt_pk_bf16(hv[6], hv[7]);
                *(u32x4*)(O + (size_t)(row0 + ai * HALF + m * 16) * 2816 + col0) = w;
            }
    }
};
__device__ __forceinline__ unsigned pk4_fp8(float a, float b, float c2, float d) {
    a = fminf(fmaxf(a, -448.f), 448.f); b = fminf(fmaxf(b, -448.f), 448.f); c2 = fminf(fmaxf(c2, -448.f), 448.f); d = fminf(fmaxf(d, -448.f), 448.f);
    unsigned w = 0; w = __builtin_amdgcn_cvt_pk_fp8_f32(a, b, w, false); w = __builtin_amdgcn_cvt_pk_fp8_f32(c2, d, w, true); return w;
}
struct EpiSwigluF8 {
    static constexpr bool PERM = true, AFTER_DRAIN = false;
    unsigned char* O;
    __device__ __forceinline__ void operator()(const f32x4 (&acc)[2][2][4][2], const Unit& u, int wr, int wc, int fr, int fq) const {
        const int row0 = u.pm * BM + wr * 64 + fr, col0 = u.pn * HALF + wc * 32 + 8 * fq;
#pragma unroll
        for (int ai = 0; ai < 2; ++ai)
#pragma unroll
            for (int m = 0; m < 4; ++m) {
                float hv[8];
#pragma unroll
                for (int n = 0; n < 2; ++n)
#pragma unroll
                    for (int j = 0; j < 4; ++j) { const float g = acc[ai][0][m][n][j], up = acc[ai][1][m][n][j]; hv[n * 4 + j] = g * __builtin_amdgcn_rcpf(1.f + __expf(-g)) * up; }
                typedef unsigned u32x2 __attribute__((ext_vector_type(2)));
                u32x2 w; w.x = pk4_fp8(hv[0], hv[1], hv[2], hv[3]); w.y = pk4_fp8(hv[4], hv[5], hv[6], hv[7]);
                *(u32x2*)(O + (size_t)(row0 + ai * HALF + m * 16) * 2816 + col0) = w;
            }
    }
};
struct EpiSlots {
    static constexpr bool PERM = true, AFTER_DRAIN = false;
    bf16_t* S; const float* roww;
    __device__ __forceinline__ void operator()(const f32x4 (&acc)[2][2][4][2], const Unit& u, int wr, int wc, int fr, int fq) const {
        const int row0 = u.pm * BM + wr * 64 + fr, col0 = u.pn * BM + wc * 32 + 8 * fq;
#pragma unroll
        for (int ai = 0; ai < 2; ++ai)
#pragma unroll
            for (int m = 0; m < 4; ++m) { const int row = row0 + ai * HALF + m * 16; const float w = roww[row]; bf16_t* rowp = S + (size_t)row * 1024 + col0;
#pragma unroll
                for (int bj = 0; bj < 2; ++bj) { const f32x4 v0 = acc[ai][bj][m][0] * w, v1 = acc[ai][bj][m][1] * w;
                    u32x4 q; q.x = cvt_pk_bf16(v0[0], v0[1]); q.y = cvt_pk_bf16(v0[2], v0[3]); q.z = cvt_pk_bf16(v1[0], v1[1]); q.w = cvt_pk_bf16(v1[2], v1[3]);
                    *(u32x4*)(rowp + bj * HALF) = q; } }
    }
};
struct EpiPartial {
    static constexpr bool PERM = false, AFTER_DRAIN = false;
    float* P; const float* gmod; int goff;
    __device__ __forceinline__ void operator()(const f32x4 (&acc)[2][2][4][2], const Unit& u, int wr, int wc, int fr, int fq) const {
        const int row0 = u.pm * BM + wr * 64 + fr, col0 = u.pn * BM + wc * 32 + 4 * fq;
        f32x4 gv[2][2];
#pragma unroll
        for (int bj = 0; bj < 2; ++bj)
#pragma unroll
            for (int n = 0; n < 2; ++n) gv[bj][n] = *(const f32x4*)(gmod + 4 * 6144 + goff + col0 + bj * HALF + n * 16);
        float* base = P + (size_t)u.ks * 1024 * 1024;
#pragma unroll
        for (int ai = 0; ai < 2; ++ai)
#pragma unroll
            for (int m = 0; m < 4; ++m) { float* rowp = base + (size_t)(row0 + ai * HALF + m * 16) * 1024 + col0;
#pragma unroll
                for (int bj = 0; bj < 2; ++bj)
#pragma unroll
                    for (int n = 0; n < 2; ++n) *(f32x4*)(rowp + bj * HALF + n * 16) = gv[bj][n] * acc[ai][bj][m][n]; }
    }
};
struct SplitOrder {
    int nS, G, c;
    __device__ void init(int nS_, int G_, int c_) { nS = nS_; G = G_; c = c_; }
    __device__ bool next(int i, Unit& u) const { const int L = i * G + c; if (L >= 16 * nS) return false; u.ks = L % nS; const int t = L / nS; u.pm = t >> 2; u.pn = t & 3; return true; }
    __device__ __forceinline__ void a_ready(const Unit&) const {}
    __device__ __forceinline__ void done(const Unit&) const {}
    __device__ __forceinline__ const bf16_t* bt(const Gemm& g, const Unit&) const { return g.Bt; }
};
struct MoeOrder {
    StaticOrder so; const int* tile_e; size_t estride;
    __device__ void init(int T, int N, int G, int c, const int* te, size_t es) { so.init(T * BM, N, G, c); tile_e = te; estride = es; }
    __device__ bool next(int i, Unit& u) const { return so.next(i, u); }
    __device__ __forceinline__ void a_ready(const Unit&) const {}
    __device__ __forceinline__ void done(const Unit&) const {}
    __device__ __forceinline__ const bf16_t* bt(const Gemm& g, const Unit& u) const { const int e = __builtin_amdgcn_readfirstlane(tile_e[u.pm]); return g.Bt + (size_t)e * estride; }
};
}

struct Ctx {
    LAS unsigned char* lds;
    int tid, lane, wave, G, bx, gw, NGW, gtid, NT;
    unsigned char* ws;
    const float* in[21];
};
#define WSP(T, off) ((T*)(C.ws + (off)))

template <bool ILV>
__device__ __forceinline__ void transpose_item(const float* W, int K, int N, bf16* WT, LAS float* scr, int item, int lane) {
    const int nblk = N / 32, kb = item / nblk, nb = item % nblk, k0 = 64 * kb, n0 = 32 * nb;
    int drow = n0;
    if (ILV) drow = (n0 < DFF) ? (n0 / 128) * 256 + (n0 % 128) : ((n0 - DFF) / 128) * 256 + 128 + ((n0 - DFF) % 128);
#pragma unroll 8
    for (int i = 0; i < 32; ++i) { const int kk = 2 * i + (lane >> 5); scr[kk * 33 + (lane & 31)] = __builtin_nontemporal_load(&W[(size_t)(k0 + kk) * N + n0 + (lane & 31)]); }
    LDS_WAIT(); asm volatile("" ::: "memory");
    const int c = lane & 7;
#pragma unroll
    for (int j = 0; j < 4; ++j) { const int n = (lane >> 3) + 8 * j; const LAS float* s = scr + (8 * c) * 33 + n;
        v4u o; o.x = pk2(s[0 * 33], s[1 * 33]); o.y = pk2(s[2 * 33], s[3 * 33]); o.z = pk2(s[4 * 33], s[5 * 33]); o.w = pk2(s[6 * 33], s[7 * 33]);
        *(v4u*)(WT + (size_t)(drow + n) * K + k0 + 8 * c) = o; }
    LDS_WAIT(); asm volatile("" ::: "memory");
}
template <bool ILV>
__device__ __forceinline__ void transpose_item_f8(const float* W, int K, int N, unsigned char* WT, LAS float* scr, int item, int lane) {
    const int nblk = N / 32, kb = item / nblk, nb = item % nblk, k0 = 64 * kb, n0 = 32 * nb;
    int drow = n0;
    if (ILV) drow = (n0 < DFF) ? (n0 / 128) * 256 + (n0 % 128) : ((n0 - DFF) / 128) * 256 + 128 + ((n0 - DFF) % 128);
#pragma unroll 8
    for (int i = 0; i < 32; ++i) { const int kk = 2 * i + (lane >> 5); scr[kk * 33 + (lane & 31)] = __builtin_nontemporal_load(&W[(size_t)(k0 + kk) * N + n0 + (lane & 31)]); }
    LDS_WAIT(); asm volatile("" ::: "memory");
    const int c = lane & 7;
#pragma unroll
    for (int j = 0; j < 4; ++j) { const int n = (lane >> 3) + 8 * j; const LAS float* s = scr + (8 * c) * 33 + n;
        v2u o; o.x = pg8::pk4_fp8(s[0 * 33] * 64.f, s[1 * 33] * 64.f, s[2 * 33] * 64.f, s[3 * 33] * 64.f); o.y = pg8::pk4_fp8(s[4 * 33] * 64.f, s[5 * 33] * 64.f, s[6 * 33] * 64.f, s[7 * 33] * 64.f);
        *(v2u*)(WT + (size_t)(drow + n) * K + k0 + 8 * c) = o; }
    LDS_WAIT(); asm volatile("" ::: "memory");
}
struct ItemDesc { const float* W; unsigned char* WT; int K, N, k0, n0, drow, f8; };
__device__ __forceinline__ ItemDesc item_desc(const Ctx& C, int it) {
    const float* w_in = C.in[8]; const float* w_out = C.in[9]; const float* ffn_in = C.in[14]; const float* ffn_out = C.in[15]; const float* moe_in = C.in[18]; const float* moe_out = C.in[19];
    constexpr int I_WIN = 16 * (NPROJ / 32), I_WOUT = 16 * 32, I_FIN = 16 * (2 * DFF / 32), I_FOUT = (DFF / 64) * 32;
    ItemDesc d; int r = it, item, ilv = 0; d.f8 = 0;
    if (r < 2 * I_WIN) { const int l = r / I_WIN; d.W = w_in + (size_t)l * D * NPROJ; d.K = D; d.N = NPROJ; d.WT = (unsigned char*)(WSP(bf16, WS_WIN) + (size_t)l * NPROJP * D); item = r % I_WIN; }
    else if ((r -= 2 * I_WIN) < 2 * I_WOUT) { const int l = r / I_WOUT; d.W = w_out + (size_t)l * D * D; d.K = D; d.N = D; d.WT = (unsigned char*)(WSP(bf16, WS_WOUT) + (size_t)l * D * D); item = r % I_WOUT; }
    else if ((r -= 2 * I_WOUT) < I_FIN) { d.W = ffn_in; d.K = D; d.N = 2 * DFF; d.WT = (unsigned char*)WSP(bf16, WS_FIN); item = r; ilv = 1; }
    else if ((r -= I_FIN) < I_FOUT) { d.W = ffn_out; d.K = DFF; d.N = D; d.WT = (unsigned char*)WSP(bf16, WS_FOUT); item = r; }
    else if ((r -= I_FOUT) < NE * I_FIN) { const int e = r / I_FIN; d.W = moe_in + (size_t)e * D * 2 * DFF; d.K = D; d.N = 2 * DFF; d.WT = WSP(unsigned char, WS_MIN) + (size_t)e * 2 * DFF * D; item = r % I_FIN; ilv = 1; d.f8 = 1; }
    else { r -= NE * I_FIN; const int e = r / I_FOUT; d.W = moe_out + (size_t)e * DFF * D; d.K = DFF; d.N = D; d.WT = WSP(unsigned char, WS_MOUT) + (size_t)e * D * DFF; item = r % I_FOUT; d.f8 = 1; }
    const int nblk = d.N / 32, kb = item / nblk, nb = item % nblk; d.k0 = 64 * kb; d.n0 = 32 * nb;
    d.drow = ilv ? ((d.n0 < DFF) ? (d.n0 / 128) * 256 + (d.n0 % 128) : ((d.n0 - DFF) / 128) * 256 + 128 + ((d.n0 - DFF) % 128)) : d.n0;
    return d;
}
__device__ __forceinline__ void item_load(const ItemDesc& d, int lane, float (&v)[32]) {
    const float* p = d.W + (size_t)(d.k0 + (lane >> 5)) * d.N + d.n0 + (lane & 31);
#pragma unroll
    for (int i = 0; i < 32; ++i) v[i] = __builtin_nontemporal_load(p + (size_t)(2 * i) * d.N);
}
__device__ __forceinline__ void item_finish(const ItemDesc& d, int lane, LAS float* scr, const float (&v)[32]) {
#pragma unroll
    for (int i = 0; i < 32; ++i) scr[(2 * i + (lane >> 5)) * 33 + (lane & 31)] = v[i];
    LDS_WAIT(); asm volatile("" ::: "memory");
    const int c = lane & 7;
    if (d.f8) {
#pragma unroll
        for (int j = 0; j < 4; ++j) { const int n = (lane >> 3) + 8 * j; const LAS float* s = scr + (8 * c) * 33 + n;
            v2u o; o.x = pg8::pk4_fp8(s[0 * 33] * 64.f, s[1 * 33] * 64.f, s[2 * 33] * 64.f, s[3 * 33] * 64.f); o.y = pg8::pk4_fp8(s[4 * 33] * 64.f, s[5 * 33] * 64.f, s[6 * 33] * 64.f, s[7 * 33] * 64.f);
            *(v2u*)(d.WT + (size_t)(d.drow + n) * d.K + d.k0 + 8 * c) = o; }
    } else {
#pragma unroll
        for (int j = 0; j < 4; ++j) { const int n = (lane >> 3) + 8 * j; const LAS float* s = scr + (8 * c) * 33 + n;
            v4u o; o.x = pk2(s[0 * 33], s[1 * 33]); o.y = pk2(s[2 * 33], s[3 * 33]); o.z = pk2(s[4 * 33], s[5 * 33]); o.w = pk2(s[6 * 33], s[7 * 33]);
            *(v4u*)((bf16*)d.WT + (size_t)(d.drow + n) * d.K + d.k0 + 8 * c) = o; }
    }
    LDS_WAIT(); asm volatile("" ::: "memory");
}
__device__ __forceinline__ void p_prologue(const Ctx& C) {
    const float* cvec = C.in[1]; const float* cctx = C.in[3]; const float* ada_w = C.in[4]; const float* ada_b = C.in[5];
    for (int task = C.G - 1 - C.bx; task < 48; task += C.G) {
        const int layer = task / 24, cg = task % 24, col = 256 * cg + 4 * C.lane;
        LAS float* stab = (LAS float*)(C.lds + RING_OFF + 49152);
        __syncthreads();
        for (int i = C.tid; i < 5 * D; i += NTHR) { const int r = i >> 10, k = i & 1023; stab[i] = siluf((r < 4) ? cvec[r * D + k] : cctx[k]); }
        __syncthreads();
        f32x4 acc[5];
#pragma unroll
        for (int r = 0; r < 5; ++r) acc[r] = (f32x4){0.f, 0.f, 0.f, 0.f};
#pragma unroll 16
        for (int kk = 0; kk < 128; ++kk) {
            const int k = 128 * C.wave + kk;
            const f32x4 w = __builtin_nontemporal_load((const f32x4*)(ada_w + ((size_t)layer * D + k) * 6144 + col));
#pragma unroll
            for (int r = 0; r < 5; ++r) acc[r] = acc[r] + w * stab[r * D + k];
        }
        __syncthreads();
        LAS float* red = (LAS float*)(C.lds + RING_OFF);
#pragma unroll
        for (int r = 0; r < 5; ++r) *(LAS f32x4*)(red + (C.wave * 5 + r) * 256 + 4 * C.lane) = acc[r];
        __syncthreads();
        for (int o = C.tid; o < 5 * 256; o += NTHR) {
            const int r = o >> 8, cc = o & 255;
            float s = ada_b[layer * 6144 + 256 * cg + cc];
#pragma unroll
            for (int w = 0; w < 8; ++w) s += red[(w * 5 + r) * 256 + cc];
            WSP(float, WS_MOD)[(layer * 5 + r) * 6144 + 256 * cg + cc] = s;
        }
        __syncthreads();
    }
    LAS float* scr = (LAS float*)(C.lds + RING_OFF + C.wave * 16384);
    constexpr int NITEMS = 2 * (16 * (NPROJ / 32)) + 2 * (16 * 32) + 16 * (2 * DFF / 32) + (DFF / 64) * 32 + NE * (16 * (2 * DFF / 32) + (DFF / 64) * 32);
    {
        float va[32], vb[32];
        const int nmod = (C.G > 96) ? 48 : 0, first_mod = C.G - nmod;
        const int vw = (C.bx < first_mod) ? C.gw : ((C.wave < 6) ? first_mod * NWAVES + (C.bx - first_mod) * 6 + C.wave : NITEMS), nvw = first_mod * NWAVES + nmod * 6;
        int it0 = vw;
        if (it0 < NITEMS) {
            ItemDesc d0 = item_desc(C, it0), d1 = d0; item_load(d0, C.lane, va);
            for (;;) {
                const int it1 = it0 + nvw; const bool h1 = it1 < NITEMS;
                if (h1) { d1 = item_desc(C, it1); item_load(d1, C.lane, vb); }
                item_finish(d0, C.lane, scr, va);
                if (!h1) break;
                it0 = it1 + nvw; const bool h0 = it0 < NITEMS;
                if (h0) { d0 = item_desc(C, it0); item_load(d0, C.lane, va); }
                item_finish(d1, C.lane, scr, vb);
                if (!h0) break;
            }
        }
    }
    for (int idx = C.gtid; idx < 1024; idx += C.NT) {
        const int pos = idx >> 4, i = idx & 15;
        const float inv = powf(10000.0f, -(float)i / 16.0f), ang = (float)pos * inv;
        WSP(float, WS_ROPE)[idx] = cosf(ang); WSP(float, WS_ROPE)[1024 + idx] = sinf(ang);
    }
}
template <int NP>
__device__ __forceinline__ void norm_row(const float* hrow, const float* gvec, const float* sh, const float* sc, bf16* orow, int lane, f32x4 (&a)[4], const float* prow = nullptr, float* hout = nullptr) {
    float ss = 0.f;
#pragma unroll
    for (int j = 0; j < 4; ++j) { a[j] = *(const f32x4*)(hrow + 4 * lane + 256 * j);
        if (NP > 0) {
#pragma unroll
            for (int p = 0; p < NP; ++p) a[j] = a[j] + *(const f32x4*)(prow + (size_t)p * 1024 * 1024 + 4 * lane + 256 * j);
            if (hout) *(f32x4*)(hout + 4 * lane + 256 * j) = a[j]; }
        ss += (a[j].x * a[j].x + a[j].y * a[j].y) + (a[j].z * a[j].z + a[j].w * a[j].w); }
    const float rstd = 1.0f / sqrtf(wave_sum(ss) * (1.0f / D) + EPS);
#pragma unroll
    for (int j = 0; j < 4; ++j) {
        const int c = 4 * lane + 256 * j;
        const f32x4 g = *(const f32x4*)(gvec + c), s1 = *(const f32x4*)(sc + c), s0 = *(const f32x4*)(sh + c);
        a[j] = (a[j] * rstd * g) * (s1 + 1.0f) + s0;
        v2u o; o.x = pk2(a[j].x, a[j].y); o.y = pk2(a[j].z, a[j].w);
        *(v2u*)(orow + c) = o;
    }
}
template <bool ROUTER, int NPC>
__device__ __forceinline__ void p_norm(const Ctx& C, int layer, int which, bool do_ctx, bool from_input, bool ctx_from_input, bool ctx_write_h) {
    const float* gvec = (which ? C.in[7] : C.in[6]) + layer * D;
    const float* mod = WSP(float, WS_MOD) + layer * 30720;
    const int o_sh = which ? 3 * D : 0, o_sc = which ? 4 * D : D;
    f32x4 rwr[4][4][2]; float rbr[8];
    if (ROUTER) { const float* rw = C.in[16]; const float* rb = C.in[17];
#pragma unroll
        for (int jj = 0; jj < 4; ++jj)
#pragma unroll
            for (int i = 0; i < 4; ++i) { const int k = 4 * C.lane + 256 * jj + i; rwr[jj][i][0] = *(const f32x4*)(rw + k * 8); rwr[jj][i][1] = *(const f32x4*)(rw + k * 8 + 4); }
#pragma unroll
        for (int e = 0; e < 8; ++e) rbr[e] = rb[e]; }
    LAS int* lcnt = (LAS int*)(C.lds + RING_OFF);
    for (int blk = C.bx; blk < 256; blk += C.G) {
        if (ROUTER) { if (C.tid < 8) lcnt[C.tid] = 0; __syncthreads(); }
        for (int j = 0; j < 8; ++j) {
            const int m = 64 * blk + 8 * C.wave + j, b = m >> 12;
            f32x4 a[4];
            norm_row<0>((from_input ? C.in[0] : WSP(float, WS_H)) + (size_t)m * D, gvec, mod + b * 6144 + o_sh, mod + b * 6144 + o_sc, WSP(bf16, WS_A) + (size_t)m * D, C.lane, a);
            if (ROUTER) {
                float lg[8];
#pragma unroll
                for (int e = 0; e < 8; ++e) lg[e] = 0.f;
#pragma unroll
                for (int jj = 0; jj < 4; ++jj)
#pragma unroll
                    for (int i = 0; i < 4; ++i) {
                        const float av = a[jj][i]; const f32x4 w0 = rwr[jj][i][0], w1 = rwr[jj][i][1];
                        lg[0] += av * w0.x; lg[1] += av * w0.y; lg[2] += av * w0.z; lg[3] += av * w0.w;
                        lg[4] += av * w1.x; lg[5] += av * w1.y; lg[6] += av * w1.z; lg[7] += av * w1.w;
                    }
                float r4[4], r2[2], r1;
#pragma unroll
                for (int e = 0; e < 4; ++e) { const bool hi = (C.lane & 1) != 0; const float keep = hi ? lg[e + 4] : lg[e], send = hi ? lg[e] : lg[e + 4]; r4[e] = keep + __shfl_xor(send, 1); }
#pragma unroll
                for (int e = 0; e < 2; ++e) { const bool hi = (C.lane & 2) != 0; const float keep = hi ? r4[e + 2] : r4[e], send = hi ? r4[e] : r4[e + 2]; r2[e] = keep + __shfl_xor(send, 2); }
                { const bool hi = (C.lane & 4) != 0; const float keep = hi ? r2[1] : r2[0], send = hi ? r2[0] : r2[1]; r1 = keep + __shfl_xor(send, 4); }
                r1 += __shfl_xor(r1, 8); r1 += __shfl_xor(r1, 16); r1 += __shfl_xor(r1, 32);
#pragma unroll
                for (int e = 0; e < 8; ++e) { const int src = ((e >> 2) & 1) | (((e >> 1) & 1) << 1) | ((e & 1) << 2); lg[e] = __shfl(r1, src) + rbr[e]; }
                int e1 = 0; float v1 = lg[0];
#pragma unroll
                for (int e = 1; e < 8; ++e) if (lg[e] > v1) { v1 = lg[e]; e1 = e; }
                int e2 = -1; float v2 = -3.0e38f;
#pragma unroll
                for (int e = 0; e < 8; ++e) if (e != e1 && lg[e] > v2) { v2 = lg[e]; e2 = e; }
                const float ex = __expf(v2 - v1), w1v = 1.0f / (1.0f + ex), w2v = ex * w1v;
                if (C.lane == 0) {
                    WSP(int, WS_TOKE)[m] = e1 | (e2 << 8);
                    WSP(float, WS_TOKW)[2 * m] = w1v; WSP(float, WS_TOKW)[2 * m + 1] = w2v;
                    atomicAdd((int*)(lcnt + e1), 1); atomicAdd((int*)(lcnt + e2), 1);
                }
            }
        }
        if (ROUTER) { __syncthreads(); if (C.tid < 8) WSP(int, WS_CNT)[blk * 8 + C.tid] = lcnt[C.tid]; __syncthreads(); }
    }
    if (do_ctx) {
        for (int cm = C.gw; cm < RCTX; cm += C.NGW) {
            const int m = RLAT + cm; f32x4 a[4];
            norm_row<NPC>(ctx_from_input ? C.in[2] + (size_t)cm * D : WSP(float, WS_H) + (size_t)m * D, gvec, mod + 4 * 6144 + o_sh, mod + 4 * 6144 + o_sc, WSP(bf16, WS_A) + (size_t)m * D, C.lane, a, WSP(float, WS_PART) + (size_t)cm * D, ctx_write_h ? WSP(float, WS_H) + (size_t)m * D : nullptr);
        }
    }
}
typedef short bf16x8 __attribute__((ext_vector_type(8)));
constexpr float LOG2E = 1.4426950408889634f;
constexpr int VTL_STRIDE = 1040, VTC_STRIDE = 528;
constexpr int NA_VTL = 0, NA_VTC = 64 * VTL_STRIDE, NA_RPB = NA_VTC + 64 * VTC_STRIDE, NA_XCH = 102400;
static_assert(NA_RPB + 465 * 4 <= NA_XCH && NA_XCH + 4 * 64 * 18 * 4 <= RING_BYTES, "NA LDS map");
__device__ __forceinline__ unsigned cvtpk(float lo, float hi) { unsigned r; asm volatile("v_cvt_pk_bf16_f32 %0, %1, %2" : "=v"(r) : "v"(lo), "v"(hi)); return r; }

template <bool LOCAL, int NT, int KT0 = 0, int KT1 = NT>
__device__ __forceinline__ void load_kfrags(bf16x8 (&kf)[NT][2], const bf16* Kbase, int krow0, int lane) {
    const int n = lane & 15, g = lane >> 4;
#pragma unroll
    for (int kt = KT0; kt < KT1; ++kt) {
        const int krow = LOCAL ? krow0 + (kt >> 1) * 64 + (kt & 1) * 16 + n : krow0 + 16 * kt + n;
        const bf16x8* kp = (const bf16x8*)(Kbase + (size_t)krow * NPROJP + 8 * g);
        kf[kt][0] = kp[0]; kf[kt][1] = kp[4];
    }
}
template <bool LOCAL, int NT>
__device__ __forceinline__ void attn_wave_core(const bf16x8 (&kfA)[8][2], const bf16* Kbase, int krow0, const bf16x8 (&qf)[2], LAS const unsigned char* vt, int vstride,
                                               LAS const float* rpb, int r, int r0, int qc, int cbase, float& m_out, float& l_out, f32x4 (&o)[4], int lane) {
    const int n = lane & 15, g = lane >> 4;
    f32x4 s[NT];
#pragma unroll
    for (int kt = 0; kt < 8; ++kt) {
        f32x4 acc = {0.f, 0.f, 0.f, 0.f};
        acc = __builtin_amdgcn_mfma_f32_16x16x32_bf16(kfA[kt][0], qf[0], acc, 0, 0, 0);
        acc = __builtin_amdgcn_mfma_f32_16x16x32_bf16(kfA[kt][1], qf[1], acc, 0, 0, 0);
        s[kt] = acc;
    }
    if constexpr (NT > 8) {
        __builtin_amdgcn_sched_barrier(0);
        bf16x8 kfB[NT][2];
        load_kfrags<LOCAL, NT, 8, NT>(kfB, Kbase, krow0, lane);
#pragma unroll
        for (int kt = 8; kt < NT; ++kt) {
            f32x4 acc = {0.f, 0.f, 0.f, 0.f};
            acc = __builtin_amdgcn_mfma_f32_16x16x32_bf16(kfB[kt][0], qf[0], acc, 0, 0, 0);
            acc = __builtin_amdgcn_mfma_f32_16x16x32_bf16(kfB[kt][1], qf[1], acc, 0, 0, 0);
            s[kt] = acc;
        }
        __builtin_amdgcn_sched_barrier(0);
    }
    const float SC = 0.125f * LOG2E;
    const int c0 = min(max(qc - 8, 0), 48);
    float mx = -1.0e30f;
#pragma unroll
    for (int kt = 0; kt < NT; ++kt)
#pragma unroll
        for (int reg = 0; reg < 4; ++reg) {
            float v = s[kt][reg] * SC;
            if (LOCAL) {
                const int i = kt >> 1, kc = cbase + 16 * (kt & 1) + 4 * g + reg;
                const int dr = r0 + i - r + 7, dc = min(max(kc - qc, -15), 15) + 15;
                const float bias = rpb[dr * 31 + dc];
                v = (kc >= c0 && kc < c0 + 16) ? v + bias : -1.0e30f;
            }
            s[kt][reg] = v; mx = fmaxf(mx, v);
        }
    mx = fmaxf(mx, __shfl_xor(mx, 16)); mx = fmaxf(mx, __shfl_xor(mx, 32));
    float l = 0.f;
#pragma unroll
    for (int kt = 0; kt < NT; ++kt)
#pragma unroll
        for (int reg = 0; reg < 4; ++reg) { const float p = __builtin_amdgcn_exp2f(s[kt][reg] - mx); s[kt][reg] = p; l += p; }
    l += __shfl_xor(l, 16); l += __shfl_xor(l, 32);
#pragma unroll
    for (int dt = 0; dt < 4; ++dt) o[dt] = (f32x4){0.f, 0.f, 0.f, 0.f};
#pragma unroll
    for (int u = 0; u < NT / 2; ++u) {
        v4u pw; pw.x = cvtpk(s[2 * u][0], s[2 * u][1]); pw.y = cvtpk(s[2 * u][2], s[2 * u][3]); pw.z = cvtpk(s[2 * u + 1][0], s[2 * u + 1][1]); pw.w = cvtpk(s[2 * u + 1][2], s[2 * u + 1][3]);
        const bf16x8 pb = __builtin_bit_cast(bf16x8, pw);
        const int slotA = LOCAL ? ((r0 + u) & 7) * 64 + cbase + 4 * g : 32 * u + 4 * g, slotB = slotA + 16;
#pragma unroll
        for (int dt = 0; dt < 4; ++dt) {
            LAS const unsigned char* rowp = vt + (16 * dt + n) * vstride;
            const v2u a_lo = *(LAS const v2u*)(rowp + slotA * 2), a_hi = *(LAS const v2u*)(rowp + slotB * 2);
            v4u aw; aw.x = a_lo.x; aw.y = a_lo.y; aw.z = a_hi.x; aw.w = a_hi.y;
            o[dt] = __builtin_amdgcn_mfma_f32_16x16x32_bf16(__builtin_bit_cast(bf16x8, aw), pb, o[dt], 0, 0, 0);
        }
    }
    m_out = mx; l_out = l;
}
__device__ __forceinline__ void attn_wave_mixed(const bf16x8 (&kfA)[8][2], const bf16* Kbase, int kcrow0, const bf16x8 (&qf)[2], LAS const unsigned char* vtl, LAS const unsigned char* vtc,
                                                LAS const float* rpb, int part, int r, int r0, int qc, int cbase, float& m_out, float& l_out, f32x4 (&o)[4], int lane) {
    const int n = lane & 15, g = lane >> 4;
    f32x4 s[16];
#pragma unroll
    for (int kt = 0; kt < 8; ++kt) {
        f32x4 acc = {0.f, 0.f, 0.f, 0.f};
        acc = __builtin_amdgcn_mfma_f32_16x16x32_bf16(kfA[kt][0], qf[0], acc, 0, 0, 0);
        acc = __builtin_amdgcn_mfma_f32_16x16x32_bf16(kfA[kt][1], qf[1], acc, 0, 0, 0);
        s[kt] = acc;
    }
    __builtin_amdgcn_sched_barrier(0);
    {
        bf16x8 kfB[8][2];
        load_kfrags<false, 8>(kfB, Kbase, kcrow0, lane);
#pragma unroll
        for (int kt = 0; kt < 8; ++kt) {
            f32x4 acc = {0.f, 0.f, 0.f, 0.f};
            acc = __builtin_amdgcn_mfma_f32_16x16x32_bf16(kfB[kt][0], qf[0], acc, 0, 0, 0);
            acc = __builtin_amdgcn_mfma_f32_16x16x32_bf16(kfB[kt][1], qf[1], acc, 0, 0, 0);
            s[8 + kt] = acc;
        }
    }
    __builtin_amdgcn_sched_barrier(0);
    const float SC = 0.125f * LOG2E;
    const int c0 = min(max(qc - 8, 0), 48);
    float mx = -1.0e30f;
#pragma unroll
    for (int kt = 0; kt < 16; ++kt)
#pragma unroll
        for (int reg = 0; reg < 4; ++reg) {
            float v = s[kt][reg] * SC;
            if (kt < 8) {
                const int i = 4 * part + (kt >> 1), kc = cbase + 16 * (kt & 1) + 4 * g + reg;
                const int dr = r0 + i - r + 7, dc = min(max(kc - qc, -15), 15) + 15;
                const float bias = rpb[dr * 31 + dc];
                v = (kc >= c0 && kc < c0 + 16) ? v + bias : -1.0e30f;
            }
            s[kt][reg] = v; mx = fmaxf(mx, v);
        }
    mx = fmaxf(mx, __shfl_xor(mx, 16)); mx = fmaxf(mx, __shfl_xor(mx, 32));
    float l = 0.f;
#pragma unroll
    for (int kt = 0; kt < 16; ++kt)
#pragma unroll
        for (int reg = 0; reg < 4; ++reg) { const float p = __builtin_amdgcn_exp2f(s[kt][reg] - mx); s[kt][reg] = p; l += p; }
    l += __shfl_xor(l, 16); l += __shfl_xor(l, 32);
#pragma unroll
    for (int dt = 0; dt < 4; ++dt) o[dt] = (f32x4){0.f, 0.f, 0.f, 0.f};
#pragma unroll
    for (int u = 0; u < 8; ++u) {
        v4u pw; pw.x = cvtpk(s[2 * u][0], s[2 * u][1]); pw.y = cvtpk(s[2 * u][2], s[2 * u][3]); pw.z = cvtpk(s[2 * u + 1][0], s[2 * u + 1][1]); pw.w = cvtpk(s[2 * u + 1][2], s[2 * u + 1][3]);
        const bf16x8 pb = __builtin_bit_cast(bf16x8, pw);
        const bool loc = (u < 4);
        const int slotA = loc ? ((r0 + 4 * part + u) & 7) * 64 + cbase + 4 * g : 128 * part + 32 * (u - 4) + 4 * g, slotB = slotA + 16;
        LAS const unsigned char* vt = loc ? vtl : vtc; const int vstride = loc ? VTL_STRIDE : VTC_STRIDE;
#pragma unroll
        for (int dt = 0; dt < 4; ++dt) {
            LAS const unsigned char* rowp = vt + (16 * dt + n) * vstride;
            const v2u a_lo = *(LAS const v2u*)(rowp + slotA * 2), a_hi = *(LAS const v2u*)(rowp + slotB * 2);
            v4u aw; aw.x = a_lo.x; aw.y = a_lo.y; aw.z = a_hi.x; aw.w = a_hi.y;
            o[dt] = __builtin_amdgcn_mfma_f32_16x16x32_bf16(__builtin_bit_cast(bf16x8, aw), pb, o[dt], 0, 0, 0);
        }
    }
    m_out = mx; l_out = l;
}
template <int NCH>
__device__ __forceinline__ void vt_scatter(const bf16* vrow, int ch0, LAS unsigned char* vt, int vstride, int slot) {
    v4u x[NCH];
#pragma unroll
    for (int c = 0; c < NCH; ++c) x[c] = *(const v4u*)(vrow + 8 * (ch0 + c));
#pragma unroll
    for (int c = 0; c < NCH; ++c) {
        LAS unsigned char* p = vt + (8 * (ch0 + c)) * vstride + slot * 2;
        *(LAS unsigned short*)(p) = (unsigned short)(x[c].x & 0xffffu); *(LAS unsigned short*)(p + vstride) = (unsigned short)(x[c].x >> 16);
        *(LAS unsigned short*)(p + 2 * vstride) = (unsigned short)(x[c].y & 0xffffu); *(LAS unsigned short*)(p + 3 * vstride) = (unsigned short)(x[c].y >> 16);
        *(LAS unsigned short*)(p + 4 * vstride) = (unsigned short)(x[c].z & 0xffffu); *(LAS unsigned short*)(p + 5 * vstride) = (unsigned short)(x[c].z >> 16);
        *(LAS unsigned short*)(p + 6 * vstride) = (unsigned short)(x[c].w & 0xffffu); *(LAS unsigned short*)(p + 7 * vstride) = (unsigned short)(x[c].w >> 16);
    }
}
__device__ __forceinline__ void attn_merge_store(const Ctx& C, int part, int qb, float m, float l, f32x4 (&o)[4], int qrow0, int h) {
    LAS float* xch = (LAS float*)(C.lds + RING_OFF + NA_XCH) + (qb * 64 + C.lane) * 18;
    if (part == 1) {
        xch[0] = m; xch[1] = l;
#pragma unroll
        for (int dt = 0; dt < 4; ++dt) *(LAS f32x4*)(xch + 2 + 4 * dt) = o[dt];
    }
    __syncthreads();
    if (part == 0) {
        const float m2 = xch[0], l2 = xch[1];
        const float mt = fmaxf(m, m2), f1 = __builtin_amdgcn_exp2f(m - mt), f2 = __builtin_amdgcn_exp2f(m2 - mt);
        const float inv = 1.0f / (l * f1 + l2 * f2);
        const int n = C.lane & 15, g = C.lane >> 4;
        bf16* yp = WSP(bf16, WS_YMIX) + (size_t)(qrow0 + n) * D + 640 + 64 * h + 4 * g;
#pragma unroll
        for (int dt = 0; dt < 4; ++dt) {
            const f32x4 o2 = *(LAS f32x4*)(xch + 2 + 4 * dt);
            const f32x4 v = (o[dt] * f1 + o2 * f2) * inv;
            v2u w; w.x = cvtpk(v[0], v[1]); w.y = cvtpk(v[2], v[3]);
            *(v2u*)(yp + 16 * dt) = w;
        }
    }
}
__device__ __forceinline__ void na_band(const Ctx& C, int layer, int u0, int nu) {
    const bf16* PROJ = WSP(bf16, WS_PROJ);
    LAS unsigned char* vtl = C.lds + RING_OFF + NA_VTL; LAS unsigned char* vtc = C.lds + RING_OFF + NA_VTC; LAS float* rpb = (LAS float*)(C.lds + RING_OFF + NA_RPB);
    const int qb = C.wave & 3, part = C.wave >> 2, n = C.lane & 15, g = C.lane >> 4;
    const int cbase = (qb == 0) ? 0 : (qb == 1) ? 8 : (qb == 2) ? 24 : 32;
    int cur_bh = -1, have_hi = 0;
    for (int uu = 0; uu < nu; ++uu) {
        const int u = u0 + uu, bh = u >> 6, r = u & 63, b = bh / 6, h = bh % 6;
        const int r0 = min(max(r - 4, 0), 56);
        const int qrow0 = b * SEQ + r * 64 + 16 * qb;
        bf16x8 qf[2];
        { const bf16x8* qp = (const bf16x8*)(PROJ + (size_t)(qrow0 + n) * NPROJP + C_NQ + 64 * h + 8 * g); qf[0] = qp[0]; qf[1] = qp[4]; }
        bf16x8 kf[8][2];
        load_kfrags<true, 8, 0, 8>(kf, PROJ + C_NK + 64 * h, b * SEQ + (r0 + 4 * part) * 64 + cbase, C.lane);
        const bool newbh = (bh != cur_bh);
        const int lo = newbh ? r0 : max(r0, have_hi);
        const int vkey = C.tid & 63, vch = C.tid >> 6;
        v4u vpre = {0u, 0u, 0u, 0u};
        if (lo < r0 + 8) vpre = *(const v4u*)(PROJ + (size_t)(b * SEQ + (r0 + 7) * 64 + vkey) * NPROJP + C_NV + 64 * h + 8 * vch);
        __syncthreads();
        if (newbh) {
            vt_scatter<4>(PROJ + (size_t)(RLAT + b * CTXL + (C.tid & 255)) * NPROJP + C_NV + 64 * h, 4 * (C.tid >> 8), vtc, VTC_STRIDE, C.tid & 255);
            const float* rp = C.in[13] + (size_t)(layer * 6 + h) * 465; for (int i = C.tid; i < 465; i += NTHR) rpb[i] = rp[i] * LOG2E;
        }
        for (int row = lo; row < r0 + 8; ++row) {
            v4u x = vpre;
            if (row != r0 + 7) x = *(const v4u*)(PROJ + (size_t)(b * SEQ + row * 64 + vkey) * NPROJP + C_NV + 64 * h + 8 * vch);
            LAS unsigned char* p = vtl + (8 * vch) * VTL_STRIDE + ((row & 7) * 64 + vkey) * 2;
            *(LAS unsigned short*)(p) = (unsigned short)(x.x & 0xffffu); *(LAS unsigned short*)(p + VTL_STRIDE) = (unsigned short)(x.x >> 16);
            *(LAS unsigned short*)(p + 2 * VTL_STRIDE) = (unsigned short)(x.y & 0xffffu); *(LAS unsigned short*)(p + 3 * VTL_STRIDE) = (unsigned short)(x.y >> 16);
            *(LAS unsigned short*)(p + 4 * VTL_STRIDE) = (unsigned short)(x.z & 0xffffu); *(LAS unsigned short*)(p + 5 * VTL_STRIDE) = (unsigned short)(x.z >> 16);
            *(LAS unsigned short*)(p + 6 * VTL_STRIDE) = (unsigned short)(x.w & 0xffffu); *(LAS unsigned short*)(p + 7 * VTL_STRIDE) = (unsigned short)(x.w >> 16);
        }
        cur_bh = bh; have_hi = r0 + 8;
        __syncthreads();
        float m, l; f32x4 o[4];
        attn_wave_mixed(kf, PROJ + C_NK + 64 * h, RLAT + b * CTXL + 128 * part, qf, vtl, vtc, rpb, part, r, r0, 16 * qb + n, cbase, m, l, o, C.lane);
        attn_merge_store(C, part, qb, m, l, o, qrow0, h);
    }
}
constexpr int VT2_ROWS = 10, VT2_STRIDE = VT2_ROWS * 64 * 2 + 16;
constexpr int NA2_VTL = 0, NA2_VTC = 64 * VT2_STRIDE, NA2_RPB = NA2_VTC + 64 * VTC_STRIDE, NA2_KC = 120832, KC_STRIDE = 144;
static_assert(NA2_RPB + (480 + 465) * 4 <= NA2_KC && NA2_KC + 256 * KC_STRIDE <= RING_BYTES && (VT2_STRIDE / 4) % 64 == 4, "NA2 LDS map");
template <bool LOCAL>
__device__ __forceinline__ void na2_scores(f32x4 (&s)[16], const bf16x8 (&kfA)[8][2], const bf16* Kbase, int krow0, const bf16x8 (&qf)[2], int lane) {
#pragma unroll
    for (int kt = 0; kt < 8; ++kt) { f32x4 acc = {0.f, 0.f, 0.f, 0.f};
        acc = __builtin_amdgcn_mfma_f32_16x16x32_bf16(kfA[kt][0], qf[0], acc, 0, 0, 0); acc = __builtin_amdgcn_mfma_f32_16x16x32_bf16(kfA[kt][1], qf[1], acc, 0, 0, 0); s[kt] = acc; }
    __builtin_amdgcn_sched_barrier(0);
    bf16x8 kfB[16][2];
    load_kfrags<LOCAL, 16, 8, 16>(kfB, Kbase, krow0, lane);
#pragma unroll
    for (int kt = 8; kt < 16; ++kt) { f32x4 acc = {0.f, 0.f, 0.f, 0.f};
        acc = __builtin_amdgcn_mfma_f32_16x16x32_bf16(kfB[kt][0], qf[0], acc, 0, 0, 0); acc = __builtin_amdgcn_mfma_f32_16x16x32_bf16(kfB[kt][1], qf[1], acc, 0, 0, 0); s[kt] = acc; }
    __builtin_amdgcn_sched_barrier(0);
}
__device__ __forceinline__ void na_band2(const Ctx& C, int layer, int u0, int nu) {
    const bf16* PROJ = WSP(bf16, WS_PROJ);
    LAS unsigned char* vtl = C.lds + RING_OFF + NA2_VTL; LAS unsigned char* vtc = C.lds + RING_OFF + NA2_VTC; LAS float* rpb = (LAS float*)(C.lds + RING_OFF + NA2_RPB); LAS unsigned char* kcim = C.lds + RING_OFF + NA2_KC;
    const int qb = C.wave & 3, grp = C.wave >> 2, n = C.lane & 15, g = C.lane >> 4;
    const int cbase = (qb == 0) ? 0 : (qb == 1) ? 8 : (qb == 2) ? 24 : 32;
    const float SC = 0.125f * LOG2E;
    int boff[2][4]; float bscl[2][4];
    { const int qc = 16 * qb + n, c0 = min(max(qc - 8, 0), 48);
#pragma unroll
      for (int hh = 0; hh < 2; ++hh)
#pragma unroll
        for (int reg = 0; reg < 4; ++reg) { const int kcol = cbase + 16 * hh + 4 * g + reg; const bool ok = (kcol >= c0) && (kcol < c0 + 16);
            boff[hh][reg] = ok ? (min(max(kcol - qc, -15), 15) + 15) * 4 : 480 * 4; bscl[hh][reg] = ok ? SC : 0.f; } }
    int cur_bh = -1, have_hi = 0;
    for (int uu = 0; uu < nu; uu += 2) {
        const int ua = u0 + uu, bh = ua >> 6, ra = ua & 63, b = bh / 6, h = bh % 6;
        const int r0a = min(max(ra - 4, 0), 56), r0b = min(max(ra + 1 - 4, 0), 56);
        const int r = ra + grp, r0 = grp ? r0b : r0a;
        const int qrow0 = b * SEQ + r * 64 + 16 * qb;
        const bool newbh = (bh != cur_bh);
        const int lo = newbh ? r0a : max(r0a, have_hi), hi = r0b + 8;
        const int vkey = C.tid & 63, vch = C.tid >> 6;
        const v4u vpa = *(const v4u*)(PROJ + (size_t)(b * SEQ + (hi - 2) * 64 + vkey) * NPROJP + C_NV + 64 * h + 8 * vch);
        const v4u vpb = *(const v4u*)(PROJ + (size_t)(b * SEQ + (hi - 1) * 64 + vkey) * NPROJP + C_NV + 64 * h + 8 * vch);
        bf16x8 qf[2];
        { const bf16x8* qp = (const bf16x8*)(PROJ + (size_t)(qrow0 + n) * NPROJP + C_NQ + 64 * h + 8 * g); qf[0] = qp[0]; qf[1] = qp[4]; }
        bf16x8 kf[8][2];
        load_kfrags<true, 8, 0, 8>(kf, PROJ + C_NK + 64 * h, b * SEQ + r0 * 64 + cbase, C.lane);
        __syncthreads();
        if (newbh) {
            vt_scatter<4>(PROJ + (size_t)(RLAT + b * CTXL + (C.tid & 255)) * NPROJP + C_NV + 64 * h, 4 * (C.tid >> 8), vtc, VTC_STRIDE, C.tid & 255);
            const float* rp = C.in[13] + (size_t)(layer * 6 + h) * 465; for (int i = C.tid; i < 465; i += NTHR) rpb[i] = rp[i] * LOG2E;
            { const int key = C.tid & 255, c4 = 4 * (C.tid >> 8); const bf16* kp = PROJ + (size_t)(RLAT + b * CTXL + key) * NPROJP + C_NK + 64 * h + 8 * c4;
              v4u kx[4];
#pragma unroll
              for (int q = 0; q < 4; ++q) kx[q] = *(const v4u*)(kp + 8 * q);
#pragma unroll
              for (int q = 0; q < 4; ++q) *(LAS v4u*)(kcim + key * KC_STRIDE + 16 * (c4 + q)) = kx[q]; }
            for (int i = C.tid; i < 15 * 31; i += NTHR) rpb[480 + i] = -1.0e30f;
        }
        for (int row = lo; row < hi; ++row) {
            v4u x;
            if (row == hi - 2) x = vpa; else if (row == hi - 1) x = vpb; else x = *(const v4u*)(PROJ + (size_t)(b * SEQ + row * 64 + vkey) * NPROJP + C_NV + 64 * h + 8 * vch);
            LAS unsigned char* p = vtl + (8 * vch) * VT2_STRIDE + ((row % VT2_ROWS) * 64 + vkey) * 2;
            *(LAS unsigned short*)(p) = (unsigned short)(x.x & 0xffffu); *(LAS unsigned short*)(p + VT2_STRIDE) = (unsigned short)(x.x >> 16);
            *(LAS unsigned short*)(p + 2 * VT2_STRIDE) = (unsigned short)(x.y & 0xffffu); *(LAS unsigned short*)(p + 3 * VT2_STRIDE) = (unsigned short)(x.y >> 16);
            *(LAS unsigned short*)(p + 4 * VT2_STRIDE) = (unsigned short)(x.z & 0xffffu); *(LAS unsigned short*)(p + 5 * VT2_STRIDE) = (unsigned short)(x.z >> 16);
            *(LAS unsigned short*)(p + 6 * VT2_STRIDE) = (unsigned short)(x.w & 0xffffu); *(LAS unsigned short*)(p + 7 * VT2_STRIDE) = (unsigned short)(x.w >> 16);
        }
        cur_bh = bh; have_hi = hi;
        __syncthreads();
        f32x4 s[16];
        na2_scores<true>(s, kf, PROJ + C_NK + 64 * h, b * SEQ + r0 * 64 + cbase, qf, C.lane);
        float mx = -1.0e30f;
        { LAS const unsigned char* rb = (LAS const unsigned char*)rpb + (r0 - r + 7) * 124;
#pragma unroll
          for (int kt = 0; kt < 16; ++kt)
#pragma unroll
            for (int reg = 0; reg < 4; ++reg) {
                const float bias = *(LAS const float*)(rb + boff[kt & 1][reg] + (kt >> 1) * 124);
                const float v = s[kt][reg] * bscl[kt & 1][reg] + bias;
                s[kt][reg] = v; mx = fmaxf(mx, v);
            } }
        mx = fmaxf(mx, __shfl_xor(mx, 16)); mx = fmaxf(mx, __shfl_xor(mx, 32));
        float l = 0.f;
#pragma unroll
        for (int kt = 0; kt < 16; ++kt)
#pragma unroll
            for (int reg = 0; reg < 4; ++reg) { const float p = __builtin_amdgcn_exp2f(s[kt][reg] - mx); s[kt][reg] = p; l += p; }
        f32x4 o[4];
#pragma unroll
        for (int dt = 0; dt < 4; ++dt) o[dt] = (f32x4){0.f, 0.f, 0.f, 0.f};
#pragma unroll
        for (int u = 0; u < 8; ++u) {
            v4u pw; pw.x = cvtpk(s[2 * u][0], s[2 * u][1]); pw.y = cvtpk(s[2 * u][2], s[2 * u][3]); pw.z = cvtpk(s[2 * u + 1][0], s[2 * u + 1][1]); pw.w = cvtpk(s[2 * u + 1][2], s[2 * u + 1][3]);
            const bf16x8 pb = __builtin_bit_cast(bf16x8, pw);
            const int slotA = ((r0 + u) % VT2_ROWS) * 64 + cbase + 4 * g, slotB = slotA + 16;
#pragma unroll
            for (int dt = 0; dt < 4; ++dt) {
                LAS const unsigned char* rowp = vtl + (16 * dt + n) * VT2_STRIDE;
                const v2u a_lo = *(LAS const v2u*)(rowp + slotA * 2), a_hi = *(LAS const v2u*)(rowp + slotB * 2);
                v4u aw; aw.x = a_lo.x; aw.y = a_lo.y; aw.z = a_hi.x; aw.w = a_hi.y;
                o[dt] = __builtin_amdgcn_mfma_f32_16x16x32_bf16(__builtin_bit_cast(bf16x8, aw), pb, o[dt], 0, 0, 0);
            }
        }
#pragma unroll
        for (int kt = 0; kt < 16; ++kt) {
            LAS const unsigned char* kp = kcim + (16 * kt + n) * KC_STRIDE + 16 * g;
            const bf16x8 ka = *(LAS const bf16x8*)(kp), kb = *(LAS const bf16x8*)(kp + 64);
            f32x4 acc = {0.f, 0.f, 0.f, 0.f};
            acc = __builtin_amdgcn_mfma_f32_16x16x32_bf16(ka, qf[0], acc, 0, 0, 0); acc = __builtin_amdgcn_mfma_f32_16x16x32_bf16(kb, qf[1], acc, 0, 0, 0); s[kt] = acc;
        }
        float mx2 = -1.0e30f;
#pragma unroll
        for (int kt = 0; kt < 16; ++kt)
#pragma unroll
            for (int reg = 0; reg < 4; ++reg) { const float v = s[kt][reg] * SC; s[kt][reg] = v; mx2 = fmaxf(mx2, v); }
        mx2 = fmaxf(mx2, __shfl_xor(mx2, 16)); mx2 = fmaxf(mx2, __shfl_xor(mx2, 32));
        const float mt = fmaxf(mx, mx2), f1 = __builtin_amdgcn_exp2f(mx - mt);
        l *= f1;
#pragma unroll
        for (int dt = 0; dt < 4; ++dt) o[dt] = o[dt] * f1;
#pragma unroll
        for (int kt = 0; kt < 16; ++kt)
#pragma unroll
            for (int reg = 0; reg < 4; ++reg) { const float p = __builtin_amdgcn_exp2f(s[kt][reg] - mt); s[kt][reg] = p; l += p; }
        l += __shfl_xor(l, 16); l += __shfl_xor(l, 32);
#pragma unroll
        for (int u = 0; u < 8; ++u) {
            v4u pw; pw.x = cvtpk(s[2 * u][0], s[2 * u][1]); pw.y = cvtpk(s[2 * u][2], s[2 * u][3]); pw.z = cvtpk(s[2 * u + 1][0], s[2 * u + 1][1]); pw.w = cvtpk(s[2 * u + 1][2], s[2 * u + 1][3]);
            const bf16x8 pb = __builtin_bit_cast(bf16x8, pw);
            const int slotA = 32 * u + 4 * g, slotB = slotA + 16;
#pragma unroll
            for (int dt = 0; dt < 4; ++dt) {
                LAS const unsigned char* rowp = vtc + (16 * dt + n) * VTC_STRIDE;
                const v2u a_lo = *(LAS const v2u*)(rowp + slotA * 2), a_hi = *(LAS const v2u*)(rowp + slotB * 2);
                v4u aw; aw.x = a_lo.x; aw.y = a_lo.y; aw.z = a_hi.x; aw.w = a_hi.y;
                o[dt] = __builtin_amdgcn_mfma_f32_16x16x32_bf16(__builtin_bit_cast(bf16x8, aw), pb, o[dt], 0, 0, 0);
            }
        }
        const float inv = 1.0f / l;
        bf16* yp = WSP(bf16, WS_YMIX) + (size_t)(qrow0 + n) * D + 640 + 64 * h + 4 * g;
#pragma unroll
        for (int dt = 0; dt < 4; ++dt) { const f32x4 v = o[dt] * inv; v2u w; w.x = cvtpk(v[0], v[1]); w.y = cvtpk(v[2], v[3]); *(v2u*)(yp + 16 * dt) = w; }
    }
    __syncthreads();
}
__device__ __forceinline__ void ctxattn_unit(const Ctx& C, int b, int h, int qblk) {
    const bf16* PROJ = WSP(bf16, WS_PROJ);
    LAS unsigned char* vtc = C.lds + RING_OFF + NA_VTC; LAS float* rpb = (LAS float*)(C.lds + RING_OFF + NA_RPB);
    __syncthreads();
    vt_scatter<4>(PROJ + (size_t)(RLAT + b * CTXL + (C.tid & 255)) * NPROJP + C_NV + 64 * h, 4 * (C.tid >> 8), vtc, VTC_STRIDE, C.tid & 255);
    __syncthreads();
    const int qb = C.wave & 3, part = C.wave >> 2, n = C.lane & 15, g = C.lane >> 4;
    const int qrow0 = RLAT + b * CTXL + 64 * qblk + 16 * qb;
    bf16x8 qf[2];
    { const bf16x8* qp = (const bf16x8*)(PROJ + (size_t)(qrow0 + n) * NPROJP + C_NQ + 64 * h + 8 * g); qf[0] = qp[0]; qf[1] = qp[4]; }
    float m, l; f32x4 o[4];
    bf16x8 kf[8][2];
    load_kfrags<false, 8>(kf, PROJ + C_NK + 64 * h, RLAT + b * CTXL + 128 * part, C.lane);
    attn_wave_core<false, 8>(kf, PROJ + C_NK + 64 * h, RLAT + b * CTXL + 128 * part, qf, vtc + 256 * part, VTC_STRIDE, rpb, 0, 0, 0, 0, m, l, o, C.lane);
    attn_merge_store(C, part, qb, m, l, o, qrow0, h);
}

constexpr size_t WS_UT = WS_OBUF;
constexpr size_t WS_SB = WS_OBUF + 26 * MiB;
constexpr int RT_STRIDE = 272;
__device__ __forceinline__ float logsig(float x) { return -log1pf(expf(-x)); }
__device__ __forceinline__ int ret_row0(int b, int c) { return (c < 2) ? RLAT + b * CTXL + 128 * c : b * SEQ + 128 * (c - 2); }

struct RaLoads { v4u k0, k1, v0, v1; };
__device__ __forceinline__ void ra_load(const Ctx& C, int b, int h, int c, RaLoads& L) {
    const int j = C.tid & 127, q4 = C.tid >> 7;
    const bf16* pr = WSP(bf16, WS_PROJ) + (size_t)(ret_row0(b, c) + j) * NPROJP + 64 * h + 16 * q4;
    L.k0 = *(const v4u*)(pr + C_RK); L.k1 = *(const v4u*)(pr + C_RK + 8); L.v0 = *(const v4u*)(pr + C_RV); L.v1 = *(const v4u*)(pr + C_RV + 8);
}
__device__ __forceinline__ void ret_a_unit(const Ctx& C, int layer, int b, int h, int c, const RaLoads& L) {
    LAS unsigned char* kt = C.lds + RING_OFF; LAS unsigned char* vft = kt + 64 * RT_STRIDE; LAS unsigned char* vbt = vft + 64 * RT_STRIDE;
    const float lgf = logsig(C.in[10][(layer * 2 + 0) * 6 + h]), lgb = logsig(C.in[10][(layer * 2 + 1) * 6 + h]);
    __syncthreads();
    {
        const int j = C.tid & 127, q4 = C.tid >> 7;
        const v4u k0 = L.k0, k1 = L.k1, v0 = L.v0, v1 = L.v1;
        const float wf = expf(lgf * (float)(127 - j)), wb = expf(lgb * (float)j);
        const unsigned kw[8] = {k0.x, k0.y, k0.z, k0.w, k1.x, k1.y, k1.z, k1.w}, vw[8] = {v0.x, v0.y, v0.z, v0.w, v1.x, v1.y, v1.z, v1.w};
#pragma unroll
        for (int i = 0; i < 8; ++i) {
            const int d = 16 * q4 + 2 * i;
            *(LAS unsigned short*)(kt + d * RT_STRIDE + 2 * j) = (unsigned short)(kw[i] & 0xffffu); *(LAS unsigned short*)(kt + (d + 1) * RT_STRIDE + 2 * j) = (unsigned short)(kw[i] >> 16);
            const float a = bflo(vw[i]), bb = bfhi(vw[i]);
            *(LAS unsigned short*)(vft + d * RT_STRIDE + 2 * j) = (unsigned short)f2bf(a * wf); *(LAS unsigned short*)(vft + (d + 1) * RT_STRIDE + 2 * j) = (unsigned short)f2bf(bb * wf);
            *(LAS unsigned short*)(vbt + d * RT_STRIDE + 2 * j) = (unsigned short)f2bf(a * wb); *(LAS unsigned short*)(vbt + (d + 1) * RT_STRIDE + 2 * j) = (unsigned short)f2bf(bb * wb);
        }
    }
    __syncthreads();
    const int dir = C.wave >> 2, dt = C.wave & 3, n = C.lane & 15, g = C.lane >> 4;
    LAS const unsigned char* vt = dir ? vbt : vft;
    f32x4 acc[4];
#pragma unroll
    for (int et = 0; et < 4; ++et) acc[et] = (f32x4){0.f, 0.f, 0.f, 0.f};
#pragma unroll
    for (int s = 0; s < 4; ++s) {
        const bf16x8 a = *(LAS const bf16x8*)(kt + (16 * dt + n) * RT_STRIDE + (32 * s + 8 * g) * 2);
#pragma unroll
        for (int et = 0; et < 4; ++et) {
            const bf16x8 bf = *(LAS const bf16x8*)(vt + (16 * et + n) * RT_STRIDE + (32 * s + 8 * g) * 2);
            acc[et] = __builtin_amdgcn_mfma_f32_16x16x32_bf16(a, bf, acc[et], 0, 0, 0);
        }
    }
    float* U = WSP(float, WS_UT) + ((size_t)((dir * 24 + b * 6 + h) * 34 + c)) * 4096;
#pragma unroll
    for (int et = 0; et < 4; ++et) *(f32x4*)(U + (16 * et + n) * 64 + 16 * dt + 4 * g) = acc[et];
}
typedef float f32x2v __attribute__((ext_vector_type(2)));
__device__ __forceinline__ void ret_scan(const Ctx& C, int layer) {
    for (int task = C.gtid; task < 48 * 2048; task += C.NT) {
        const int dir = task / (24 * 2048), rem = task % (24 * 2048), bh = rem >> 11, p = rem & 2047, h = bh % 6;
        const float dec = expf(128.0f * logsig(C.in[10][(layer * 2 + dir) * 6 + h]));
        const float* __restrict__ U = WSP(float, WS_UT) + ((size_t)(dir * 24 + bh) * 34) * 4096 + 2 * p;
        bf16* __restrict__ SB = WSP(bf16, WS_SB) + ((size_t)(dir * 24 + bh) * 34) * 4096 + 2 * p;
        f32x2v u[34];
#pragma unroll
        for (int k = 0; k < 34; ++k) { const int c = dir ? ((k < 2) ? 1 - k : 35 - k) : k; u[k] = *(const f32x2v*)(U + (size_t)c * 4096); }
        float s0 = 0.f, s1 = 0.f;
#pragma unroll
        for (int k = 0; k < 34; ++k) {
            const int c = dir ? ((k < 2) ? 1 - k : 35 - k) : k;
            *(unsigned*)(SB + (size_t)c * 4096) = pk2(s0, s1);
            s0 = dec * s0 + u[k].x; s1 = dec * s1 + u[k].y;
        }
    }
}
constexpr int RC_KS = 144;
constexpr int RC_VT = 0, RC_K = 64 * RT_STRIDE, RC_SB = RC_K + 128 * RC_KS, RC_TAB = RC_SB + 2 * 64 * RC_KS;
static_assert(RC_TAB + 1024 <= RING_BYTES, "retC LDS map");
struct RcLoads { bf16x8 qf[2]; v2u gw[4]; v4u v0, v1, k0, k1, s0, s1; };
__device__ __forceinline__ void rc_load(const Ctx& C, int b, int h, int c, RcLoads& L) {
    const bf16* PROJ = WSP(bf16, WS_PROJ);
    const int row0 = ret_row0(b, c);
    const int n = C.lane & 15, g = C.lane >> 4, i = 16 * C.wave + n, rowi = row0 + i;
    { const bf16x8* qp = (const bf16x8*)(PROJ + (size_t)rowi * NPROJP + C_RQ + 64 * h + 8 * g); L.qf[0] = qp[0]; L.qf[1] = qp[4]; }
    { const bf16* gp = PROJ + (size_t)rowi * NPROJP + C_RG + 64 * h + 4 * g;
#pragma unroll
      for (int et = 0; et < 4; ++et) L.gw[et] = *(const v2u*)(gp + 16 * et); }
    const int vj = C.tid & 127, vq4 = C.tid >> 7;
    const bf16* vpr = PROJ + (size_t)(row0 + vj) * NPROJP + 64 * h + 16 * vq4;
    L.v0 = *(const v4u*)(vpr + C_RV); L.v1 = *(const v4u*)(vpr + C_RV + 8);
    L.k0 = *(const v4u*)(vpr + C_RK); L.k1 = *(const v4u*)(vpr + C_RK + 8);
    const int se = C.tid & 63, sq = (C.tid >> 6) & 3, sd = C.tid >> 8;
    const bf16* spr = WSP(bf16, WS_SB) + ((size_t)((sd * 24 + b * 6 + h) * 34 + c)) * 4096 + se * 64 + 16 * sq;
    L.s0 = *(const v4u*)(spr); L.s1 = *(const v4u*)(spr + 8);
}
__device__ __forceinline__ void ret_c_unit(const Ctx& C, int layer, int b, int h, int c, const RcLoads& L) {
    LAS unsigned char* vt = C.lds + RING_OFF + RC_VT; LAS unsigned char* kim = C.lds + RING_OFF + RC_K; LAS unsigned char* sim = C.lds + RING_OFF + RC_SB;
    LAS float* tabf = (LAS float*)(C.lds + RING_OFF + RC_TAB);
    const float lgf = logsig(C.in[10][(layer * 2 + 0) * 6 + h]), lgb = logsig(C.in[10][(layer * 2 + 1) * 6 + h]);
    const int row0 = ret_row0(b, c);
    const int n = C.lane & 15, g = C.lane >> 4, i = 16 * C.wave + n, rowi = row0 + i;
    const int vj = C.tid & 127, vq4 = C.tid >> 7;
    const int se = C.tid & 63, sq = (C.tid >> 6) & 3, sd = C.tid >> 8;
    const bf16x8 qf[2] = {L.qf[0], L.qf[1]};
    const v2u gw[4] = {L.gw[0], L.gw[1], L.gw[2], L.gw[3]};
    const v4u v0 = L.v0, v1 = L.v1, k0 = L.k0, k1 = L.k1, s0 = L.s0, s1 = L.s1;
    __syncthreads();
    {
        const unsigned vw[8] = {v0.x, v0.y, v0.z, v0.w, v1.x, v1.y, v1.z, v1.w};
#pragma unroll
        for (int ii = 0; ii < 8; ++ii) { const int dd = 16 * vq4 + 2 * ii;
            *(LAS unsigned short*)(vt + dd * RT_STRIDE + 2 * vj) = (unsigned short)(vw[ii] & 0xffffu); *(LAS unsigned short*)(vt + (dd + 1) * RT_STRIDE + 2 * vj) = (unsigned short)(vw[ii] >> 16); }
        *(LAS v4u*)(kim + vj * RC_KS + 32 * vq4) = k0; *(LAS v4u*)(kim + vj * RC_KS + 32 * vq4 + 16) = k1;
        *(LAS v4u*)(sim + (sd * 64 + se) * RC_KS + 32 * sq) = s0; *(LAS v4u*)(sim + (sd * 64 + se) * RC_KS + 32 * sq + 16) = s1;
        if (C.tid < 255) { const int dl = C.tid - 127; tabf[C.tid] = (dl > 0) ? expf(lgf * (float)dl) : ((dl < 0) ? expf(lgb * (float)(-dl)) : 2.0f); }
    }
    __syncthreads();
    f32x4 st[8];
#pragma unroll
    for (int jt = 0; jt < 8; ++jt) {
        LAS const unsigned char* kp = kim + (16 * jt + n) * RC_KS + 16 * g;
        const bf16x8 ka = *(LAS const bf16x8*)(kp), kb = *(LAS const bf16x8*)(kp + 64);
        f32x4 acc = {0.f, 0.f, 0.f, 0.f};
        acc = __builtin_amdgcn_mfma_f32_16x16x32_bf16(ka, qf[0], acc, 0, 0, 0);
        acc = __builtin_amdgcn_mfma_f32_16x16x32_bf16(kb, qf[1], acc, 0, 0, 0);
        st[jt] = acc;
    }
#pragma unroll
    for (int jt = 0; jt < 8; ++jt)
#pragma unroll
        for (int reg = 0; reg < 4; ++reg) {
            const int j = 16 * jt + 4 * g + reg;
            st[jt][reg] *= tabf[127 + i - j];
        }
    f32x4 o[4];
#pragma unroll
    for (int et = 0; et < 4; ++et) o[et] = (f32x4){0.f, 0.f, 0.f, 0.f};
#pragma unroll
    for (int u = 0; u < 4; ++u) {
        v4u pw; pw.x = cvtpk(st[2 * u][0], st[2 * u][1]); pw.y = cvtpk(st[2 * u][2], st[2 * u][3]); pw.z = cvtpk(st[2 * u + 1][0], st[2 * u + 1][1]); pw.w = cvtpk(st[2 * u + 1][2], st[2 * u + 1][3]);
        const bf16x8 pb = __builtin_bit_cast(bf16x8, pw);
        const int slotA = 32 * u + 4 * g, slotB = slotA + 16;
#pragma unroll
        for (int et = 0; et < 4; ++et) {
            LAS const unsigned char* rowp = vt + (16 * et + n) * RT_STRIDE;
            const v2u a_lo = *(LAS const v2u*)(rowp + slotA * 2), a_hi = *(LAS const v2u*)(rowp + slotB * 2);
            v4u aw; aw.x = a_lo.x; aw.y = a_lo.y; aw.z = a_hi.x; aw.w = a_hi.y;
            o[et] = __builtin_amdgcn_mfma_f32_16x16x32_bf16(__builtin_bit_cast(bf16x8, aw), pb, o[et], 0, 0, 0);
        }
    }
#pragma unroll
    for (int dir = 0; dir < 2; ++dir) {
        const float scl = dir ? expf(lgb * (float)(128 - i)) : expf(lgf * (float)(i + 1));
#pragma unroll
        for (int et = 0; et < 4; ++et) {
            LAS const unsigned char* sp = sim + (dir * 64 + 16 * et + n) * RC_KS + 16 * g;
            const bf16x8 a0 = *(LAS const bf16x8*)(sp), a1 = *(LAS const bf16x8*)(sp + 64);
            f32x4 t = {0.f, 0.f, 0.f, 0.f};
            t = __builtin_amdgcn_mfma_f32_16x16x32_bf16(a0, qf[0], t, 0, 0, 0);
            t = __builtin_amdgcn_mfma_f32_16x16x32_bf16(a1, qf[1], t, 0, 0, 0);
            o[et] = o[et] + t * scl;
        }
    }
    float sm = 0.f;
#pragma unroll
    for (int et = 0; et < 4; ++et) sm += (o[et][0] + o[et][1]) + (o[et][2] + o[et][3]);
    sm += __shfl_xor(sm, 16); sm += __shfl_xor(sm, 32);
    const float mu = sm * (1.f / 64.f);
    float sq2 = 0.f;
#pragma unroll
    for (int et = 0; et < 4; ++et) { o[et] = o[et] - mu; sq2 += (o[et][0] * o[et][0] + o[et][1] * o[et][1]) + (o[et][2] * o[et][2] + o[et][3] * o[et][3]); }
    sq2 += __shfl_xor(sq2, 16); sq2 += __shfl_xor(sq2, 32);
    const float rstd = 1.0f / sqrtf(sq2 * (1.f / 64.f) + EPS);
    const float* gn = C.in[11] + layer * 384 + 64 * h;
    bf16* yp = WSP(bf16, WS_YMIX) + (size_t)rowi * D + 64 * h + 4 * g;
#pragma unroll
    for (int et = 0; et < 4; ++et) {
        const f32x4 gg = *(const f32x4*)(gn + 16 * et + 4 * g);
        const float y0 = o[et][0] * rstd * gg[0] * siluf(bflo(gw[et].x)), y1 = o[et][1] * rstd * gg[1] * siluf(bfhi(gw[et].x));
        const float y2 = o[et][2] * rstd * gg[2] * siluf(bflo(gw[et].y)), y3 = o[et][3] * rstd * gg[3] * siluf(bfhi(gw[et].y));
        v2u w; w.x = cvtpk(y0, y1); w.y = cvtpk(y2, y3);
        *(v2u*)(yp + 16 * et) = w;
    }
}

__device__ __forceinline__ void p_mix1(const Ctx& C, int layer) {
    { const int per = (1536 + C.G - 1) / C.G, u0 = C.bx * per, nu = min(per, 1536 - u0); if (nu > 0) { if ((per & 1) == 0) na_band2(C, layer, u0, nu); else na_band(C, layer, u0, nu); } }
    const int n_ctx = (layer == 0) ? 96 : 0;
    for (int u = C.bx; u < n_ctx; u += C.G) { const int bh = u >> 2; ctxattn_unit(C, bh / 6, bh % 6, u & 3); }
    {
        int u0 = (C.bx + C.G - (n_ctx % C.G)) % C.G;
        if (u0 < 816) {
            RaLoads La, Lb;
            ra_load(C, (u0 / 34) / 6, (u0 / 34) % 6, u0 % 34, La);
            for (;;) {
                const int u1 = u0 + C.G; const bool h1 = u1 < 816;
                if (h1) ra_load(C, (u1 / 34) / 6, (u1 / 34) % 6, u1 % 34, Lb);
                ret_a_unit(C, layer, (u0 / 34) / 6, (u0 / 34) % 6, u0 % 34, La);
                if (!h1) break;
                u0 = u1 + C.G; const bool h0 = u0 < 816;
                if (h0) ra_load(C, (u0 / 34) / 6, (u0 / 34) % 6, u0 % 34, La);
                ret_a_unit(C, layer, (u1 / 34) / 6, (u1 / 34) % 6, u1 % 34, Lb);
                if (!h0) break;
            }
        }
    }
    __syncthreads();
}
__device__ __forceinline__ void p_mix2(const Ctx& C, int layer) {
    ret_scan(C, layer);
    const bf16* PROJ = WSP(bf16, WS_PROJ); bf16* Y = WSP(bf16, WS_YMIX);
    const float* cw = C.in[12] + layer * 3 * 256;
    const int nrows = (layer == 0) ? RALL : RLAT;
    for (int idx = C.gtid; idx < nrows * 32; idx += C.NT) {
        const int m = idx >> 5, ch = (idx & 31) * 8;
        int tpos, len; if (m < RLAT) { tpos = m & 4095; len = SEQ; } else { tpos = (m - RLAT) & 255; len = CTXL; }
        const bf16* p = PROJ + (size_t)m * NPROJP + ch;
        const v4u zero = {0u, 0u, 0u, 0u};
        const v4u cb = *(const v4u*)(p + C_CB), cc1 = *(const v4u*)(p + C_CC), cx1 = *(const v4u*)(p + C_CX);
        const v4u cc0 = (tpos > 0) ? *(const v4u*)(p + C_CC - NPROJP) : zero, cx0 = (tpos > 0) ? *(const v4u*)(p + C_CX - NPROJP) : zero;
        const v4u cc2 = (tpos < len - 1) ? *(const v4u*)(p + C_CC + NPROJP) : zero, cx2 = (tpos < len - 1) ? *(const v4u*)(p + C_CX + NPROJP) : zero;
        const f32x4 w0a = *(const f32x4*)(cw + ch), w0b = *(const f32x4*)(cw + ch + 4), w1a = *(const f32x4*)(cw + 256 + ch), w1b = *(const f32x4*)(cw + 256 + ch + 4), w2a = *(const f32x4*)(cw + 512 + ch), w2b = *(const f32x4*)(cw + 512 + ch + 4);
        float y[8];
#pragma unroll
        for (int i = 0; i < 4; ++i) {
            const float wl0 = (i < 2) ? w0a[2 * i] : w0b[2 * i - 4], wh0 = (i < 2) ? w0a[2 * i + 1] : w0b[2 * i - 3];
            const float wl1 = (i < 2) ? w1a[2 * i] : w1b[2 * i - 4], wh1 = (i < 2) ? w1a[2 * i + 1] : w1b[2 * i - 3];
            const float wl2 = (i < 2) ? w2a[2 * i] : w2b[2 * i - 4], wh2 = (i < 2) ? w2a[2 * i + 1] : w2b[2 * i - 3];
            y[2 * i] = bflo(cb[i]) * (wl0 * bflo(cc0[i]) * bflo(cx0[i]) + wl1 * bflo(cc1[i]) * bflo(cx1[i]) + wl2 * bflo(cc2[i]) * bflo(cx2[i]));
            y[2 * i + 1] = bfhi(cb[i]) * (wh0 * bfhi(cc0[i]) * bfhi(cx0[i]) + wh1 * bfhi(cc1[i]) * bfhi(cx1[i]) + wh2 * bfhi(cc2[i]) * bfhi(cx2[i]));
        }
        v4u o; o.x = cvtpk(y[0], y[1]); o.y = cvtpk(y[2], y[3]); o.z = cvtpk(y[4], y[5]); o.w = cvtpk(y[6], y[7]);
        *(v4u*)(Y + (size_t)m * D + 384 + ch) = o;
    }
}
__device__ __forceinline__ void rc_unit_of(int layer, int u, int& bh, int& c) { if (layer == 0) { bh = u / 34; c = u % 34; } else { bh = u >> 5; c = 2 + (u & 31); } }
__device__ __forceinline__ void p_mix3(const Ctx& C, int layer) {
    const int nu = (layer == 0) ? 816 : 768;
    int u0 = C.bx;
    if (u0 < nu) {
        RcLoads La, Lb; int bh0, c0, bh1, c1;
        rc_unit_of(layer, u0, bh0, c0); rc_load(C, bh0 / 6, bh0 % 6, c0, La);
        for (;;) {
            const int u1 = u0 + C.G; const bool h1 = u1 < nu;
            if (h1) { rc_unit_of(layer, u1, bh1, c1); rc_load(C, bh1 / 6, bh1 % 6, c1, Lb); }
            ret_c_unit(C, layer, bh0 / 6, bh0 % 6, c0, La);
            if (!h1) break;
            u0 = u1 + C.G; const bool h0 = u0 < nu;
            if (h0) { rc_unit_of(layer, u0, bh0, c0); rc_load(C, bh0 / 6, bh0 % 6, c0, La); }
            ret_c_unit(C, layer, bh1 / 6, bh1 % 6, c1, Lb);
            if (!h0) break;
        }
    }
    __syncthreads();
}
__device__ __forceinline__ void p_moe_lists(const Ctx& C) {
    LAS int* L = (LAS int*)(C.lds + RING_OFF);
    const int* CNT = WSP(int, WS_CNT);
    for (int blk = C.bx; blk < 256; blk += C.G) {
        __syncthreads();
        for (int i = C.tid; i < 2048; i += NTHR) L[i] = CNT[i];
        if (C.tid < 64) L[2080 + C.tid] = WSP(int, WS_TOKE)[64 * blk + C.tid];
        __syncthreads();
        {
            const int e = C.wave; int tot = 0, pre = 0;
#pragma unroll
            for (int q = 0; q < 4; ++q) { const int k = 4 * C.lane + q; const int cnt = L[k * 8 + e]; tot += cnt; pre += (k < blk) ? cnt : 0; }
#pragma unroll
            for (int o = 1; o < 64; o <<= 1) { tot += __shfl_xor(tot, o); pre += __shfl_xor(pre, o); }
            if (C.lane == 0) { L[2048 + e] = tot; L[2064 + e] = pre; }
        }
        __syncthreads();
        if (C.tid == 0) { int base = 0; for (int e = 0; e < 8; ++e) { L[2056 + e] = base; base += (L[2048 + e] + 255) & ~255; } }
        __syncthreads();
        {
            const int e = C.wave, ee = L[2080 + C.lane], e1 = ee & 255, e2 = ee >> 8;
            const bool hit = (e1 == e) || (e2 == e);
            const unsigned long long bal = __ballot(hit);
            const int rank = __popcll(bal & ((1ull << C.lane) - 1ull));
            if (hit) L[2144 + 2 * C.lane + ((e1 == e) ? 0 : 1)] = L[2056 + e] + L[2064 + e] + rank;
        }
        __syncthreads();
        if (C.tid < 128) { const int t = C.tid >> 1, k = C.tid & 1, m = 64 * blk + t, pos = L[2144 + C.tid];
            WSP(int, WS_TOKP)[2 * m + k] = pos; WSP(float, WS_ROWW)[pos] = WSP(float, WS_TOKW)[2 * m + k]; }
        for (int j = 0; j < 8; ++j) { const int t = 8 * C.wave + j, m = 64 * blk + t;
            const v4u* src = (const v4u*)(WSP(bf16, WS_A) + (size_t)m * D) + 2 * C.lane;
            const v4u x0 = src[0], x1 = src[1];
            v4u y; y.x = pg8::pk4_fp8(bflo(x0.x), bfhi(x0.x), bflo(x0.y), bfhi(x0.y)); y.y = pg8::pk4_fp8(bflo(x0.z), bfhi(x0.z), bflo(x0.w), bfhi(x0.w));
            y.z = pg8::pk4_fp8(bflo(x1.x), bfhi(x1.x), bflo(x1.y), bfhi(x1.y)); y.w = pg8::pk4_fp8(bflo(x1.z), bfhi(x1.z), bflo(x1.w), bfhi(x1.w));
#pragma unroll
            for (int k = 0; k < 2; ++k) { v4u* dst = (v4u*)(WSP(unsigned char, WS_SORT) + (size_t)L[2144 + 2 * t + k] * D) + C.lane; dst[0] = y; } }
        if (blk == 0 && C.tid == 0) { int T = 0; int* TE = WSP(int, WS_TILE);
            for (int e = 0; e < 8; ++e) { const int nt = (L[2048 + e] + 255) >> 8; for (int k = 0; k < nt; ++k) TE[T + k] = e; T += nt; }
            TE[255] = T; }
    }
    __syncthreads();
}
__device__ __forceinline__ void p_final(const Ctx& C, float* out) {
    const float* fg = C.in[20]; const float* mod = WSP(float, WS_MOD) + 30720; const bf16* SL = WSP(bf16, WS_SLOT);
    for (int m0 = C.gw; m0 < RLAT; m0 += 2 * C.NGW) {
        int mm[2], pp[2][2]; bool ok[2];
#pragma unroll
        for (int r = 0; r < 2; ++r) { mm[r] = m0 + r * C.NGW; ok[r] = mm[r] < RLAT; const int mc = ok[r] ? mm[r] : m0; mm[r] = mc; pp[r][0] = WSP(int, WS_TOKP)[2 * mc]; pp[r][1] = WSP(int, WS_TOKP)[2 * mc + 1]; }
        f32x4 v[2][4]; float ss[2] = {0.f, 0.f};
#pragma unroll
        for (int r = 0; r < 2; ++r)
#pragma unroll
            for (int j = 0; j < 4; ++j) { const int c = 4 * C.lane + 256 * j; const int b = mm[r] >> 12;
                const f32x4 hv = *(const f32x4*)(WSP(float, WS_H) + (size_t)mm[r] * D + c), g2 = *(const f32x4*)(mod + b * 6144 + 5 * D + c);
                const v2u q1 = *(const v2u*)(SL + (size_t)pp[r][0] * D + c), q2 = *(const v2u*)(SL + (size_t)pp[r][1] * D + c);
                const f32x4 s1 = {bflo(q1.x), bfhi(q1.x), bflo(q1.y), bfhi(q1.y)}, s2 = {bflo(q2.x), bfhi(q2.x), bflo(q2.y), bfhi(q2.y)};
                v[r][j] = hv + g2 * (s1 + s2); ss[r] += (v[r][j].x * v[r][j].x + v[r][j].y * v[r][j].y) + (v[r][j].z * v[r][j].z + v[r][j].w * v[r][j].w); }
#pragma unroll
        for (int r = 0; r < 2; ++r) {
            const float rstd = 1.0f / sqrtf(wave_sum(ss[r]) * (1.0f / D) + EPS);
            if (ok[r]) {
#pragma unroll
                for (int j = 0; j < 4; ++j) { const int c = 4 * C.lane + 256 * j; __builtin_nontemporal_store(v[r][j] * rstd * *(const f32x4*)(fg + c), (f32x4*)(out + (size_t)mm[r] * D + c)); }
            }
        }
    }
}

#ifndef MK_ONE_LAUNCH
#define MK_ONE_LAUNCH 1
#endif
constexpr int NPHASES = 21;
#ifndef PROBE_DUP
#define PROBE_DUP 0u
#endif
#define REPS(k) ((((PROBE_DUP) >> (k)) & 1u) ? 2 : 1)
struct Args { const float* in[21]; float* out; unsigned char* ws; int ph_lo, ph_hi; };
__global__ void __launch_bounds__(NTHR, 2) fwd(Args args) {
    extern __shared__ __attribute__((aligned(16))) unsigned char lds_raw[];
    Ctx C;
    C.lds = (LAS unsigned char*)lds_raw;
    C.tid = threadIdx.x; C.lane = C.tid & 63; C.wave = __builtin_amdgcn_readfirstlane(C.tid >> 6);
    C.G = gridDim.x; C.bx = blockIdx.x; C.gw = C.bx * NWAVES + C.wave; C.NGW = C.G * NWAVES; C.gtid = C.bx * NTHR + C.tid; C.NT = C.G * NTHR;
    C.ws = args.ws;
#pragma unroll
    for (int i = 0; i < 21; ++i) C.in[i] = args.in[i];
    volatile LAS unsigned* MISC = (volatile LAS unsigned*)(C.lds + MISC_OFF);
    for (int u = C.tid; u < (LDS_BYTES - LDSCTL_OFF) / 4; u += NTHR) ((LAS unsigned*)(C.lds + LDSCTL_OFF))[u] = 0u;
    __syncthreads();
    const int lo = args.ph_lo, hi = args.ph_hi;
    unsigned* barw = (unsigned*)(C.ws + WS_CTL) + CW_BAR;
    XcdBarrier bar; bar.bar = barw; bar.x = 0; bar.st = nullptr;
    if (hi - lo > 1) bar = xcd_barrier_post(barw, MISC + 8);
#define IN(k) (lo <= (k) && (k) < hi)
#define SEAM(k) do { if (IN(k) && IN((k) + 1)) xcd_barrier(bar); } while (0)
    LAS unsigned char* ring = C.lds + RING_OFF;
    const float* cosT = WSP(float, WS_ROPE); const float* sinT = cosT + 1024;

    if (IN(0)) for (int rep = 0; rep < REPS(0); ++rep) { p_prologue(C); } SEAM(0);
    if (IN(1)) for (int rep = 0; rep < REPS(1); ++rep) { p_norm<false, 0>(C, 0, 0, true, true, true, false); } SEAM(1);
    if (IN(2)) for (int rep = 0; rep < REPS(2); ++rep) { pg8::Gemm g{WSP(bf16, WS_A), WSP(bf16, WS_WIN), RALL, NPROJP, D, D}; pg8::StaticOrder S; S.init(RALL, NPROJP, C.G, C.bx);
        pg8::EpiInProj E{WSP(bf16, WS_PROJ), cosT, sinT};
        pg8::gemm_phase<pg8::EpiInProj, pg8::StaticOrder, true, true>(ring, g, S, E); } SEAM(2);
    if (IN(3)) for (int rep = 0; rep < REPS(3); ++rep) { p_mix1(C, 0); } SEAM(3);
    if (IN(4)) for (int rep = 0; rep < REPS(4); ++rep) { p_mix2(C, 0); } SEAM(4);
    if (IN(5)) for (int rep = 0; rep < REPS(5); ++rep) { p_mix3(C, 0); } SEAM(5);
    if (IN(6)) for (int rep = 0; rep < REPS(6); ++rep) { { pg8::Gemm g{WSP(bf16, WS_YMIX), WSP(bf16, WS_WOUT), RLAT, D, D, D}; pg8::StaticOrder S; S.init(RLAT, D, C.G, C.bx);
        pg8::EpiResid E{WSP(float, WS_H), C.in[0], C.in[2], WSP(float, WS_MOD), 2 * D};
        pg8::gemm_phase<pg8::EpiResid, pg8::StaticOrder, true, true>(ring, g, S, E); }
        { pg8::Gemm g{WSP(bf16, WS_YMIX) + (size_t)RLAT * D, WSP(bf16, WS_WOUT), RCTX, D, 256, D}; pg8::SplitOrder S; S.init(4, C.G, C.bx);
        pg8::EpiPartial E{WSP(float, WS_PART), WSP(float, WS_MOD), 2 * D};
        pg8::gemm_phase<pg8::EpiPartial, pg8::SplitOrder, false, true>(ring, g, S, E); } } SEAM(6);
    if (IN(7)) for (int rep = 0; rep < REPS(7); ++rep) { p_norm<false, 4>(C, 0, 1, true, false, true, true); } SEAM(7);
    if (IN(8)) for (int rep = 0; rep < REPS(8); ++rep) { pg8::Gemm g{WSP(bf16, WS_A), WSP(bf16, WS_FIN), RALL, 2 * DFF, D, D}; pg8::StaticOrder S; S.init(RALL, 2 * DFF, C.G, C.bx);
        pg8::EpiSwiglu E{WSP(bf16, WS_HID)};
        pg8::gemm_phase<pg8::EpiSwiglu, pg8::StaticOrder, true, true>(ring, g, S, E); } SEAM(8);
    if (IN(9)) for (int rep = 0; rep < REPS(9); ++rep) { { pg8::Gemm g{WSP(bf16, WS_HID), WSP(bf16, WS_FOUT), RLAT, D, DFF, DFF}; pg8::StaticOrder S; S.init(RLAT, D, C.G, C.bx);
        pg8::EpiResid E{WSP(float, WS_H), WSP(float, WS_H), WSP(float, WS_H) + (size_t)RLAT * D, WSP(float, WS_MOD), 5 * D};
        pg8::gemm_phase<pg8::EpiResid, pg8::StaticOrder, true, true>(ring, g, S, E); }
        { pg8::Gemm g{WSP(bf16, WS_HID) + (size_t)RLAT * DFF, WSP(bf16, WS_FOUT), RCTX, D, 256, DFF}; pg8::SplitOrder S; S.init(11, C.G, C.bx);
        pg8::EpiPartial E{WSP(float, WS_PART), WSP(float, WS_MOD), 5 * D};
        pg8::gemm_phase<pg8::EpiPartial, pg8::SplitOrder, false, true>(ring, g, S, E); } } SEAM(9);
    if (IN(10)) for (int rep = 0; rep < REPS(10); ++rep) { p_norm<false, 11>(C, 1, 0, true, false, false, false); } SEAM(10);
    if (IN(11)) for (int rep = 0; rep < REPS(11); ++rep) { pg8::Gemm g{WSP(bf16, WS_A), WSP(bf16, WS_WIN) + (size_t)NPROJP * D, RALL, NPROJP, D, D}; pg8::StaticOrder S; S.init(RALL, NPROJP, C.G, C.bx);
        pg8::EpiInProj E{WSP(bf16, WS_PROJ), cosT, sinT};
        pg8::gemm_phase<pg8::EpiInProj, pg8::StaticOrder, true, true>(ring, g, S, E); } SEAM(11);
    if (IN(12)) for (int rep = 0; rep < REPS(12); ++rep) { p_mix1(C, 1); } SEAM(12);
    if (IN(13)) for (int rep = 0; rep < REPS(13); ++rep) { p_mix2(C, 1); } SEAM(13);
    if (IN(14)) for (int rep = 0; rep < REPS(14); ++rep) { p_mix3(C, 1); } SEAM(14);
    if (IN(15)) for (int rep = 0; rep < REPS(15); ++rep) { pg8::Gemm g{WSP(bf16, WS_YMIX), WSP(bf16, WS_WOUT) + (size_t)D * D, RLAT, D, D, D}; pg8::StaticOrder S; S.init(RLAT, D, C.G, C.bx);
        pg8::EpiResid E{WSP(float, WS_H), WSP(float, WS_H), WSP(float, WS_H) + (size_t)RLAT * D, WSP(float, WS_MOD) + 30720, 2 * D};
        pg8::gemm_phase<pg8::EpiResid, pg8::StaticOrder, true, true>(ring, g, S, E); } SEAM(15);
    if (IN(16)) for (int rep = 0; rep < REPS(16); ++rep) { p_norm<true, 0>(C, 1, 1, false, false, false, false); } SEAM(16);
    if (IN(17)) for (int rep = 0; rep < REPS(17); ++rep) { p_moe_lists(C); } SEAM(17);
    if (IN(18)) for (int rep = 0; rep < REPS(18); ++rep) { const int T = __builtin_amdgcn_readfirstlane(WSP(int, WS_TILE)[255]);
        pg8::Gemm g{WSP(bf16, WS_SORT), WSP(bf16, WS_MIN), T * 256, 2 * DFF, D / 2, D / 2}; pg8::MoeOrder S; S.init(T, 2 * DFF, C.G, C.bx, WSP(int, WS_TILE), (size_t)2 * DFF * D / 2);
        pg8::EpiSwigluF8 E{WSP(unsigned char, WS_HID)};
        pg8::gemm_phase<pg8::EpiSwigluF8, pg8::MoeOrder, true, true, true>(ring, g, S, E); } SEAM(18);
    if (IN(19)) for (int rep = 0; rep < REPS(19); ++rep) { const int T = __builtin_amdgcn_readfirstlane(WSP(int, WS_TILE)[255]);
        pg8::Gemm g{WSP(bf16, WS_HID), WSP(bf16, WS_MOUT), T * 256, D, DFF / 2, DFF / 2}; pg8::MoeOrder S; S.init(T, D, C.G, C.bx, WSP(int, WS_TILE), (size_t)D * DFF / 2);
        pg8::EpiSlots E{WSP(bf16, WS_SLOT), WSP(float, WS_ROWW)};
        pg8::gemm_phase<pg8::EpiSlots, pg8::MoeOrder, true, true, true>(ring, g, S, E); } SEAM(19);
    if (IN(20)) for (int rep = 0; rep < REPS(20); ++rep) { p_final(C, args.out); }
#undef IN
#undef SEAM
}

extern "C" void kernel_launch(void* const* d_in, const int* in_sizes, int n_in, void* d_out, int out_size, void* d_ws, size_t ws_size, hipStream_t stream) {
    static int grid = 0;
    if (grid == 0) {
        if (n_in != 21 || ws_size < WS_END) { fprintf(stderr, "kernel_launch: unexpected n_in %d or ws_size %zu (need %zu)\n", n_in, ws_size, (size_t)WS_END); grid = -1; return; }
        int dev = 0, cus = 0, per_cu = 0;
        if (hipGetDevice(&dev) != hipSuccess || hipDeviceGetAttribute(&cus, hipDeviceAttributeMultiprocessorCount, dev) != hipSuccess) { grid = -1; return; }
        if (hipFuncSetAttribute((const void*)fwd, hipFuncAttributeMaxDynamicSharedMemorySize, LDS_BYTES) != hipSuccess) { fprintf(stderr, "kernel_launch: hipFuncSetAttribute failed\n"); grid = -1; return; }
        if (hipOccupancyMaxActiveBlocksPerMultiprocessor(&per_cu, (const void*)fwd, NTHR, LDS_BYTES) != hipSuccess || per_cu < 1) fprintf(stderr, "kernel_launch: occupancy query reports %d\n", per_cu);
        (void)hipGetLastError();
        grid = cus < 256 ? cus : 256;
    }
    if (grid < 0) return;
    (void)hipMemsetAsync((char*)d_ws + WS_CTL, 0, CTL_ZERO_BYTES, stream);
    Args a{};
    for (int i = 0; i < 21; ++i) a.in[i] = (const float*)d_in[i];
    a.out = (float*)d_out; a.ws = (unsigned char*)d_ws;
#if MK_ONE_LAUNCH
    a.ph_lo = 0; a.ph_hi = NPHASES;
    hipLaunchKernelGGL(fwd, dim3(grid), dim3(NTHR), LDS_BYTES, stream, a);
#else
    for (int p = 0; p < NPHASES; ++p) { a.ph_lo = p; a.ph_hi = p + 1; hipLaunchKernelGGL(fwd, dim3(grid), dim3(NTHR), LDS_BYTES, stream, a); }
#endif
}
```

```cpp
#include <hip/hip_runtime.h>
#include <cstdio>
#include <cstdint>
namespace pg8 {
#define PG8_LAS __attribute__((address_space(3)))
typedef unsigned short bf16_t;
typedef short bf16x8 __attribute__((ext_vector_type(8)));
typedef float f32x4 __attribute__((ext_vector_type(4)));
typedef unsigned u32x4 __attribute__((ext_vector_type(4)));
constexpr int BM = 256, BK = 64, HALF = 128, HTB = HALF * BK * 2  , STAGE_BYTES = 8 * HTB, NXCD = 8, WGM = 8;

__host__ __device__ __forceinline__ int lds_byte(int r, int c) { const int st = (r >> 4) * 2 + (c >> 5), rr = r & 15, cc = c & 31, ob = rr * 64 + cc * 2; return st * 1024 + (ob ^ (((ob >> 9) & 1) << 5)); }
__host__ __device__ __forceinline__ void stage_rc(int b, int& R, int& C) { const int st = b / 1024, sb = b % 1024, swz = sb ^ (((sb >> 9) & 1) << 5); R = (st >> 1) * 16 + swz / 64; C = (st & 1) * 32 + (swz % 64) / 2; }
__host__ __device__ __forceinline__ int perm32(int rho) { const int n = rho >> 4, i = rho & 15; return 8 * (i >> 2) + 4 * n + (i & 3); }

struct Unit { int pm, pn, ks; };
struct Gemm { const bf16_t* A; const bf16_t* Bt; int M, N, K, ld; };

struct StaticOrder {
    int nM, nN, nwg, G, c;
    __host__ __device__ void init(int M, int N, int G_, int c_) { nM = M / BM; nN = N / BM; nwg = nM * nN; G = G_; c = c_; }
    __host__ __device__ bool next(int i, Unit& u) const {
        const long L = (long)i * G + c; if (L >= nwg) return false;
        int wgid = (int)L; { const int q = nwg / NXCD, r = nwg % NXCD, xcd = wgid % NXCD, off = wgid / NXCD; wgid = (xcd < r ? xcd * (q + 1) : r * (q + 1) + (xcd - r) * q) + off; }
        const int nig = WGM * nN, gid = wgid / nig, fm = gid * WGM, gsz = (nM - fm) < WGM ? (nM - fm) : WGM;
        u.pm = fm + ((wgid % nig) % gsz); u.pn = (wgid % nig) / gsz; u.ks = 0; return true;
    }
    __device__ __forceinline__ void a_ready(const Unit&) const {}
    __device__ __forceinline__ void done(const Unit&) const {}
    __device__ __forceinline__ const bf16_t* bt(const Gemm& g, const Unit&) const { return g.Bt; }
};

__device__ __forceinline__ unsigned cvt_pk_bf16(float lo, float hi) { unsigned r; asm volatile("v_cvt_pk_bf16_f32 %0, %1, %2" : "=v"(r) : "v"(lo), "v"(hi)); return r; }
typedef float f32x2 __attribute__((ext_vector_type(2)));

typedef int i32x4_t __attribute__((ext_vector_type(4)));
typedef int i32x8_t __attribute__((ext_vector_type(8)));
__device__ __forceinline__ i32x8_t cat8(bf16x8 lo, bf16x8 hi) { const i32x4_t l = __builtin_bit_cast(i32x4_t, lo), h = __builtin_bit_cast(i32x4_t, hi); return __builtin_shufflevector(l, h, 0, 1, 2, 3, 4, 5, 6, 7); }
template <class Epi, class Sched, bool ALIGN_EPI = false, bool SP2 = false, bool FP8 = false>
__device__ __forceinline__ void gemm_phase(PG8_LAS unsigned char* lds, const Gemm g, const Sched& S, const Epi& E) {
    const int tid = threadIdx.x, wid = __builtin_amdgcn_readfirstlane(tid >> 6), lane = tid & 63, wr = wid >> 2, wc = wid & 3, fr = lane & 15, fq = lane >> 4;
    const int K = g.K, nt = K / BK, LD = g.ld;
    unsigned voffA[2], voffB[2];
#pragma unroll
    for (int i = 0; i < 2; ++i) { int R, C; stage_rc(tid * 16 + i * 8192, R, C); const int Rb = Epi::PERM ? ((R & ~31) + perm32(R & 31)) : R;
        voffA[i] = (unsigned)(R * LD + C) * 2u; voffB[i] = (unsigned)(Rb * LD + C) * 2u; }
    const size_t kstep = (size_t)(BK * 2);
    const size_t hstep = (size_t)HALF * LD * 2;
    const size_t tstep = 2 * hstep;
    const unsigned ldsw = (unsigned)wid * 1024u;
    const int aoff = lds_byte(wr * 64 + fr, fq * 8), boff = lds_byte(wc * 32 + fr, fq * 8);
#define PG8_SA(b, h) (((b) * 2 + (h)) * HTB)
#define PG8_SB(b, h) ((4 + (b) * 2 + (h)) * HTB)
#define PG8_STAGE(bufoff, gbase, voff) do { _Pragma("unroll") for (int _i = 0; _i < 2; ++_i) \
        __builtin_amdgcn_global_load_lds((const unsigned*)((const char*)(gbase) + (voff)[_i]), (PG8_LAS unsigned*)(lds + (bufoff) + ldsw + _i * 8192), 16, 0, 0); } while (0)
#define PG8_LDA(dst, b, h) do { if constexpr (FP8) { _Pragma("unroll") for (int m = 0; m < 4; ++m) dst##_8[m] = cat8(*(const PG8_LAS bf16x8*)(lds + PG8_SA(b, h) + aoff + m * 2048), *(const PG8_LAS bf16x8*)(lds + PG8_SA(b, h) + aoff + m * 2048 + 1024)); } \
    else { _Pragma("unroll") for (int m = 0; m < 4; ++m) _Pragma("unroll") for (int k = 0; k < 2; ++k) dst[m][k] = *(const PG8_LAS bf16x8*)(lds + PG8_SA(b, h) + aoff + m * 2048 + k * 1024); } } while (0)
#define PG8_LDB(dst, b, h) do { if constexpr (FP8) { _Pragma("unroll") for (int n = 0; n < 2; ++n) dst##_8[n] = cat8(*(const PG8_LAS bf16x8*)(lds + PG8_SB(b, h) + boff + n * 2048), *(const PG8_LAS bf16x8*)(lds + PG8_SB(b, h) + boff + n * 2048 + 1024)); } \
    else { _Pragma("unroll") for (int n = 0; n < 2; ++n) _Pragma("unroll") for (int k = 0; k < 2; ++k) dst[n][k] = *(const PG8_LAS bf16x8*)(lds + PG8_SB(b, h) + boff + n * 2048 + k * 1024); } } while (0)
#define PG8_MMA(ai, bj, At, Bt) do { __builtin_amdgcn_s_setprio(1); _Pragma("unroll") for (int m = 0; m < 4; ++m) _Pragma("unroll") for (int n = 0; n < 2; ++n) { \
        if constexpr (FP8) { asm volatile("v_mfma_scale_f32_16x16x128_f8f6f4 %0, %1, %2, %0, %3, %4 op_sel_hi:[0,0,0]" : "+v"(acc[ai][bj][m][n]) : "v"(Bt##_8[n]), "v"(At##_8[m]), "v"(f8_scale_w), "v"(f8_scale_a)); } \
        else { _Pragma("unroll") for (int k = 0; k < 2; ++k) acc[ai][bj][m][n] = __builtin_amdgcn_mfma_f32_16x16x32_bf16(Bt[n][k], At[m][k], acc[ai][bj][m][n], 0, 0, 0); } } __builtin_amdgcn_s_setprio(0); } while (0)
#define PG8_WAIT_V(n) asm volatile("s_waitcnt vmcnt(" #n ")" ::: "memory")
#define PG8_WAIT_L(n) asm volatile("s_waitcnt lgkmcnt(" #n ")" ::: "memory")
#define PG8_BAR __builtin_amdgcn_s_barrier()
#define PG8_SCHED __builtin_amdgcn_sched_barrier(0)
    Unit cur, nxt; int ui = 0;
    if (!S.next(0, cur)) return;
    f32x4 acc[2][2][4][2];
#pragma unroll
    for (int a = 0; a < 2; ++a)
#pragma unroll
        for (int b = 0; b < 2; ++b)
#pragma unroll
            for (int m = 0; m < 4; ++m)
#pragma unroll
                for (int n = 0; n < 2; ++n) acc[a][b][m][n] = (f32x4){0.f, 0.f, 0.f, 0.f};
    bf16x8 At[4][2], B0[2][2], B1[2][2]; i32x8_t At_8[4], B0_8[2], B1_8[2];
    const int f8_scale_w = 0x79797979, f8_scale_a = 0x7f7f7f7f;
    const char* cA = (const char*)g.A + (size_t)cur.pm * tstep + (size_t)cur.ks * K * 2; const char* cB = (const char*)S.bt(g, cur) + (size_t)cur.pn * tstep + (size_t)cur.ks * K * 2;
    S.a_ready(cur);
    if constexpr (SP2) {
        PG8_STAGE(PG8_SB(0, 0), cB, voffB); PG8_STAGE(PG8_SB(0, 1), cB + hstep, voffB); PG8_STAGE(PG8_SA(0, 0), cA, voffA); PG8_STAGE(PG8_SA(0, 1), cA + hstep, voffA);
        if (wr == 1) PG8_BAR;
        PG8_WAIT_V(2); PG8_BAR;
        PG8_STAGE(PG8_SB(1, 0), cB + kstep, voffB); PG8_STAGE(PG8_SA(1, 0), cA + kstep, voffA); PG8_STAGE(PG8_SB(1, 1), cB + hstep + kstep, voffB);
        PG8_WAIT_V(6); PG8_BAR;
    } else {
        PG8_STAGE(PG8_SB(0, 0), cB, voffB); PG8_STAGE(PG8_SA(0, 0), cA, voffA); PG8_STAGE(PG8_SB(0, 1), cB + hstep, voffB); PG8_STAGE(PG8_SA(0, 1), cA + hstep, voffA);
        if (wr == 1) PG8_BAR;
        PG8_WAIT_V(4); PG8_BAR;
        PG8_STAGE(PG8_SB(1, 0), cB + kstep, voffB); PG8_STAGE(PG8_SA(1, 0), cA + kstep, voffA); PG8_STAGE(PG8_SB(1, 1), cB + hstep + kstep, voffB);
        PG8_WAIT_V(6); PG8_BAR;
    }
    for (;;) {
        const bool has_next = S.next(ui + 1, nxt);
        const char* nA = has_next ? (const char*)g.A + (size_t)nxt.pm * tstep + (size_t)nxt.ks * K * 2 : cA; const char* nB = has_next ? (const char*)S.bt(g, nxt) + (size_t)nxt.pn * tstep + (size_t)nxt.ks * K * 2 : cB;
#pragma clang loop unroll(disable)
        for (int t = 0; t < nt; t += 2) {
            const bool last = (t == nt - 2);
            const char* a1 = cA + (size_t)(t + 1) * kstep;
            const char* a2 = last ? nA : cA + (size_t)(t + 2) * kstep; const char* b2 = last ? nB : cB + (size_t)(t + 2) * kstep;
            const char* a3 = a2 + kstep; const char* b3 = b2 + kstep;
            if (last && has_next) S.a_ready(nxt);
            if constexpr (SP2) {
            PG8_LDB(B0, 0, 0); PG8_LDB(B1, 0, 1); PG8_SCHED; PG8_LDA(At, 0, 0); PG8_STAGE(PG8_SA(1, 1), a1 + hstep, voffA);
            PG8_WAIT_V(8); PG8_WAIT_L(0); PG8_BAR; PG8_MMA(0, 0, At, B0); PG8_MMA(0, 1, At, B1); PG8_BAR; PG8_SCHED;
            PG8_LDA(At, 0, 1); PG8_STAGE(PG8_SB(0, 0), b2, voffB); PG8_STAGE(PG8_SB(0, 1), b2 + hstep, voffB); PG8_STAGE(PG8_SA(0, 0), a2, voffA);
            PG8_WAIT_V(8); PG8_WAIT_L(0); PG8_BAR; PG8_MMA(1, 0, At, B0); PG8_MMA(1, 1, At, B1); PG8_BAR; PG8_SCHED;
            PG8_LDB(B0, 1, 0); PG8_LDB(B1, 1, 1); PG8_SCHED; PG8_LDA(At, 1, 0); PG8_STAGE(PG8_SA(0, 1), a2 + hstep, voffA);
            PG8_WAIT_V(8); PG8_WAIT_L(0); PG8_BAR; PG8_MMA(0, 0, At, B0); PG8_MMA(0, 1, At, B1); PG8_BAR; PG8_SCHED;
            PG8_LDA(At, 1, 1); PG8_STAGE(PG8_SB(1, 0), b3, voffB); PG8_STAGE(PG8_SB(1, 1), b3 + hstep, voffB); PG8_STAGE(PG8_SA(1, 0), a3, voffA);
            PG8_WAIT_V(8); PG8_WAIT_L(0); PG8_BAR; PG8_MMA(1, 0, At, B0); PG8_MMA(1, 1, At, B1); PG8_BAR; PG8_SCHED;
            } else {
            PG8_LDB(B0, 0, 0); PG8_SCHED; PG8_LDA(At, 0, 0); PG8_STAGE(PG8_SA(1, 1), a1 + hstep, voffA);
            PG8_WAIT_L(8); PG8_BAR; PG8_WAIT_L(0); PG8_MMA(0, 0, At, B0); PG8_BAR; PG8_SCHED;
            PG8_LDB(B1, 0, 1); PG8_STAGE(PG8_SB(0, 0), b2, voffB);
            PG8_BAR; PG8_WAIT_L(0); PG8_MMA(0, 1, At, B1); PG8_BAR;
            PG8_LDA(At, 0, 1); PG8_STAGE(PG8_SA(0, 0), a2, voffA);
            PG8_BAR; PG8_WAIT_L(0); PG8_MMA(1, 0, At, B0); PG8_BAR; PG8_SCHED;
            PG8_STAGE(PG8_SB(0, 1), b2 + hstep, voffB);
            PG8_WAIT_V(6); PG8_BAR; PG8_MMA(1, 1, At, B1); PG8_BAR;
            PG8_LDB(B0, 1, 0); PG8_SCHED; PG8_LDA(At, 1, 0); PG8_STAGE(PG8_SA(0, 1), a2 + hstep, voffA);
            PG8_WAIT_L(8); PG8_BAR; PG8_WAIT_L(0); PG8_MMA(0, 0, At, B0); PG8_BAR; PG8_SCHED;
            PG8_LDB(B1, 1, 1); PG8_STAGE(PG8_SB(1, 0), b3, voffB);
            PG8_BAR; PG8_WAIT_L(0); PG8_MMA(0, 1, At, B1); PG8_BAR;
            PG8_LDA(At, 1, 1); PG8_STAGE(PG8_SA(1, 0), a3, voffA);
            PG8_BAR; PG8_WAIT_L(0); PG8_MMA(1, 0, At, B0); PG8_BAR; PG8_SCHED;
            PG8_STAGE(PG8_SB(1, 1), b3 + hstep, voffB);
            PG8_WAIT_V(6); PG8_BAR; PG8_MMA(1, 1, At, B1); PG8_BAR;
            }
        }
        if constexpr (ALIGN_EPI) { if (wr == 0) PG8_BAR; }
        if constexpr (FP8) asm volatile("s_nop 15\n\ts_nop 15" ::: "memory");
        if constexpr (!Epi::AFTER_DRAIN) { E(acc, cur, wr, wc, fr, fq); S.done(cur); }
        if (!has_next) break;
#pragma unroll
        for (int a = 0; a < 2; ++a)
#pragma unroll
            for (int b = 0; b < 2; ++b)
#pragma unroll
                for (int m = 0; m < 4; ++m)
#pragma unroll
                    for (int n = 0; n < 2; ++n) acc[a][b][m][n] = (f32x4){0.f, 0.f, 0.f, 0.f};
        cur = nxt; cA = nA; cB = nB; ++ui;
        if constexpr (ALIGN_EPI) { if (wr == 1) PG8_BAR; }
    }
    PG8_WAIT_V(0);
    if constexpr (!ALIGN_EPI) { if (wr == 0) PG8_BAR; }
    PG8_BAR;
    if constexpr (Epi::AFTER_DRAIN) { E.fused(acc, cur, wr, wc, fr, fq, lds, wid, lane); S.done(cur); }
#undef PG8_SA
#undef PG8_SB
#undef PG8_STAGE
#undef PG8_LDA
#undef PG8_LDB
#undef PG8_MMA
#undef PG8_WAIT_V
#undef PG8_WAIT_L
#undef PG8_BAR
#undef PG8_SCHED
}
}


constexpr int NWAVES = 8, NTHR = 512;
constexpr int D = 1024, NB = 4, SEQ = 4096, CTXL = 256, RLAT = NB * SEQ, RCTX = NB * CTXL, RALL = RLAT + RCTX;
constexpr int NPROJ = 3456, NPROJP = 3584, DFF = 2816, NE = 8;
constexpr int C_RQ = 0, C_RK = 384, C_RV = 768, C_RG = 1152, C_CB = 1536, C_CC = 1792, C_CX = 2048, C_NQ = 2304, C_NK = 2688, C_NV = 3072;
constexpr int MOE_ROWS = 2 * RLAT + NE * 256;
constexpr float EPS = 1e-6f;

constexpr size_t MiB = 1u << 20, KiB = 1u << 10;
constexpr size_t WS_CTL = 0, CTL_ZERO_BYTES = 1 * MiB;
constexpr size_t WS_MODP = 1 * MiB;
constexpr size_t WS_MOD = 3 * MiB;
constexpr size_t WS_ROWW = 3 * MiB + 256 * KiB;
constexpr size_t WS_ROPE = 3 * MiB + 512 * KiB;
constexpr size_t WS_CNT = WS_ROPE + 16 * KiB;
constexpr size_t WS_TILE = WS_ROPE + 32 * KiB;
constexpr size_t WS_TOKE = WS_ROPE + 64 * KiB;
constexpr size_t WS_TOKW = WS_ROPE + 128 * KiB;
constexpr size_t WS_TOKP = WS_ROPE + 256 * KiB;
constexpr size_t WS_WIN = 4 * MiB;
constexpr size_t WS_WOUT = 18 * MiB;
constexpr size_t WS_FIN = 22 * MiB;
constexpr size_t WS_FOUT = 33 * MiB;
constexpr size_t WS_MIN = 39 * MiB;
constexpr size_t WS_MOUT = 127 * MiB;
constexpr size_t WS_H = 171 * MiB;
constexpr size_t WS_A = 239 * MiB;
constexpr size_t WS_PROJ = 273 * MiB;
constexpr size_t WS_YMIX = 392 * MiB;
constexpr size_t WS_HID = 273 * MiB;
constexpr size_t WS_OBUF = 474 * MiB;
constexpr size_t WS_SORT = 526 * MiB;
constexpr size_t WS_SLOT = 474 * MiB;
constexpr size_t WS_PART = 610 * MiB;
constexpr size_t WS_END = 654 * MiB;
constexpr int CW_BAR = 4096;

constexpr int RING_OFF = 0, RING_BYTES = 157696;
constexpr int LDSCTL_OFF = RING_BYTES, MISC_OFF = LDSCTL_OFF + 320;
constexpr int LDS_BYTES = 158720;

#define GAS __attribute__((address_space(1)))
#define LAS __attribute__((address_space(3)))
typedef unsigned short bf16;
typedef unsigned v4u __attribute__((ext_vector_type(4)));
typedef unsigned v2u __attribute__((ext_vector_type(2)));
typedef float f32x4 __attribute__((ext_vector_type(4)));
typedef GAS unsigned gu32;
#define RLX_AGENT __ATOMIC_RELAXED, __HIP_MEMORY_SCOPE_AGENT
#define LDS_WAIT() asm volatile("s_waitcnt lgkmcnt(0)" ::: "memory")
__device__ __forceinline__ unsigned f2bf(float f) { unsigned u = __builtin_bit_cast(unsigned, f); return (u + 0x7fffu + ((u >> 16) & 1u)) >> 16; }
__device__ __forceinline__ unsigned pk2(float lo, float hi) { return f2bf(lo) | (f2bf(hi) << 16); }
__device__ __forceinline__ float bf2f(unsigned short b) { return __builtin_bit_cast(float, (unsigned)b << 16); }
__device__ __forceinline__ float bflo(unsigned u) { return __builtin_bit_cast(float, u << 16); }
__device__ __forceinline__ float bfhi(unsigned u) { return __builtin_bit_cast(float, u & 0xffff0000u); }
__device__ __forceinline__ float siluf(float x) { return x * __builtin_amdgcn_rcpf(1.f + __expf(-x)); }
__device__ __forceinline__ float wave_sum(float v) {
#pragma unroll
    for (int o = 1; o < 64; o <<= 1) v += __shfl_xor(v, o);
    return v;
}
__device__ __forceinline__ float wave_max(float v) {
#pragma unroll
    for (int o = 1; o < 64; o <<= 1) v = fmaxf(v, __shfl_xor(v, o));
    return v;
}
#define XB_TMO      128
#define XB_XCNT(j)  (256  + 64 * (j))
#define XB_XSUB(j)  (1280 + 64 * (j))
#define XB_XGEN(j)  (2304 + 64 * (j))
#define XB_TOP      3328
#define XB_TOPGEN   3392
#define XCD_BAR_WORDS 3456
#define XB_SPIN_CAP (1u << 18)

__device__ __forceinline__ unsigned xb_ld(unsigned* p)              { return __hip_atomic_load(p, __ATOMIC_RELAXED, __HIP_MEMORY_SCOPE_AGENT); }
__device__ __forceinline__ unsigned xb_add(unsigned* p, unsigned v) { return __hip_atomic_fetch_add(p, v, __ATOMIC_RELAXED, __HIP_MEMORY_SCOPE_AGENT); }
__device__ __forceinline__ unsigned xb_xcc_id() { return (unsigned)__builtin_amdgcn_s_getreg((3 << 11) | 20) & 0xFu; }
#define XB_SPIN(cond, bar) do { unsigned _sp = 0; while (cond) { __builtin_amdgcn_s_sleep(1); \
    if ((++_sp & 255u) == 0u) { if (xb_ld(&(bar)[XB_TMO])) break; if (_sp > XB_SPIN_CAP) { atomicAdd(&(bar)[XB_TMO], 1u); break; } } } } while (0)

struct XcdBarrier {
    unsigned* bar; unsigned x;
    volatile LAS unsigned* st;
};

__device__ __forceinline__ XcdBarrier xcd_barrier_post(unsigned* bar, volatile LAS unsigned* st) {
    XcdBarrier b; b.bar = bar; b.x = xb_xcc_id(); b.st = st;
    if (threadIdx.x == 0) (void)xb_add(&bar[XB_XCNT(b.x)], 1u);
    return b;
}
__device__ __forceinline__ void xcd_barrier_complete(unsigned* bar, unsigned x, unsigned& nloc, unsigned& nx) {
    const unsigned G = gridDim.x * gridDim.y * gridDim.z;
    unsigned sum, cnt, mine, sp = 0u;
    for (;;) {
        sum = 0u; cnt = 0u; mine = 0u;
#pragma unroll
        for (unsigned j = 0; j < 16; ++j) { const unsigned c = xb_ld(&bar[XB_XCNT(j)]); sum += c; cnt += (c > 0u) ? 1u : 0u; mine = (j == x) ? c : mine; }
        if (sum == G) break;
        __builtin_amdgcn_s_sleep(1);
        if ((++sp & 255u) == 0u) { if (xb_ld(&bar[XB_TMO])) break; if (sp > XB_SPIN_CAP) { atomicAdd(&bar[XB_TMO], 1u); break; } }
    }
    nloc = mine > 0u ? mine : 1u; nx = cnt > 0u ? cnt : 1u;
}

__device__ __forceinline__ void xcd_barrier(const XcdBarrier& b) {
    asm volatile("s_waitcnt vmcnt(0)" ::: "memory");
    __syncthreads();
    if (threadIdx.x == 0) {
        unsigned* bar = b.bar;
        __builtin_amdgcn_s_waitcnt(0);
        unsigned nloc = b.st[0], nx = b.st[1];
        if (nloc == 0u) { xcd_barrier_complete(bar, b.x, nloc, nx); b.st[0] = nloc; b.st[1] = nx; }
        const unsigned old = xb_add(&bar[XB_XSUB(b.x)], 1u);
        const unsigned gen = old / nloc;
        if (old + 1u == (gen + 1u) * nloc) {
            __builtin_amdgcn_fence(__ATOMIC_RELEASE, "agent");
            asm volatile("s_waitcnt vmcnt(0)" ::: "memory");
            const unsigned og = xb_add(&bar[XB_TOP], 1u);
            const unsigned tg = og / nx;
            if (og + 1u == (tg + 1u) * nx) xb_add(&bar[XB_TOPGEN], 1u);
            else XB_SPIN(xb_ld(&bar[XB_TOPGEN]) == tg, bar);
            __builtin_amdgcn_fence(__ATOMIC_ACQUIRE, "agent");
            xb_add(&bar[XB_XGEN(b.x)], 1u);
            asm volatile("s_waitcnt vmcnt(0)" ::: "memory");
        } else {
            XB_SPIN(xb_ld(&bar[XB_XGEN(b.x)]) == gen, bar);
            __builtin_amdgcn_fence(__ATOMIC_ACQUIRE, "agent");
            asm volatile("s_waitcnt vmcnt(0)" ::: "memory");
        }
    }
    __syncthreads();
}


namespace pg8 {
struct EpiInProj {
    static constexpr bool PERM = true, AFTER_DRAIN = false;
    bf16_t* O; const float* cosT; const float* sinT;
    __device__ __forceinline__ void operator()(const f32x4 (&acc)[2][2][4][2], const Unit& u, int wr, int wc, int fr, int fq) const {
        const bool rope = (u.pn <= 2) && (u.pm < 64);
        const int row0 = u.pm * BM + wr * 64 + fr, col0 = u.pn * BM + wc * 32 + 8 * fq;
        const float sgn = (fq < 2) ? -1.f : 1.f;
#pragma unroll
        for (int ai = 0; ai < 2; ++ai)
#pragma unroll
            for (int m = 0; m < 4; ++m) {
                const int row = row0 + ai * HALF + m * 16;
                f32x4 cs0 = {1.f, 1.f, 1.f, 1.f}, cs1 = cs0, sn0 = {0.f, 0.f, 0.f, 0.f}, sn1 = sn0;
                if (rope) { const int t = row & 4095, pos = (wc & 1) ? (t & 63) : (t >> 6); const float* cp = cosT + pos * 16 + 8 * (fq & 1); const float* sp = sinT + pos * 16 + 8 * (fq & 1);
                    cs0 = *(const f32x4*)cp; cs1 = *(const f32x4*)(cp + 4); sn0 = *(const f32x4*)sp; sn1 = *(const f32x4*)(sp + 4); }
#pragma unroll
                for (int bj = 0; bj < 2; ++bj) {
                    f32x4 v0 = acc[ai][bj][m][0], v1 = acc[ai][bj][m][1];
                    if (rope) {
                        f32x4 p0, p1;
#pragma unroll
                        for (int j = 0; j < 4; ++j) { p0[j] = __shfl_xor(v0[j], 32); p1[j] = __shfl_xor(v1[j], 32); }
                        v0 = v0 * cs0 + (p0 * sn0) * sgn; v1 = v1 * cs1 + (p1 * sn1) * sgn;
                    }
                    const float sc = (u.pn == 2 || (u.pn == 1 && bj == 1)) ? 0.125f : 1.f;
                    v0 = v0 * sc; v1 = v1 * sc;
                    u32x4 w; w.x = cvt_pk_bf16(v0[0], v0[1]); w.y = cvt_pk_bf16(v0[2], v0[3]); w.z = cvt_pk_bf16(v1[0], v1[1]); w.w = cvt_pk_bf16(v1[2], v1[3]);
                    *(u32x4*)(O + (size_t)row * 3584 + col0 + bj * HALF) = w;
                }
            }
    }
};
struct EpiResid {
    static constexpr bool PERM = false, AFTER_DRAIN = false;
    float* H; const float* src_lat; const float* src_ctx; const float* gmod; int goff;
    __device__ __forceinline__ void operator()(const f32x4 (&acc)[2][2][4][2], const Unit& u, int wr, int wc, int fr, int fq) const {
        const int row0 = u.pm * BM + wr * 64 + fr, col0 = u.pn * BM + wc * 32 + 4 * fq;
        const int bi = (u.pm < 64) ? (u.pm >> 4) : 4;
        const float* src = (u.pm < 64) ? src_lat : src_ctx - (size_t)16384 * 1024;
        f32x4 gv[2][2];
#pragma unroll
        for (int bj = 0; bj < 2; ++bj)
#pragma unroll
            for (int n = 0; n < 2; ++n) gv[bj][n] = *(const f32x4*)(gmod + bi * 6144 + goff + col0 + bj * HALF + n * 16);
#pragma unroll
        for (int ai = 0; ai < 2; ++ai)
            {
                f32x4 sv[4][2][2];
#pragma unroll
                for (int m = 0; m < 4; ++m)
#pragma unroll
                    for (int bj = 0; bj < 2; ++bj)
#pragma unroll
                        for (int n = 0; n < 2; ++n) sv[m][bj][n] = *(const f32x4*)(src + (size_t)(row0 + ai * HALF + m * 16) * 1024 + col0 + bj * HALF + n * 16);
                asm volatile("" ::: "memory");
#pragma unroll
                for (int m = 0; m < 4; ++m)
#pragma unroll
                    for (int bj = 0; bj < 2; ++bj)
#pragma unroll
                        for (int n = 0; n < 2; ++n) *(f32x4*)(H + (size_t)(row0 + ai * HALF + m * 16) * 1024 + col0 + bj * HALF + n * 16) = sv[m][bj][n] + gv[bj][n] * acc[ai][bj][m][n];
                asm volatile("" ::: "memory");
            }
    }
};
struct EpiSwiglu {
    static constexpr bool PERM = true, AFTER_DRAIN = false;
    bf16_t* O;
    __device__ __forceinline__ void operator()(const f32x4 (&acc)[2][2][4][2], const Unit& u, int wr, int wc, int fr, int fq) const {
        const int row0 = u.pm * BM + wr * 64 + fr, col0 = u.pn * HALF + wc * 32 + 8 * fq;
#pragma unroll
        for (int ai = 0; ai < 2; ++ai)
#pragma unroll
            for (int m = 0; m < 4; ++m) {
                float hv[8];
#pragma unroll
                for (int n = 0; n < 2; ++n)
#pragma unroll
                    for (int j = 0; j < 4; ++j) { const float g = acc[ai][0][m][n][j], up = acc[ai][1][m][n][j]; hv[n * 4 + j] = g * __builtin_amdgcn_rcpf(1.f + __expf(-g)) * up; }
                u32x4 w; w.x = cvt_pk_bf16(hv[0], hv[1]); w.y = cvt_pk_bf16(hv[2], hv[3]); w.z = cvt_pk_bf16(hv[4], hv[5]); w.w = cvt_pk_bf16(hv[6], hv[7]);
                *(u32x4*)(O + (size_t)(row0 + ai * HALF + m * 16) * 2816 + col0) = w;
            }
    }
};
__device__ __forceinline__ unsigned pk4_fp8(float a, float b, float c2, float d) {
    a = fminf(fmaxf(a, -448.f), 448.f); b = fminf(fmaxf(b, -448.f), 448.f); c2 = fminf(fmaxf(c2, -448.f), 448.f); d = fminf(fmaxf(d, -448.f), 448.f);
    unsigned w = 0; w = __builtin_amdgcn_cvt_pk_fp8_f32(a, b, w, false); w = __builtin_amdgcn_cvt_pk_fp8_f32(c2, d, w, true); return w;
}
struct EpiSwigluF8 {
    static constexpr bool PERM = true, AFTER_DRAIN = false;
    unsigned char* O;
    __device__ __forceinline__ void operator()(const f32x4 (&acc)[2][2][4][2], const Unit& u, int wr, int wc, int fr, int fq) const {
        const int row0 = u.pm * BM + wr * 64 + fr, col0 = u.pn * HALF + wc * 32 + 8 * fq;
#pragma unroll
        for (int ai = 0; ai < 2; ++ai)
#pragma unroll
            for (int m = 0; m < 4; ++m) {
                float hv[8];
#pragma unroll
                for (int n = 0; n < 2; ++n)
#pragma unroll
                    for (int j = 0; j < 4; ++j) { const float g = acc[ai][0][m][n][j], up = acc[ai][1][m][n][j]; hv[n * 4 + j] = g * __builtin_amdgcn_rcpf(1.f + __expf(-g)) * up; }
                typedef unsigned u32x2 __attribute__((ext_vector_type(2)));
                u32x2 w; w.x = pk4_fp8(hv[0], hv[1], hv[2], hv[3]); w.y = pk4_fp8(hv[4], hv[5], hv[6], hv[7]);
                *(u32x2*)(O + (size_t)(row0 + ai * HALF + m * 16) * 2816 + col0) = w;
            }
    }
};
struct EpiSlots {
    static constexpr bool PERM = true, AFTER_DRAIN = false;
    bf16_t* S; const float* roww;
    __device__ __forceinline__ void operator()(const f32x4 (&acc)[2][2][4][2], const Unit& u, int wr, int wc, int fr, int fq) const {
        const int row0 = u.pm * BM + wr * 64 + fr, col0 = u.pn * BM + wc * 32 + 8 * fq;
#pragma unroll
        for (int ai = 0; ai < 2; ++ai)
#pragma unroll
            for (int m = 0; m < 4; ++m) { const int row = row0 + ai * HALF + m * 16; const float w = roww[row]; bf16_t* rowp = S + (size_t)row * 1024 + col0;
#pragma unroll
                for (int bj = 0; bj < 2; ++bj) { const f32x4 v0 = acc[ai][bj][m][0] * w, v1 = acc[ai][bj][m][1] * w;
                    u32x4 q; q.x = cvt_pk_bf16(v0[0], v0[1]); q.y = cvt_pk_bf16(v0[2], v0[3]); q.z = cvt_pk_bf16(v1[0], v1[1]); q.w = cvt_pk_bf16(v1[2], v1[3]);
                    *(u32x4*)(rowp + bj * HALF) = q; } }
    }
};
struct EpiPartial {
    static constexpr bool PERM = false, AFTER_DRAIN = false;
    float* P; const float* gmod; int goff;
    __device__ __forceinline__ void operator()(const f32x4 (&acc)[2][2][4][2], const Unit& u, int wr, int wc, int fr, int fq) const {
        const int row0 = u.pm * BM + wr * 64 + fr, col0 = u.pn * BM + wc * 32 + 4 * fq;
        f32x4 gv[2][2];
#pragma unroll
        for (int bj = 0; bj < 2; ++bj)
#pragma unroll
            for (int n = 0; n < 2; ++n) gv[bj][n] = *(const f32x4*)(gmod + 4 * 6144 + goff + col0 + bj * HALF + n * 16);
        float* base = P + (size_t)u.ks * 1024 * 1024;
#pragma unroll
        for (int ai = 0; ai < 2; ++ai)
#pragma unroll
            for (int m = 0; m < 4; ++m) { float* rowp = base + (size_t)(row0 + ai * HALF + m * 16) * 1024 + col0;
#pragma unroll
                for (int bj = 0; bj < 2; ++bj)
#pragma unroll
                    for (int n = 0; n < 2; ++n) *(f32x4*)(rowp + bj * HALF + n * 16) = gv[bj][n] * acc[ai][bj][m][n]; }
    }
};
struct SplitOrder {
    int nS, G, c;
    __device__ void init(int nS_, int G_, int c_) { nS = nS_; G = G_; c = c_; }
    __device__ bool next(int i, Unit& u) const { const int L = i * G + c; if (L >= 16 * nS) return false; u.ks = L % nS; const int t = L / nS; u.pm = t >> 2; u.pn = t & 3; return true; }
    __device__ __forceinline__ void a_ready(const Unit&) const {}
    __device__ __forceinline__ void done(const Unit&) const {}
    __device__ __forceinline__ const bf16_t* bt(const Gemm& g, const Unit&) const { return g.Bt; }
};
struct MoeOrder {
    StaticOrder so; const int* tile_e; size_t estride;
    __device__ void init(int T, int N, int G, int c, const int* te, size_t es) { so.init(T * BM, N, G, c); tile_e = te; estride = es; }
    __device__ bool next(int i, Unit& u) const { return so.next(i, u); }
    __device__ __forceinline__ void a_ready(const Unit&) const {}
    __device__ __forceinline__ void done(const Unit&) const {}
    __device__ __forceinline__ const bf16_t* bt(const Gemm& g, const Unit& u) const { const int e = __builtin_amdgcn_readfirstlane(tile_e[u.pm]); return g.Bt + (size_t)e * estride; }
};
}

struct Ctx {
    LAS unsigned char* lds;
    int tid, lane, wave, G, bx, gw, NGW, gtid, NT;
    unsigned char* ws;
    const float* in[21];
};
#define WSP(T, off) ((T*)(C.ws + (off)))

template <bool ILV>
__device__ __forceinline__ void transpose_item(const float* W, int K, int N, bf16* WT, LAS float* scr, int item, int lane) {
    const int nblk = N / 32, kb = item / nblk, nb = item % nblk, k0 = 64 * kb, n0 = 32 * nb;
    int drow = n0;
    if (ILV) drow = (n0 < DFF) ? (n0 / 128) * 256 + (n0 % 128) : ((n0 - DFF) / 128) * 256 + 128 + ((n0 - DFF) % 128);
#pragma unroll 8
    for (int i = 0; i < 32; ++i) { const int kk = 2 * i + (lane >> 5); scr[kk * 33 + (lane & 31)] = __builtin_nontemporal_load(&W[(size_t)(k0 + kk) * N + n0 + (lane & 31)]); }
    LDS_WAIT(); asm volatile("" ::: "memory");
    const int c = lane & 7;
#pragma unroll
    for (int j = 0; j < 4; ++j) { const int n = (lane >> 3) + 8 * j; const LAS float* s = scr + (8 * c) * 33 + n;
        v4u o; o.x = pk2(s[0 * 33], s[1 * 33]); o.y = pk2(s[2 * 33], s[3 * 33]); o.z = pk2(s[4 * 33], s[5 * 33]); o.w = pk2(s[6 * 33], s[7 * 33]);
        *(v4u*)(WT + (size_t)(drow + n) * K + k0 + 8 * c) = o; }
    LDS_WAIT(); asm volatile("" ::: "memory");
}
template <bool ILV>
__device__ __forceinline__ void transpose_item_f8(const float* W, int K, int N, unsigned char* WT, LAS float* scr, int item, int lane) {
    const int nblk = N / 32, kb = item / nblk, nb = item % nblk, k0 = 64 * kb, n0 = 32 * nb;
    int drow = n0;
    if (ILV) drow = (n0 < DFF) ? (n0 / 128) * 256 + (n0 % 128) : ((n0 - DFF) / 128) * 256 + 128 + ((n0 - DFF) % 128);
#pragma unroll 8
    for (int i = 0; i < 32; ++i) { const int kk = 2 * i + (lane >> 5); scr[kk * 33 + (lane & 31)] = __builtin_nontemporal_load(&W[(size_t)(k0 + kk) * N + n0 + (lane & 31)]); }
    LDS_WAIT(); asm volatile("" ::: "memory");
    const int c = lane & 7;
#pragma unroll
    for (int j = 0; j < 4; ++j) { const int n = (lane >> 3) + 8 * j; const LAS float* s = scr + (8 * c) * 33 + n;
        v2u o; o.x = pg8::pk4_fp8(s[0 * 33] * 64.f, s[1 * 33] * 64.f, s[2 * 33] * 64.f, s[3 * 33] * 64.f); o.y = pg8::pk4_fp8(s[4 * 33] * 64.f, s[5 * 33] * 64.f, s[6 * 33] * 64.f, s[7 * 33] * 64.f);
        *(v2u*)(WT + (size_t)(drow + n) * K + k0 + 8 * c) = o; }
    LDS_WAIT(); asm volatile("" ::: "memory");
}
struct ItemDesc { const float* W; unsigned char* WT; int K, N, k0, n0, drow, f8; };
__device__ __forceinline__ ItemDesc item_desc(const Ctx& C, int it) {
    const float* w_in = C.in[8]; const float* w_out = C.in[9]; const float* ffn_in = C.in[14]; const float* ffn_out = C.in[15]; const float* moe_in = C.in[18]; const float* moe_out = C.in[19];
    constexpr int I_WIN = 16 * (NPROJ / 32), I_WOUT = 16 * 32, I_FIN = 16 * (2 * DFF / 32), I_FOUT = (DFF / 64) * 32;
    ItemDesc d; int r = it, item, ilv = 0; d.f8 = 0;
    if (r < 2 * I_WIN) { const int l = r / I_WIN; d.W = w_in + (size_t)l * D * NPROJ; d.K = D; d.N = NPROJ; d.WT = (unsigned char*)(WSP(bf16, WS_WIN) + (size_t)l * NPROJP * D); item = r % I_WIN; }
    else if ((r -= 2 * I_WIN) < 2 * I_WOUT) { const int l = r / I_WOUT; d.W = w_out + (size_t)l * D * D; d.K = D; d.N = D; d.WT = (unsigned char*)(WSP(bf16, WS_WOUT) + (size_t)l * D * D); item = r % I_WOUT; }
    else if ((r -= 2 * I_WOUT) < I_FIN) { d.W = ffn_in; d.K = D; d.N = 2 * DFF; d.WT = (unsigned char*)WSP(bf16, WS_FIN); item = r; ilv = 1; }
    else if ((r -= I_FIN) < I_FOUT) { d.W = ffn_out; d.K = DFF; d.N = D; d.WT = (unsigned char*)WSP(bf16, WS_FOUT); item = r; }
    else if ((r -= I_FOUT) < NE * I_FIN) { const int e = r / I_FIN; d.W = moe_in + (size_t)e * D * 2 * DFF; d.K = D; d.N = 2 * DFF; d.WT = WSP(unsigned char, WS_MIN) + (size_t)e * 2 * DFF * D; item = r % I_FIN; ilv = 1; d.f8 = 1; }
    else { r -= NE * I_FIN; const int e = r / I_FOUT; d.W = moe_out + (size_t)e * DFF * D; d.K = DFF; d.N = D; d.WT = WSP(unsigned char, WS_MOUT) + (size_t)e * D * DFF; item = r % I_FOUT; d.f8 = 1; }
    const int nblk = d.N / 32, kb = item / nblk, nb = item % nblk; d.k0 = 64 * kb; d.n0 = 32 * nb;
    d.drow = ilv ? ((d.n0 < DFF) ? (d.n0 / 128) * 256 + (d.n0 % 128) : ((d.n0 - DFF) / 128) * 256 + 128 + ((d.n0 - DFF) % 128)) : d.n0;
    return d;
}
__device__ __forceinline__ void item_load(const ItemDesc& d, int lane, float (&v)[32]) {
    const float* p = d.W + (size_t)(d.k0 + (lane >> 5)) * d.N + d.n0 + (lane & 31);
#pragma unroll
    for (int i = 0; i < 32; ++i) v[i] = __builtin_nontemporal_load(p + (size_t)(2 * i) * d.N);
}
__device__ __forceinline__ void item_finish(const ItemDesc& d, int lane, LAS float* scr, const float (&v)[32]) {
#pragma unroll
    for (int i = 0; i < 32; ++i) scr[(2 * i + (lane >> 5)) * 33 + (lane & 31)] = v[i];
    LDS_WAIT(); asm volatile("" ::: "memory");
    const int c = lane & 7;
    if (d.f8) {
#pragma unroll
        for (int j = 0; j < 4; ++j) { const int n = (lane >> 3) + 8 * j; const LAS float* s = scr + (8 * c) * 33 + n;
            v2u o; o.x = pg8::pk4_fp8(s[0 * 33] * 64.f, s[1 * 33] * 64.f, s[2 * 33] * 64.f, s[3 * 33] * 64.f); o.y = pg8::pk4_fp8(s[4 * 33] * 64.f, s[5 * 33] * 64.f, s[6 * 33] * 64.f, s[7 * 33] * 64.f);
            *(v2u*)(d.WT + (size_t)(d.drow + n) * d.K + d.k0 + 8 * c) = o; }
    } else {
#pragma unroll
        for (int j = 0; j < 4; ++j) { const int n = (lane >> 3) + 8 * j; const LAS float* s = scr + (8 * c) * 33 + n;
            v4u o; o.x = pk2(s[0 * 33], s[1 * 33]); o.y = pk2(s[2 * 33], s[3 * 33]); o.z = pk2(s[4 * 33], s[5 * 33]); o.w = pk2(s[6 * 33], s[7 * 33]);
            *(v4u*)((bf16*)d.WT + (size_t)(d.drow + n) * d.K + d.k0 + 8 * c) = o; }
    }
    LDS_WAIT(); asm volatile("" ::: "memory");
}
__device__ __forceinline__ void p_prologue(const Ctx& C) {
    const float* cvec = C.in[1]; const float* cctx = C.in[3]; const float* ada_w = C.in[4]; const float* ada_b = C.in[5];
    for (int task = C.G - 1 - C.bx; task < 48; task += C.G) {
        const int layer = task / 24, cg = task % 24, col = 256 * cg + 4 * C.lane;
        LAS float* stab = (LAS float*)(C.lds + RING_OFF + 49152);
        __syncthreads();
        for (int i = C.tid; i < 5 * D; i += NTHR) { const int r = i >> 10, k = i & 1023; stab[i] = siluf((r < 4) ? cvec[r * D + k] : cctx[k]); }
        __syncthreads();
        f32x4 acc[5];
#pragma unroll
        for (int r = 0; r < 5; ++r) acc[r] = (f32x4){0.f, 0.f, 0.f, 0.f};
#pragma unroll 16
        for (int kk = 0; kk < 128; ++kk) {
            const int k = 128 * C.wave + kk;
            const f32x4 w = __builtin_nontemporal_load((const f32x4*)(ada_w + ((size_t)layer * D + k) * 6144 + col));
#pragma unroll
            for (int r = 0; r < 5; ++r) acc[r] = acc[r] + w * stab[r * D + k];
        }
        __syncthreads();
        LAS float* red = (LAS float*)(C.lds + RING_OFF);
#pragma unroll
        for (int r = 0; r < 5; ++r) *(LAS f32x4*)(red + (C.wave * 5 + r) * 256 + 4 * C.lane) = acc[r];
        __syncthreads();
        for (int o = C.tid; o < 5 * 256; o += NTHR) {
            const int r = o >> 8, cc = o & 255;
            float s = ada_b[layer * 6144 + 256 * cg + cc];
#pragma unroll
            for (int w = 0; w < 8; ++w) s += red[(w * 5 + r) * 256 + cc];
            WSP(float, WS_MOD)[(layer * 5 + r) * 6144 + 256 * cg + cc] = s;
        }
        __syncthreads();
    }
    LAS float* scr = (LAS float*)(C.lds + RING_OFF + C.wave * 16384);
    constexpr int NITEMS = 2 * (16 * (NPROJ / 32)) + 2 * (16 * 32) + 16 * (2 * DFF / 32) + (DFF / 64) * 32 + NE * (16 * (2 * DFF / 32) + (DFF / 64) * 32);
    {
        float va[32], vb[32];
        const int nmod = (C.G > 96) ? 48 : 0, first_mod = C.G - nmod;
        const int vw = (C.bx < first_mod) ? C.gw : ((C.wave < 6) ? first_mod * NWAVES + (C.bx - first_mod) * 6 + C.wave : NITEMS), nvw = first_mod * NWAVES + nmod * 6;
        int it0 = vw;
        if (it0 < NITEMS) {
            ItemDesc d0 = item_desc(C, it0), d1 = d0; item_load(d0, C.lane, va);
            for (;;) {
                const int it1 = it0 + nvw; const bool h1 = it1 < NITEMS;
                if (h1) { d1 = item_desc(C, it1); item_load(d1, C.lane, vb); }
                item_finish(d0, C.lane, scr, va);
                if (!h1) break;
                it0 = it1 + nvw; const bool h0 = it0 < NITEMS;
                if (h0) { d0 = item_desc(C, it0); item_load(d0, C.lane, va); }
                item_finish(d1, C.lane, scr, vb);
                if (!h0) break;
            }
        }
    }
    for (int idx = C.gtid; idx < 1024; idx += C.NT) {
        const int pos = idx >> 4, i = idx & 15;
        const float inv = powf(10000.0f, -(float)i / 16.0f), ang = (float)pos * inv;
        WSP(float, WS_ROPE)[idx] = cosf(ang); WSP(float, WS_ROPE)[1024 + idx] = sinf(ang);
    }
}
template <int NP>
__device__ __forceinline__ void norm_row(const float* hrow, const f32x4 (&gs)[4], const f32x4 (&s0v)[4], bf16* orow, int lane, f32x4 (&a)[4], const float* prow = nullptr, float* hout = nullptr) {
    float ss = 0.f;
#pragma unroll
    for (int j = 0; j < 4; ++j) { a[j] = *(const f32x4*)(hrow + 4 * lane + 256 * j);
        if (NP > 0) {
#pragma unroll
            for (int p = 0; p < NP; ++p) a[j] = a[j] + *(const f32x4*)(prow + (size_t)p * 1024 * 1024 + 4 * lane + 256 * j);
            if (hout) *(f32x4*)(hout + 4 * lane + 256 * j) = a[j]; }
        ss += (a[j].x * a[j].x + a[j].y * a[j].y) + (a[j].z * a[j].z + a[j].w * a[j].w); }
    const float rstd = 1.0f / sqrtf(wave_sum(ss) * (1.0f / D) + EPS);
#pragma unroll
    for (int j = 0; j < 4; ++j) {
        const int c = 4 * lane + 256 * j;
        a[j] = (a[j] * rstd) * gs[j] + s0v[j];
        v2u o; o.x = pg8::cvt_pk_bf16(a[j].x, a[j].y); o.y = pg8::cvt_pk_bf16(a[j].z, a[j].w);
        *(v2u*)(orow + c) = o;
    }
}
__device__ __forceinline__ void norm_vectors(const float* gvec, const float* sh, const float* sc, int lane, f32x4 (&gs)[4], f32x4 (&s0v)[4]) {
#pragma unroll
    for (int j = 0; j < 4; ++j) { const int c = 4 * lane + 256 * j; gs[j] = *(const f32x4*)(gvec + c) * (*(const f32x4*)(sc + c) + 1.0f); s0v[j] = *(const f32x4*)(sh + c); }
}
template <bool ROUTER, int NPC>
__device__ __forceinline__ void p_norm(const Ctx& C, int layer, int which, bool do_ctx, bool from_input, bool ctx_from_input, bool ctx_write_h) {
    const float* gvec = (which ? C.in[7] : C.in[6]) + layer * D;
    const float* mod = WSP(float, WS_MOD) + layer * 30720;
    const int o_sh = which ? 3 * D : 0, o_sc = which ? 4 * D : D;
    f32x4 rwr[4][4][2]; float rbr[8];
    if (ROUTER) { const float* rw = C.in[16]; const float* rb = C.in[17];
#pragma unroll
        for (int jj = 0; jj < 4; ++jj)
#pragma unroll
            for (int i = 0; i < 4; ++i) { const int k = 4 * C.lane + 256 * jj + i; rwr[jj][i][0] = *(const f32x4*)(rw + k * 8); rwr[jj][i][1] = *(const f32x4*)(rw + k * 8 + 4); }
#pragma unroll
        for (int e = 0; e < 8; ++e) rbr[e] = rb[e]; }
    LAS int* lcnt = (LAS int*)(C.lds + RING_OFF);
    for (int blk = C.bx; blk < 256; blk += C.G) {
        if (ROUTER) { if (C.tid < 8) lcnt[C.tid] = 0; __syncthreads(); }
        f32x4 gs[4], s0v[4];
        { const int b = (64 * blk) >> 12; norm_vectors(gvec, mod + b * 6144 + o_sh, mod + b * 6144 + o_sc, C.lane, gs, s0v); }
        for (int j = 0; j < 8; ++j) {
            const int m = 64 * blk + 8 * C.wave + j;
            f32x4 a[4];
            norm_row<0>((from_input ? C.in[0] : WSP(float, WS_H)) + (size_t)m * D, gs, s0v, WSP(bf16, WS_A) + (size_t)m * D, C.lane, a);
            if (ROUTER) {
                float lg[8];
#pragma unroll
                for (int e = 0; e < 8; ++e) lg[e] = 0.f;
#pragma unroll
                for (int jj = 0; jj < 4; ++jj)
#pragma unroll
                    for (int i = 0; i < 4; ++i) {
                        const float av = a[jj][i]; const f32x4 w0 = rwr[jj][i][0], w1 = rwr[jj][i][1];
                        lg[0] += av * w0.x; lg[1] += av * w0.y; lg[2] += av * w0.z; lg[3] += av * w0.w;
                        lg[4] += av * w1.x; lg[5] += av * w1.y; lg[6] += av * w1.z; lg[7] += av * w1.w;
                    }
                float r4[4], r2[2], r1;
#pragma unroll
                for (int e = 0; e < 4; ++e) { const bool hi = (C.lane & 1) != 0; const float keep = hi ? lg[e + 4] : lg[e], send = hi ? lg[e] : lg[e + 4]; r4[e] = keep + __shfl_xor(send, 1); }
#pragma unroll
                for (int e = 0; e < 2; ++e) { const bool hi = (C.lane & 2) != 0; const float keep = hi ? r4[e + 2] : r4[e], send = hi ? r4[e] : r4[e + 2]; r2[e] = keep + __shfl_xor(send, 2); }
                { const bool hi = (C.lane & 4) != 0; const float keep = hi ? r2[1] : r2[0], send = hi ? r2[0] : r2[1]; r1 = keep + __shfl_xor(send, 4); }
                r1 += __shfl_xor(r1, 8); r1 += __shfl_xor(r1, 16); r1 += __shfl_xor(r1, 32);
#pragma unroll
                for (int e = 0; e < 8; ++e) { const int src = ((e >> 2) & 1) | (((e >> 1) & 1) << 1) | ((e & 1) << 2); lg[e] = __shfl(r1, src) + rbr[e]; }
                int e1 = 0; float v1 = lg[0];
#pragma unroll
                for (int e = 1; e < 8; ++e) if (lg[e] > v1) { v1 = lg[e]; e1 = e; }
                int e2 = -1; float v2 = -3.0e38f;
#pragma unroll
                for (int e = 0; e < 8; ++e) if (e != e1 && lg[e] > v2) { v2 = lg[e]; e2 = e; }
                const float ex = __expf(v2 - v1), w1v = 1.0f / (1.0f + ex), w2v = ex * w1v;
                if (C.lane == 0) {
                    WSP(int, WS_TOKE)[m] = e1 | (e2 << 8);
                    WSP(float, WS_TOKW)[2 * m] = w1v; WSP(float, WS_TOKW)[2 * m + 1] = w2v;
                    atomicAdd((int*)(lcnt + e1), 1); atomicAdd((int*)(lcnt + e2), 1);
                }
            }
        }
        if (ROUTER) { __syncthreads(); if (C.tid < 8) WSP(int, WS_CNT)[blk * 8 + C.tid] = lcnt[C.tid]; __syncthreads(); }
    }
    if (do_ctx) {
        f32x4 gsc[4], s0c[4];
        norm_vectors(gvec, mod + 4 * 6144 + o_sh, mod + 4 * 6144 + o_sc, C.lane, gsc, s0c);
        for (int cm = C.gw; cm < RCTX; cm += C.NGW) {
            const int m = RLAT + cm; f32x4 a[4];
            norm_row<NPC>(ctx_from_input ? C.in[2] + (size_t)cm * D : WSP(float, WS_H) + (size_t)m * D, gsc, s0c, WSP(bf16, WS_A) + (size_t)m * D, C.lane, a, WSP(float, WS_PART) + (size_t)cm * D, ctx_write_h ? WSP(float, WS_H) + (size_t)m * D : nullptr);
        }
    }
}
typedef short bf16x8 __attribute__((ext_vector_type(8)));
constexpr float LOG2E = 1.4426950408889634f;
constexpr int VTL_STRIDE = 1040, VTC_STRIDE = 528;
constexpr int NA_VTL = 0, NA_VTC = 64 * VTL_STRIDE, NA_RPB = NA_VTC + 64 * VTC_STRIDE, NA_XCH = 102400;
static_assert(NA_RPB + 465 * 4 <= NA_XCH && NA_XCH + 4 * 64 * 18 * 4 <= RING_BYTES, "NA LDS map");
__device__ __forceinline__ unsigned cvtpk(float lo, float hi) { unsigned r; asm volatile("v_cvt_pk_bf16_f32 %0, %1, %2" : "=v"(r) : "v"(lo), "v"(hi)); return r; }

template <bool LOCAL, int NT, int KT0 = 0, int KT1 = NT>
__device__ __forceinline__ void load_kfrags(bf16x8 (&kf)[NT][2], const bf16* Kbase, int krow0, int lane) {
    const int n = lane & 15, g = lane >> 4;
#pragma unroll
    for (int kt = KT0; kt < KT1; ++kt) {
        const int krow = LOCAL ? krow0 + (kt >> 1) * 64 + (kt & 1) * 16 + n : krow0 + 16 * kt + n;
        const bf16x8* kp = (const bf16x8*)(Kbase + (size_t)krow * NPROJP + 8 * g);
        kf[kt][0] = kp[0]; kf[kt][1] = kp[4];
    }
}
template <bool LOCAL, int NT>
__device__ __forceinline__ void attn_wave_core(const bf16x8 (&kfA)[8][2], const bf16* Kbase, int krow0, const bf16x8 (&qf)[2], LAS const unsigned char* vt, int vstride,
                                               LAS const float* rpb, int r, int r0, int qc, int cbase, float& m_out, float& l_out, f32x4 (&o)[4], int lane) {
    const int n = lane & 15, g = lane >> 4;
    f32x4 s[NT];
#pragma unroll
    for (int kt = 0; kt < 8; ++kt) {
        f32x4 acc = {0.f, 0.f, 0.f, 0.f};
        acc = __builtin_amdgcn_mfma_f32_16x16x32_bf16(kfA[kt][0], qf[0], acc, 0, 0, 0);
        acc = __builtin_amdgcn_mfma_f32_16x16x32_bf16(kfA[kt][1], qf[1], acc, 0, 0, 0);
        s[kt] = acc;
    }
    if constexpr (NT > 8) {
        __builtin_amdgcn_sched_barrier(0);
        bf16x8 kfB[NT][2];
        load_kfrags<LOCAL, NT, 8, NT>(kfB, Kbase, krow0, lane);
#pragma unroll
        for (int kt = 8; kt < NT; ++kt) {
            f32x4 acc = {0.f, 0.f, 0.f, 0.f};
            acc = __builtin_amdgcn_mfma_f32_16x16x32_bf16(kfB[kt][0], qf[0], acc, 0, 0, 0);
            acc = __builtin_amdgcn_mfma_f32_16x16x32_bf16(kfB[kt][1], qf[1], acc, 0, 0, 0);
            s[kt] = acc;
        }
        __builtin_amdgcn_sched_barrier(0);
    }
    const float SC = 0.125f * LOG2E;
    const int c0 = min(max(qc - 8, 0), 48);
    float mx = -1.0e30f;
#pragma unroll
    for (int kt = 0; kt < NT; ++kt)
#pragma unroll
        for (int reg = 0; reg < 4; ++reg) {
            float v = s[kt][reg] * SC;
            if (LOCAL) {
                const int i = kt >> 1, kc = cbase + 16 * (kt & 1) + 4 * g + reg;
                const int dr = r0 + i - r + 7, dc = min(max(kc - qc, -15), 15) + 15;
                const float bias = rpb[dr * 31 + dc];
                v = (kc >= c0 && kc < c0 + 16) ? v + bias : -1.0e30f;
            }
            s[kt][reg] = v; mx = fmaxf(mx, v);
        }
    mx = fmaxf(mx, __shfl_xor(mx, 16)); mx = fmaxf(mx, __shfl_xor(mx, 32));
    float l = 0.f;
#pragma unroll
    for (int kt = 0; kt < NT; ++kt)
#pragma unroll
        for (int reg = 0; reg < 4; ++reg) { const float p = __builtin_amdgcn_exp2f(s[kt][reg] - mx); s[kt][reg] = p; l += p; }
    l += __shfl_xor(l, 16); l += __shfl_xor(l, 32);
#pragma unroll
    for (int dt = 0; dt < 4; ++dt) o[dt] = (f32x4){0.f, 0.f, 0.f, 0.f};
#pragma unroll
    for (int u = 0; u < NT / 2; ++u) {
        v4u pw; pw.x = cvtpk(s[2 * u][0], s[2 * u][1]); pw.y = cvtpk(s[2 * u][2], s[2 * u][3]); pw.z = cvtpk(s[2 * u + 1][0], s[2 * u + 1][1]); pw.w = cvtpk(s[2 * u + 1][2], s[2 * u + 1][3]);
        const bf16x8 pb = __builtin_bit_cast(bf16x8, pw);
        const int slotA = LOCAL ? ((r0 + u) & 7) * 64 + cbase + 4 * g : 32 * u + 4 * g, slotB = slotA + 16;
#pragma unroll
        for (int dt = 0; dt < 4; ++dt) {
            LAS const unsigned char* rowp = vt + (16 * dt + n) * vstride;
            const v2u a_lo = *(LAS const v2u*)(rowp + slotA * 2), a_hi = *(LAS const v2u*)(rowp + slotB * 2);
            v4u aw; aw.x = a_lo.x; aw.y = a_lo.y; aw.z = a_hi.x; aw.w = a_hi.y;
            o[dt] = __builtin_amdgcn_mfma_f32_16x16x32_bf16(__builtin_bit_cast(bf16x8, aw), pb, o[dt], 0, 0, 0);
        }
    }
    m_out = mx; l_out = l;
}
__device__ __forceinline__ void attn_wave_mixed(const bf16x8 (&kfA)[8][2], const bf16* Kbase, int kcrow0, const bf16x8 (&qf)[2], LAS const unsigned char* vtl, LAS const unsigned char* vtc,
                                                LAS const float* rpb, int part, int r, int r0, int qc, int cbase, float& m_out, float& l_out, f32x4 (&o)[4], int lane) {
    const int n = lane & 15, g = lane >> 4;
    f32x4 s[16];
#pragma unroll
    for (int kt = 0; kt < 8; ++kt) {
        f32x4 acc = {0.f, 0.f, 0.f, 0.f};
        acc = __builtin_amdgcn_mfma_f32_16x16x32_bf16(kfA[kt][0], qf[0], acc, 0, 0, 0);
        acc = __builtin_amdgcn_mfma_f32_16x16x32_bf16(kfA[kt][1], qf[1], acc, 0, 0, 0);
        s[kt] = acc;
    }
    __builtin_amdgcn_sched_barrier(0);
    {
        bf16x8 kfB[8][2];
        load_kfrags<false, 8>(kfB, Kbase, kcrow0, lane);
#pragma unroll
        for (int kt = 0; kt < 8; ++kt) {
            f32x4 acc = {0.f, 0.f, 0.f, 0.f};
            acc = __builtin_amdgcn_mfma_f32_16x16x32_bf16(kfB[kt][0], qf[0], acc, 0, 0, 0);
            acc = __builtin_amdgcn_mfma_f32_16x16x32_bf16(kfB[kt][1], qf[1], acc, 0, 0, 0);
            s[8 + kt] = acc;
        }
    }
    __builtin_amdgcn_sched_barrier(0);
    const float SC = 0.125f * LOG2E;
    const int c0 = min(max(qc - 8, 0), 48);
    float mx = -1.0e30f;
#pragma unroll
    for (int kt = 0; kt < 16; ++kt)
#pragma unroll
        for (int reg = 0; reg < 4; ++reg) {
            float v = s[kt][reg] * SC;
            if (kt < 8) {
                const int i = 4 * part + (kt >> 1), kc = cbase + 16 * (kt & 1) + 4 * g + reg;
                const int dr = r0 + i - r + 7, dc = min(max(kc - qc, -15), 15) + 15;
                const float bias = rpb[dr * 31 + dc];
                v = (kc >= c0 && kc < c0 + 16) ? v + bias : -1.0e30f;
            }
            s[kt][reg] = v; mx = fmaxf(mx, v);
        }
    mx = fmaxf(mx, __shfl_xor(mx, 16)); mx = fmaxf(mx, __shfl_xor(mx, 32));
    float l = 0.f;
#pragma unroll
    for (int kt = 0; kt < 16; ++kt)
#pragma unroll
        for (int reg = 0; reg < 4; ++reg) { const float p = __builtin_amdgcn_exp2f(s[kt][reg] - mx); s[kt][reg] = p; l += p; }
    l += __shfl_xor(l, 16); l += __shfl_xor(l, 32);
#pragma unroll
    for (int dt = 0; dt < 4; ++dt) o[dt] = (f32x4){0.f, 0.f, 0.f, 0.f};
#pragma unroll
    for (int u = 0; u < 8; ++u) {
        v4u pw; pw.x = cvtpk(s[2 * u][0], s[2 * u][1]); pw.y = cvtpk(s[2 * u][2], s[2 * u][3]); pw.z = cvtpk(s[2 * u + 1][0], s[2 * u + 1][1]); pw.w = cvtpk(s[2 * u + 1][2], s[2 * u + 1][3]);
        const bf16x8 pb = __builtin_bit_cast(bf16x8, pw);
        const bool loc = (u < 4);
        const int slotA = loc ? ((r0 + 4 * part + u) & 7) * 64 + cbase + 4 * g : 128 * part + 32 * (u - 4) + 4 * g, slotB = slotA + 16;
        LAS const unsigned char* vt = loc ? vtl : vtc; const int vstride = loc ? VTL_STRIDE : VTC_STRIDE;
#pragma unroll
        for (int dt = 0; dt < 4; ++dt) {
            LAS const unsigned char* rowp = vt + (16 * dt + n) * vstride;
            const v2u a_lo = *(LAS const v2u*)(rowp + slotA * 2), a_hi = *(LAS const v2u*)(rowp + slotB * 2);
            v4u aw; aw.x = a_lo.x; aw.y = a_lo.y; aw.z = a_hi.x; aw.w = a_hi.y;
            o[dt] = __builtin_amdgcn_mfma_f32_16x16x32_bf16(__builtin_bit_cast(bf16x8, aw), pb, o[dt], 0, 0, 0);
        }
    }
    m_out = mx; l_out = l;
}
template <int NCH>
__device__ __forceinline__ void vt_scatter(const bf16* vrow, int ch0, LAS unsigned char* vt, int vstride, int slot) {
    v4u x[NCH];
#pragma unroll
    for (int c = 0; c < NCH; ++c) x[c] = *(const v4u*)(vrow + 8 * (ch0 + c));
#pragma unroll
    for (int c = 0; c < NCH; ++c) {
        LAS unsigned char* p = vt + (8 * (ch0 + c)) * vstride + slot * 2;
        *(LAS unsigned short*)(p) = (unsigned short)(x[c].x & 0xffffu); *(LAS unsigned short*)(p + vstride) = (unsigned short)(x[c].x >> 16);
        *(LAS unsigned short*)(p + 2 * vstride) = (unsigned short)(x[c].y & 0xffffu); *(LAS unsigned short*)(p + 3 * vstride) = (unsigned short)(x[c].y >> 16);
        *(LAS unsigned short*)(p + 4 * vstride) = (unsigned short)(x[c].z & 0xffffu); *(LAS unsigned short*)(p + 5 * vstride) = (unsigned short)(x[c].z >> 16);
        *(LAS unsigned short*)(p + 6 * vstride) = (unsigned short)(x[c].w & 0xffffu); *(LAS unsigned short*)(p + 7 * vstride) = (unsigned short)(x[c].w >> 16);
    }
}
__device__ __forceinline__ void attn_merge_store(const Ctx& C, int part, int qb, float m, float l, f32x4 (&o)[4], int qrow0, int h) {
    LAS float* xch = (LAS float*)(C.lds + RING_OFF + NA_XCH) + (qb * 64 + C.lane) * 18;
    if (part == 1) {
        xch[0] = m; xch[1] = l;
#pragma unroll
        for (int dt = 0; dt < 4; ++dt) *(LAS f32x4*)(xch + 2 + 4 * dt) = o[dt];
    }
    __syncthreads();
    if (part == 0) {
        const float m2 = xch[0], l2 = xch[1];
        const float mt = fmaxf(m, m2), f1 = __builtin_amdgcn_exp2f(m - mt), f2 = __builtin_amdgcn_exp2f(m2 - mt);
        const float inv = 1.0f / (l * f1 + l2 * f2);
        const int n = C.lane & 15, g = C.lane >> 4;
        bf16* yp = WSP(bf16, WS_YMIX) + (size_t)(qrow0 + n) * D + 640 + 64 * h + 4 * g;
#pragma unroll
        for (int dt = 0; dt < 4; ++dt) {
            const f32x4 o2 = *(LAS f32x4*)(xch + 2 + 4 * dt);
            const f32x4 v = (o[dt] * f1 + o2 * f2) * inv;
            v2u w; w.x = cvtpk(v[0], v[1]); w.y = cvtpk(v[2], v[3]);
            *(v2u*)(yp + 16 * dt) = w;
        }
    }
}
__device__ __forceinline__ void na_band(const Ctx& C, int layer, int u0, int nu) {
    const bf16* PROJ = WSP(bf16, WS_PROJ);
    LAS unsigned char* vtl = C.lds + RING_OFF + NA_VTL; LAS unsigned char* vtc = C.lds + RING_OFF + NA_VTC; LAS float* rpb = (LAS float*)(C.lds + RING_OFF + NA_RPB);
    const int qb = C.wave & 3, part = C.wave >> 2, n = C.lane & 15, g = C.lane >> 4;
    const int cbase = (qb == 0) ? 0 : (qb == 1) ? 8 : (qb == 2) ? 24 : 32;
    int cur_bh = -1, have_hi = 0;
    for (int uu = 0; uu < nu; ++uu) {
        const int u = u0 + uu, bh = u >> 6, r = u & 63, b = bh / 6, h = bh % 6;
        const int r0 = min(max(r - 4, 0), 56);
        const int qrow0 = b * SEQ + r * 64 + 16 * qb;
        bf16x8 qf[2];
        { const bf16x8* qp = (const bf16x8*)(PROJ + (size_t)(qrow0 + n) * NPROJP + C_NQ + 64 * h + 8 * g); qf[0] = qp[0]; qf[1] = qp[4]; }
        bf16x8 kf[8][2];
        load_kfrags<true, 8, 0, 8>(kf, PROJ + C_NK + 64 * h, b * SEQ + (r0 + 4 * part) * 64 + cbase, C.lane);
        const bool newbh = (bh != cur_bh);
        const int lo = newbh ? r0 : max(r0, have_hi);
        const int vkey = C.tid & 63, vch = C.tid >> 6;
        v4u vpre = {0u, 0u, 0u, 0u};
        if (lo < r0 + 8) vpre = *(const v4u*)(PROJ + (size_t)(b * SEQ + (r0 + 7) * 64 + vkey) * NPROJP + C_NV + 64 * h + 8 * vch);
        __syncthreads();
        if (newbh) {
            vt_scatter<4>(PROJ + (size_t)(RLAT + b * CTXL + (C.tid & 255)) * NPROJP + C_NV + 64 * h, 4 * (C.tid >> 8), vtc, VTC_STRIDE, C.tid & 255);
            const float* rp = C.in[13] + (size_t)(layer * 6 + h) * 465; for (int i = C.tid; i < 465; i += NTHR) rpb[i] = rp[i] * LOG2E;
        }
        for (int row = lo; row < r0 + 8; ++row) {
            v4u x = vpre;
            if (row != r0 + 7) x = *(const v4u*)(PROJ + (size_t)(b * SEQ + row * 64 + vkey) * NPROJP + C_NV + 64 * h + 8 * vch);
            LAS unsigned char* p = vtl + (8 * vch) * VTL_STRIDE + ((row & 7) * 64 + vkey) * 2;
            *(LAS unsigned short*)(p) = (unsigned short)(x.x & 0xffffu); *(LAS unsigned short*)(p + VTL_STRIDE) = (unsigned short)(x.x >> 16);
            *(LAS unsigned short*)(p + 2 * VTL_STRIDE) = (unsigned short)(x.y & 0xffffu); *(LAS unsigned short*)(p + 3 * VTL_STRIDE) = (unsigned short)(x.y >> 16);
            *(LAS unsigned short*)(p + 4 * VTL_STRIDE) = (unsigned short)(x.z & 0xffffu); *(LAS unsigned short*)(p + 5 * VTL_STRIDE) = (unsigned short)(x.z >> 16);
            *(LAS unsigned short*)(p + 6 * VTL_STRIDE) = (unsigned short)(x.w & 0xffffu); *(LAS unsigned short*)(p + 7 * VTL_STRIDE) = (unsigned short)(x.w >> 16);
        }
        cur_bh = bh; have_hi = r0 + 8;
        __syncthreads();
        float m, l; f32x4 o[4];
        attn_wave_mixed(kf, PROJ + C_NK + 64 * h, RLAT + b * CTXL + 128 * part, qf, vtl, vtc, rpb, part, r, r0, 16 * qb + n, cbase, m, l, o, C.lane);
        attn_merge_store(C, part, qb, m, l, o, qrow0, h);
    }
}
constexpr int VT2_ROWS = 10, VT2_STRIDE = VT2_ROWS * 64 * 2 + 16;
constexpr int NA2_VTL = 0, NA2_VTC = 64 * VT2_STRIDE, NA2_RPB = NA2_VTC + 64 * VTC_STRIDE, NA2_KC = 120832, KC_STRIDE = 144;
static_assert(NA2_RPB + (480 + 465) * 4 <= NA2_KC && NA2_KC + 256 * KC_STRIDE <= RING_BYTES && (VT2_STRIDE / 4) % 64 == 4, "NA2 LDS map");
template <bool LOCAL>
__device__ __forceinline__ void na2_scores(f32x4 (&s)[16], const bf16x8 (&kfA)[8][2], const bf16* Kbase, int krow0, const bf16x8 (&qf)[2], int lane) {
#pragma unroll
    for (int kt = 0; kt < 8; ++kt) { f32x4 acc = {0.f, 0.f, 0.f, 0.f};
        acc = __builtin_amdgcn_mfma_f32_16x16x32_bf16(kfA[kt][0], qf[0], acc, 0, 0, 0); acc = __builtin_amdgcn_mfma_f32_16x16x32_bf16(kfA[kt][1], qf[1], acc, 0, 0, 0); s[kt] = acc; }
    __builtin_amdgcn_sched_barrier(0);
    bf16x8 kfB[16][2];
    load_kfrags<LOCAL, 16, 8, 16>(kfB, Kbase, krow0, lane);
#pragma unroll
    for (int kt = 8; kt < 16; ++kt) { f32x4 acc = {0.f, 0.f, 0.f, 0.f};
        acc = __builtin_amdgcn_mfma_f32_16x16x32_bf16(kfB[kt][0], qf[0], acc, 0, 0, 0); acc = __builtin_amdgcn_mfma_f32_16x16x32_bf16(kfB[kt][1], qf[1], acc, 0, 0, 0); s[kt] = acc; }
    __builtin_amdgcn_sched_barrier(0);
}
__device__ __forceinline__ void na_band2(const Ctx& C, int layer, int u0, int nu) {
    const bf16* PROJ = WSP(bf16, WS_PROJ);
    LAS unsigned char* vtl = C.lds + RING_OFF + NA2_VTL; LAS unsigned char* vtc = C.lds + RING_OFF + NA2_VTC; LAS float* rpb = (LAS float*)(C.lds + RING_OFF + NA2_RPB); LAS unsigned char* kcim = C.lds + RING_OFF + NA2_KC;
    const int qb = C.wave & 3, grp = C.wave >> 2, n = C.lane & 15, g = C.lane >> 4;
    const int cbase = (qb == 0) ? 0 : (qb == 1) ? 8 : (qb == 2) ? 24 : 32;
    const float SC = 0.125f * LOG2E;
    int boff[2][4]; float bscl[2][4];
    { const int qc = 16 * qb + n, c0 = min(max(qc - 8, 0), 48);
#pragma unroll
      for (int hh = 0; hh < 2; ++hh)
#pragma unroll
        for (int reg = 0; reg < 4; ++reg) { const int kcol = cbase + 16 * hh + 4 * g + reg; const bool ok = (kcol >= c0) && (kcol < c0 + 16);
            boff[hh][reg] = ok ? (min(max(kcol - qc, -15), 15) + 15) * 4 : 480 * 4; bscl[hh][reg] = ok ? SC : 0.f; } }
    int cur_bh = -1, have_hi = 0;
    for (int uu = 0; uu < nu; uu += 2) {
        const int ua = u0 + uu, bh = ua >> 6, ra = ua & 63, b = bh / 6, h = bh % 6;
        const int r0a = min(max(ra - 4, 0), 56), r0b = min(max(ra + 1 - 4, 0), 56);
        const int r = ra + grp, r0 = grp ? r0b : r0a;
        const int qrow0 = b * SEQ + r * 64 + 16 * qb;
        const bool newbh = (bh != cur_bh);
        const int lo = newbh ? r0a : max(r0a, have_hi), hi = r0b + 8;
        const int vkey = C.tid & 63, vch = C.tid >> 6;
        const v4u vpa = *(const v4u*)(PROJ + (size_t)(b * SEQ + (hi - 2) * 64 + vkey) * NPROJP + C_NV + 64 * h + 8 * vch);
        const v4u vpb = *(const v4u*)(PROJ + (size_t)(b * SEQ + (hi - 1) * 64 + vkey) * NPROJP + C_NV + 64 * h + 8 * vch);
        bf16x8 qf[2];
        { const bf16x8* qp = (const bf16x8*)(PROJ + (size_t)(qrow0 + n) * NPROJP + C_NQ + 64 * h + 8 * g); qf[0] = qp[0]; qf[1] = qp[4]; }
        bf16x8 kf[8][2];
        load_kfrags<true, 8, 0, 8>(kf, PROJ + C_NK + 64 * h, b * SEQ + r0 * 64 + cbase, C.lane);
        __syncthreads();
        if (newbh) {
            vt_scatter<4>(PROJ + (size_t)(RLAT + b * CTXL + (C.tid & 255)) * NPROJP + C_NV + 64 * h, 4 * (C.tid >> 8), vtc, VTC_STRIDE, C.tid & 255);
            const float* rp = C.in[13] + (size_t)(layer * 6 + h) * 465; for (int i = C.tid; i < 465; i += NTHR) rpb[i] = rp[i] * LOG2E;
            { const int key = C.tid & 255, c4 = 4 * (C.tid >> 8); const bf16* kp = PROJ + (size_t)(RLAT + b * CTXL + key) * NPROJP + C_NK + 64 * h + 8 * c4;
              v4u kx[4];
#pragma unroll
              for (int q = 0; q < 4; ++q) kx[q] = *(const v4u*)(kp + 8 * q);
#pragma unroll
              for (int q = 0; q < 4; ++q) *(LAS v4u*)(kcim + key * KC_STRIDE + 16 * (c4 + q)) = kx[q]; }
            for (int i = C.tid; i < 15 * 31; i += NTHR) rpb[480 + i] = -1.0e30f;
        }
        for (int row = lo; row < hi; ++row) {
            v4u x;
            if (row == hi - 2) x = vpa; else if (row == hi - 1) x = vpb; else x = *(const v4u*)(PROJ + (size_t)(b * SEQ + row * 64 + vkey) * NPROJP + C_NV + 64 * h + 8 * vch);
            LAS unsigned char* p = vtl + (8 * vch) * VT2_STRIDE + ((row % VT2_ROWS) * 64 + vkey) * 2;
            *(LAS unsigned short*)(p) = (unsigned short)(x.x & 0xffffu); *(LAS unsigned short*)(p + VT2_STRIDE) = (unsigned short)(x.x >> 16);
            *(LAS unsigned short*)(p + 2 * VT2_STRIDE) = (unsigned short)(x.y & 0xffffu); *(LAS unsigned short*)(p + 3 * VT2_STRIDE) = (unsigned short)(x.y >> 16);
            *(LAS unsigned short*)(p + 4 * VT2_STRIDE) = (unsigned short)(x.z & 0xffffu); *(LAS unsigned short*)(p + 5 * VT2_STRIDE) = (unsigned short)(x.z >> 16);
            *(LAS unsigned short*)(p + 6 * VT2_STRIDE) = (unsigned short)(x.w & 0xffffu); *(LAS unsigned short*)(p + 7 * VT2_STRIDE) = (unsigned short)(x.w >> 16);
        }
        cur_bh = bh; have_hi = hi;
        __syncthreads();
        f32x4 s[16];
        na2_scores<true>(s, kf, PROJ + C_NK + 64 * h, b * SEQ + r0 * 64 + cbase, qf, C.lane);
        float mx = -1.0e30f;
        { LAS const unsigned char* rb = (LAS const unsigned char*)rpb + (r0 - r + 7) * 124;
#pragma unroll
          for (int kt = 0; kt < 16; ++kt)
#pragma unroll
            for (int reg = 0; reg < 4; ++reg) {
                const float bias = *(LAS const float*)(rb + boff[kt & 1][reg] + (kt >> 1) * 124);
                const float v = s[kt][reg] * bscl[kt & 1][reg] + bias;
                s[kt][reg] = v; mx = fmaxf(mx, v);
            } }
        mx = fmaxf(mx, __shfl_xor(mx, 16)); mx = fmaxf(mx, __shfl_xor(mx, 32));
        float l = 0.f;
#pragma unroll
        for (int kt = 0; kt < 16; ++kt)
#pragma unroll
            for (int reg = 0; reg < 4; ++reg) { const float p = __builtin_amdgcn_exp2f(s[kt][reg] - mx); s[kt][reg] = p; l += p; }
        f32x4 o[4];
#pragma unroll
        for (int dt = 0; dt < 4; ++dt) o[dt] = (f32x4){0.f, 0.f, 0.f, 0.f};
#pragma unroll
        for (int u = 0; u < 8; ++u) {
            v4u pw; pw.x = cvtpk(s[2 * u][0], s[2 * u][1]); pw.y = cvtpk(s[2 * u][2], s[2 * u][3]); pw.z = cvtpk(s[2 * u + 1][0], s[2 * u + 1][1]); pw.w = cvtpk(s[2 * u + 1][2], s[2 * u + 1][3]);
            const bf16x8 pb = __builtin_bit_cast(bf16x8, pw);
            const int slotA = ((r0 + u) % VT2_ROWS) * 64 + cbase + 4 * g, slotB = slotA + 16;
#pragma unroll
            for (int dt = 0; dt < 4; ++dt) {
                LAS const unsigned char* rowp = vtl + (16 * dt + n) * VT2_STRIDE;
                const v2u a_lo = *(LAS const v2u*)(rowp + slotA * 2), a_hi = *(LAS const v2u*)(rowp + slotB * 2);
                v4u aw; aw.x = a_lo.x; aw.y = a_lo.y; aw.z = a_hi.x; aw.w = a_hi.y;
                o[dt] = __builtin_amdgcn_mfma_f32_16x16x32_bf16(__builtin_bit_cast(bf16x8, aw), pb, o[dt], 0, 0, 0);
            }
        }
#pragma unroll
        for (int kt = 0; kt < 16; ++kt) {
            LAS const unsigned char* kp = kcim + (16 * kt + n) * KC_STRIDE + 16 * g;
            const bf16x8 ka = *(LAS const bf16x8*)(kp), kb = *(LAS const bf16x8*)(kp + 64);
            f32x4 acc = {0.f, 0.f, 0.f, 0.f};
            acc = __builtin_amdgcn_mfma_f32_16x16x32_bf16(ka, qf[0], acc, 0, 0, 0); acc = __builtin_amdgcn_mfma_f32_16x16x32_bf16(kb, qf[1], acc, 0, 0, 0); s[kt] = acc;
        }
        float mx2 = -1.0e30f;
#pragma unroll
        for (int kt = 0; kt < 16; ++kt)
#pragma unroll
            for (int reg = 0; reg < 4; ++reg) { const float v = s[kt][reg] * SC; s[kt][reg] = v; mx2 = fmaxf(mx2, v); }
        mx2 = fmaxf(mx2, __shfl_xor(mx2, 16)); mx2 = fmaxf(mx2, __shfl_xor(mx2, 32));
        const float mt = fmaxf(mx, mx2), f1 = __builtin_amdgcn_exp2f(mx - mt);
        l *= f1;
#pragma unroll
        for (int dt = 0; dt < 4; ++dt) o[dt] = o[dt] * f1;
#pragma unroll
        for (int kt = 0; kt < 16; ++kt)
#pragma unroll
            for (int reg = 0; reg < 4; ++reg) { const float p = __builtin_amdgcn_exp2f(s[kt][reg] - mt); s[kt][reg] = p; l += p; }
        l += __shfl_xor(l, 16); l += __shfl_xor(l, 32);
#pragma unroll
        for (int u = 0; u < 8; ++u) {
            v4u pw; pw.x = cvtpk(s[2 * u][0], s[2 * u][1]); pw.y = cvtpk(s[2 * u][2], s[2 * u][3]); pw.z = cvtpk(s[2 * u + 1][0], s[2 * u + 1][1]); pw.w = cvtpk(s[2 * u + 1][2], s[2 * u + 1][3]);
            const bf16x8 pb = __builtin_bit_cast(bf16x8, pw);
            const int slotA = 32 * u + 4 * g, slotB = slotA + 16;
#pragma unroll
            for (int dt = 0; dt < 4; ++dt) {
                LAS const unsigned char* rowp = vtc + (16 * dt + n) * VTC_STRIDE;
                const v2u a_lo = *(LAS const v2u*)(rowp + slotA * 2), a_hi = *(LAS const v2u*)(rowp + slotB * 2);
                v4u aw; aw.x = a_lo.x; aw.y = a_lo.y; aw.z = a_hi.x; aw.w = a_hi.y;
                o[dt] = __builtin_amdgcn_mfma_f32_16x16x32_bf16(__builtin_bit_cast(bf16x8, aw), pb, o[dt], 0, 0, 0);
            }
        }
        const float inv = 1.0f / l;
        bf16* yp = WSP(bf16, WS_YMIX) + (size_t)(qrow0 + n) * D + 640 + 64 * h + 4 * g;
#pragma unroll
        for (int dt = 0; dt < 4; ++dt) { const f32x4 v = o[dt] * inv; v2u w; w.x = cvtpk(v[0], v[1]); w.y = cvtpk(v[2], v[3]); *(v2u*)(yp + 16 * dt) = w; }
    }
    __syncthreads();
}
__device__ __forceinline__ void ctxattn_unit(const Ctx& C, int b, int h, int qblk) {
    const bf16* PROJ = WSP(bf16, WS_PROJ);
    LAS unsigned char* vtc = C.lds + RING_OFF + NA_VTC; LAS float* rpb = (LAS float*)(C.lds + RING_OFF + NA_RPB);
    __syncthreads();
    vt_scatter<4>(PROJ + (size_t)(RLAT + b * CTXL + (C.tid & 255)) * NPROJP + C_NV + 64 * h, 4 * (C.tid >> 8), vtc, VTC_STRIDE, C.tid & 255);
    __syncthreads();
    const int qb = C.wave & 3, part = C.wave >> 2, n = C.lane & 15, g = C.lane >> 4;
    const int qrow0 = RLAT + b * CTXL + 64 * qblk + 16 * qb;
    bf16x8 qf[2];
    { const bf16x8* qp = (const bf16x8*)(PROJ + (size_t)(qrow0 + n) * NPROJP + C_NQ + 64 * h + 8 * g); qf[0] = qp[0]; qf[1] = qp[4]; }
    float m, l; f32x4 o[4];
    bf16x8 kf[8][2];
    load_kfrags<false, 8>(kf, PROJ + C_NK + 64 * h, RLAT + b * CTXL + 128 * part, C.lane);
    attn_wave_core<false, 8>(kf, PROJ + C_NK + 64 * h, RLAT + b * CTXL + 128 * part, qf, vtc + 256 * part, VTC_STRIDE, rpb, 0, 0, 0, 0, m, l, o, C.lane);
    attn_merge_store(C, part, qb, m, l, o, qrow0, h);
}

constexpr size_t WS_UT = WS_OBUF;
constexpr size_t WS_SB = WS_OBUF + 26 * MiB;
constexpr int RT_STRIDE = 272;
__device__ __forceinline__ float logsig(float x) { return -log1pf(expf(-x)); }
__device__ __forceinline__ int ret_row0(int b, int c) { return (c < 2) ? RLAT + b * CTXL + 128 * c : b * SEQ + 128 * (c - 2); }

struct RaLoads { v4u k0, k1, v0, v1; };
__device__ __forceinline__ void ra_load(const Ctx& C, int b, int h, int c, RaLoads& L) {
    const int j = C.tid & 127, q4 = C.tid >> 7;
    const bf16* pr = WSP(bf16, WS_PROJ) + (size_t)(ret_row0(b, c) + j) * NPROJP + 64 * h + 16 * q4;
    L.k0 = *(const v4u*)(pr + C_RK); L.k1 = *(const v4u*)(pr + C_RK + 8); L.v0 = *(const v4u*)(pr + C_RV); L.v1 = *(const v4u*)(pr + C_RV + 8);
}
__device__ __forceinline__ void ret_a_unit(const Ctx& C, int layer, int b, int h, int c, const RaLoads& L) {
    LAS unsigned char* kt = C.lds + RING_OFF; LAS unsigned char* vft = kt + 64 * RT_STRIDE; LAS unsigned char* vbt = vft + 64 * RT_STRIDE;
    const float lgf = logsig(C.in[10][(layer * 2 + 0) * 6 + h]), lgb = logsig(C.in[10][(layer * 2 + 1) * 6 + h]);
    __syncthreads();
    {
        const int j = C.tid & 127, q4 = C.tid >> 7;
        const v4u k0 = L.k0, k1 = L.k1, v0 = L.v0, v1 = L.v1;
        const float wf = expf(lgf * (float)(127 - j)), wb = expf(lgb * (float)j);
        const unsigned kw[8] = {k0.x, k0.y, k0.z, k0.w, k1.x, k1.y, k1.z, k1.w}, vw[8] = {v0.x, v0.y, v0.z, v0.w, v1.x, v1.y, v1.z, v1.w};
#pragma unroll
        for (int i = 0; i < 8; ++i) {
            const int d = 16 * q4 + 2 * i;
            *(LAS unsigned short*)(kt + d * RT_STRIDE + 2 * j) = (unsigned short)(kw[i] & 0xffffu); *(LAS unsigned short*)(kt + (d + 1) * RT_STRIDE + 2 * j) = (unsigned short)(kw[i] >> 16);
            const float a = bflo(vw[i]), bb = bfhi(vw[i]);
            *(LAS unsigned short*)(vft + d * RT_STRIDE + 2 * j) = (unsigned short)f2bf(a * wf); *(LAS unsigned short*)(vft + (d + 1) * RT_STRIDE + 2 * j) = (unsigned short)f2bf(bb * wf);
            *(LAS unsigned short*)(vbt + d * RT_STRIDE + 2 * j) = (unsigned short)f2bf(a * wb); *(LAS unsigned short*)(vbt + (d + 1) * RT_STRIDE + 2 * j) = (unsigned short)f2bf(bb * wb);
        }
    }
    __syncthreads();
    const int dir = C.wave >> 2, dt = C.wave & 3, n = C.lane & 15, g = C.lane >> 4;
    LAS const unsigned char* vt = dir ? vbt : vft;
    f32x4 acc[4];
#pragma unroll
    for (int et = 0; et < 4; ++et) acc[et] = (f32x4){0.f, 0.f, 0.f, 0.f};
#pragma unroll
    for (int s = 0; s < 4; ++s) {
        const bf16x8 a = *(LAS const bf16x8*)(kt + (16 * dt + n) * RT_STRIDE + (32 * s + 8 * g) * 2);
#pragma unroll
        for (int et = 0; et < 4; ++et) {
            const bf16x8 bf = *(LAS const bf16x8*)(vt + (16 * et + n) * RT_STRIDE + (32 * s + 8 * g) * 2);
            acc[et] = __builtin_amdgcn_mfma_f32_16x16x32_bf16(a, bf, acc[et], 0, 0, 0);
        }
    }
    float* U = WSP(float, WS_UT) + ((size_t)((dir * 24 + b * 6 + h) * 34 + c)) * 4096;
#pragma unroll
    for (int et = 0; et < 4; ++et) *(f32x4*)(U + (16 * et + n) * 64 + 16 * dt + 4 * g) = acc[et];
}
typedef float f32x2v __attribute__((ext_vector_type(2)));
__device__ __forceinline__ void ret_scan(const Ctx& C, int layer) {
    for (int task = C.gtid; task < 48 * 2048; task += C.NT) {
        const int dir = task / (24 * 2048), rem = task % (24 * 2048), bh = rem >> 11, p = rem & 2047, h = bh % 6;
        const float dec = expf(128.0f * logsig(C.in[10][(layer * 2 + dir) * 6 + h]));
        const float* __restrict__ U = WSP(float, WS_UT) + ((size_t)(dir * 24 + bh) * 34) * 4096 + 2 * p;
        bf16* __restrict__ SB = WSP(bf16, WS_SB) + ((size_t)(dir * 24 + bh) * 34) * 4096 + 2 * p;
        f32x2v u[34];
#pragma unroll
        for (int k = 0; k < 34; ++k) { const int c = dir ? ((k < 2) ? 1 - k : 35 - k) : k; u[k] = *(const f32x2v*)(U + (size_t)c * 4096); }
        float s0 = 0.f, s1 = 0.f;
#pragma unroll
        for (int k = 0; k < 34; ++k) {
            const int c = dir ? ((k < 2) ? 1 - k : 35 - k) : k;
            *(unsigned*)(SB + (size_t)c * 4096) = pk2(s0, s1);
            s0 = dec * s0 + u[k].x; s1 = dec * s1 + u[k].y;
        }
    }
}
constexpr int RC_KS = 144;
constexpr int RC_VT = 0, RC_K = 64 * RT_STRIDE, RC_SB = RC_K + 128 * RC_KS, RC_TAB = RC_SB + 2 * 64 * RC_KS;
static_assert(RC_TAB + 1024 <= RING_BYTES, "retC LDS map");
struct RcLoads { bf16x8 qf[2]; v2u gw[4]; v4u v0, v1, k0, k1, s0, s1; };
__device__ __forceinline__ void rc_load(const Ctx& C, int b, int h, int c, RcLoads& L) {
    const bf16* PROJ = WSP(bf16, WS_PROJ);
    const int row0 = ret_row0(b, c);
    const int n = C.lane & 15, g = C.lane >> 4, i = 16 * C.wave + n, rowi = row0 + i;
    { const bf16x8* qp = (const bf16x8*)(PROJ + (size_t)rowi * NPROJP + C_RQ + 64 * h + 8 * g); L.qf[0] = qp[0]; L.qf[1] = qp[4]; }
    { const bf16* gp = PROJ + (size_t)rowi * NPROJP + C_RG + 64 * h + 4 * g;
#pragma unroll
      for (int et = 0; et < 4; ++et) L.gw[et] = *(const v2u*)(gp + 16 * et); }
    const int vj = C.tid & 127, vq4 = C.tid >> 7;
    const bf16* vpr = PROJ + (size_t)(row0 + vj) * NPROJP + 64 * h + 16 * vq4;
    L.v0 = *(const v4u*)(vpr + C_RV); L.v1 = *(const v4u*)(vpr + C_RV + 8);
    L.k0 = *(const v4u*)(vpr + C_RK); L.k1 = *(const v4u*)(vpr + C_RK + 8);
    const int se = C.tid & 63, sq = (C.tid >> 6) & 3, sd = C.tid >> 8;
    const bf16* spr = WSP(bf16, WS_SB) + ((size_t)((sd * 24 + b * 6 + h) * 34 + c)) * 4096 + se * 64 + 16 * sq;
    L.s0 = *(const v4u*)(spr); L.s1 = *(const v4u*)(spr + 8);
}
__device__ __forceinline__ void ret_c_unit(const Ctx& C, int layer, int b, int h, int c, const RcLoads& L) {
    LAS unsigned char* vt = C.lds + RING_OFF + RC_VT; LAS unsigned char* kim = C.lds + RING_OFF + RC_K; LAS unsigned char* sim = C.lds + RING_OFF + RC_SB;
    LAS float* tabf = (LAS float*)(C.lds + RING_OFF + RC_TAB);
    const float lgf = logsig(C.in[10][(layer * 2 + 0) * 6 + h]), lgb = logsig(C.in[10][(layer * 2 + 1) * 6 + h]);
    const int row0 = ret_row0(b, c);
    const int n = C.lane & 15, g = C.lane >> 4, i = 16 * C.wave + n, rowi = row0 + i;
    const int vj = C.tid & 127, vq4 = C.tid >> 7;
    const int se = C.tid & 63, sq = (C.tid >> 6) & 3, sd = C.tid >> 8;
    const bf16x8 qf[2] = {L.qf[0], L.qf[1]};
    const v2u gw[4] = {L.gw[0], L.gw[1], L.gw[2], L.gw[3]};
    const v4u v0 = L.v0, v1 = L.v1, k0 = L.k0, k1 = L.k1, s0 = L.s0, s1 = L.s1;
    __syncthreads();
    {
        const unsigned vw[8] = {v0.x, v0.y, v0.z, v0.w, v1.x, v1.y, v1.z, v1.w};
#pragma unroll
        for (int ii = 0; ii < 8; ++ii) { const int dd = 16 * vq4 + 2 * ii;
            *(LAS unsigned short*)(vt + dd * RT_STRIDE + 2 * vj) = (unsigned short)(vw[ii] & 0xffffu); *(LAS unsigned short*)(vt + (dd + 1) * RT_STRIDE + 2 * vj) = (unsigned short)(vw[ii] >> 16); }
        *(LAS v4u*)(kim + vj * RC_KS + 32 * vq4) = k0; *(LAS v4u*)(kim + vj * RC_KS + 32 * vq4 + 16) = k1;
        *(LAS v4u*)(sim + (sd * 64 + se) * RC_KS + 32 * sq) = s0; *(LAS v4u*)(sim + (sd * 64 + se) * RC_KS + 32 * sq + 16) = s1;
        if (C.tid < 255) { const int dl = C.tid - 127; tabf[C.tid] = (dl > 0) ? expf(lgf * (float)dl) : ((dl < 0) ? expf(lgb * (float)(-dl)) : 2.0f); }
    }
    __syncthreads();
    f32x4 st[8];
#pragma unroll
    for (int jt = 0; jt < 8; ++jt) {
        LAS const unsigned char* kp = kim + (16 * jt + n) * RC_KS + 16 * g;
        const bf16x8 ka = *(LAS const bf16x8*)(kp), kb = *(LAS const bf16x8*)(kp + 64);
        f32x4 acc = {0.f, 0.f, 0.f, 0.f};
        acc = __builtin_amdgcn_mfma_f32_16x16x32_bf16(ka, qf[0], acc, 0, 0, 0);
        acc = __builtin_amdgcn_mfma_f32_16x16x32_bf16(kb, qf[1], acc, 0, 0, 0);
        st[jt] = acc;
    }
#pragma unroll
    for (int jt = 0; jt < 8; ++jt)
#pragma unroll
        for (int reg = 0; reg < 4; ++reg) {
            const int j = 16 * jt + 4 * g + reg;
            st[jt][reg] *= tabf[127 + i - j];
        }
    f32x4 o[4];
#pragma unroll
    for (int et = 0; et < 4; ++et) o[et] = (f32x4){0.f, 0.f, 0.f, 0.f};
#pragma unroll
    for (int u = 0; u < 4; ++u) {
        v4u pw; pw.x = cvtpk(st[2 * u][0], st[2 * u][1]); pw.y = cvtpk(st[2 * u][2], st[2 * u][3]); pw.z = cvtpk(st[2 * u + 1][0], st[2 * u + 1][1]); pw.w = cvtpk(st[2 * u + 1][2], st[2 * u + 1][3]);
        const bf16x8 pb = __builtin_bit_cast(bf16x8, pw);
        const int slotA = 32 * u + 4 * g, slotB = slotA + 16;
#pragma unroll
        for (int et = 0; et < 4; ++et) {
            LAS const unsigned char* rowp = vt + (16 * et + n) * RT_STRIDE;
            const v2u a_lo = *(LAS const v2u*)(rowp + slotA * 2), a_hi = *(LAS const v2u*)(rowp + slotB * 2);
            v4u aw; aw.x = a_lo.x; aw.y = a_lo.y; aw.z = a_hi.x; aw.w = a_hi.y;
            o[et] = __builtin_amdgcn_mfma_f32_16x16x32_bf16(__builtin_bit_cast(bf16x8, aw), pb, o[et], 0, 0, 0);
        }
    }
#pragma unroll
    for (int dir = 0; dir < 2; ++dir) {
        const float scl = dir ? expf(lgb * (float)(128 - i)) : expf(lgf * (float)(i + 1));
#pragma unroll
        for (int et = 0; et < 4; ++et) {
            LAS const unsigned char* sp = sim + (dir * 64 + 16 * et + n) * RC_KS + 16 * g;
            const bf16x8 a0 = *(LAS const bf16x8*)(sp), a1 = *(LAS const bf16x8*)(sp + 64);
            f32x4 t = {0.f, 0.f, 0.f, 0.f};
            t = __builtin_amdgcn_mfma_f32_16x16x32_bf16(a0, qf[0], t, 0, 0, 0);
            t = __builtin_amdgcn_mfma_f32_16x16x32_bf16(a1, qf[1], t, 0, 0, 0);
            o[et] = o[et] + t * scl;
        }
    }
    float sm = 0.f;
#pragma unroll
    for (int et = 0; et < 4; ++et) sm += (o[et][0] + o[et][1]) + (o[et][2] + o[et][3]);
    sm += __shfl_xor(sm, 16); sm += __shfl_xor(sm, 32);
    const float mu = sm * (1.f / 64.f);
    float sq2 = 0.f;
#pragma unroll
    for (int et = 0; et < 4; ++et) { o[et] = o[et] - mu; sq2 += (o[et][0] * o[et][0] + o[et][1] * o[et][1]) + (o[et][2] * o[et][2] + o[et][3] * o[et][3]); }
    sq2 += __shfl_xor(sq2, 16); sq2 += __shfl_xor(sq2, 32);
    const float rstd = 1.0f / sqrtf(sq2 * (1.f / 64.f) + EPS);
    const float* gn = C.in[11] + layer * 384 + 64 * h;
    bf16* yp = WSP(bf16, WS_YMIX) + (size_t)rowi * D + 64 * h + 4 * g;
#pragma unroll
    for (int et = 0; et < 4; ++et) {
        const f32x4 gg = *(const f32x4*)(gn + 16 * et + 4 * g);
        const float y0 = o[et][0] * rstd * gg[0] * siluf(bflo(gw[et].x)), y1 = o[et][1] * rstd * gg[1] * siluf(bfhi(gw[et].x));
        const float y2 = o[et][2] * rstd * gg[2] * siluf(bflo(gw[et].y)), y3 = o[et][3] * rstd * gg[3] * siluf(bfhi(gw[et].y));
        v2u w; w.x = cvtpk(y0, y1); w.y = cvtpk(y2, y3);
        *(v2u*)(yp + 16 * et) = w;
    }
}

__device__ __forceinline__ void p_mix1(const Ctx& C, int layer) {
    { const int per = (1536 + C.G - 1) / C.G, u0 = C.bx * per, nu = min(per, 1536 - u0); if (nu > 0) { if ((per & 1) == 0) na_band2(C, layer, u0, nu); else na_band(C, layer, u0, nu); } }
    const int n_ctx = (layer == 0) ? 96 : 0;
    for (int u = C.bx; u < n_ctx; u += C.G) { const int bh = u >> 2; ctxattn_unit(C, bh / 6, bh % 6, u & 3); }
    {
        int u0 = (C.bx + C.G - (n_ctx % C.G)) % C.G;
        if (u0 < 816) {
            RaLoads La, Lb;
            ra_load(C, (u0 / 34) / 6, (u0 / 34) % 6, u0 % 34, La);
            for (;;) {
                const int u1 = u0 + C.G; const bool h1 = u1 < 816;
                if (h1) ra_load(C, (u1 / 34) / 6, (u1 / 34) % 6, u1 % 34, Lb);
                ret_a_unit(C, layer, (u0 / 34) / 6, (u0 / 34) % 6, u0 % 34, La);
                if (!h1) break;
                u0 = u1 + C.G; const bool h0 = u0 < 816;
                if (h0) ra_load(C, (u0 / 34) / 6, (u0 / 34) % 6, u0 % 34, La);
                ret_a_unit(C, layer, (u1 / 34) / 6, (u1 / 34) % 6, u1 % 34, Lb);
                if (!h0) break;
            }
        }
    }
    __syncthreads();
}
__device__ __forceinline__ void p_mix2(const Ctx& C, int layer) {
    ret_scan(C, layer);
    const bf16* PROJ = WSP(bf16, WS_PROJ); bf16* Y = WSP(bf16, WS_YMIX);
    const float* cw = C.in[12] + layer * 3 * 256;
    const int nrows = (layer == 0) ? RALL : RLAT;
    for (int idx = C.gtid; idx < nrows * 32; idx += C.NT) {
        const int m = idx >> 5, ch = (idx & 31) * 8;
        int tpos, len; if (m < RLAT) { tpos = m & 4095; len = SEQ; } else { tpos = (m - RLAT) & 255; len = CTXL; }
        const bf16* p = PROJ + (size_t)m * NPROJP + ch;
        const v4u zero = {0u, 0u, 0u, 0u};
        const v4u cb = *(const v4u*)(p + C_CB), cc1 = *(const v4u*)(p + C_CC), cx1 = *(const v4u*)(p + C_CX);
        const v4u cc0 = (tpos > 0) ? *(const v4u*)(p + C_CC - NPROJP) : zero, cx0 = (tpos > 0) ? *(const v4u*)(p + C_CX - NPROJP) : zero;
        const v4u cc2 = (tpos < len - 1) ? *(const v4u*)(p + C_CC + NPROJP) : zero, cx2 = (tpos < len - 1) ? *(const v4u*)(p + C_CX + NPROJP) : zero;
        const f32x4 w0a = *(const f32x4*)(cw + ch), w0b = *(const f32x4*)(cw + ch + 4), w1a = *(const f32x4*)(cw + 256 + ch), w1b = *(const f32x4*)(cw + 256 + ch + 4), w2a = *(const f32x4*)(cw + 512 + ch), w2b = *(const f32x4*)(cw + 512 + ch + 4);
        float y[8];
#pragma unroll
        for (int i = 0; i < 4; ++i) {
            const float wl0 = (i < 2) ? w0a[2 * i] : w0b[2 * i - 4], wh0 = (i < 2) ? w0a[2 * i + 1] : w0b[2 * i - 3];
            const float wl1 = (i < 2) ? w1a[2 * i] : w1b[2 * i - 4], wh1 = (i < 2) ? w1a[2 * i + 1] : w1b[2 * i - 3];
            const float wl2 = (i < 2) ? w2a[2 * i] : w2b[2 * i - 4], wh2 = (i < 2) ? w2a[2 * i + 1] : w2b[2 * i - 3];
            y[2 * i] = bflo(cb[i]) * (wl0 * bflo(cc0[i]) * bflo(cx0[i]) + wl1 * bflo(cc1[i]) * bflo(cx1[i]) + wl2 * bflo(cc2[i]) * bflo(cx2[i]));
            y[2 * i + 1] = bfhi(cb[i]) * (wh0 * bfhi(cc0[i]) * bfhi(cx0[i]) + wh1 * bfhi(cc1[i]) * bfhi(cx1[i]) + wh2 * bfhi(cc2[i]) * bfhi(cx2[i]));
        }
        v4u o; o.x = cvtpk(y[0], y[1]); o.y = cvtpk(y[2], y[3]); o.z = cvtpk(y[4], y[5]); o.w = cvtpk(y[6], y[7]);
        *(v4u*)(Y + (size_t)m * D + 384 + ch) = o;
    }
}
__device__ __forceinline__ void rc_unit_of(int layer, int u, int& bh, int& c) { if (layer == 0) { bh = u / 34; c = u % 34; } else { bh = u >> 5; c = 2 + (u & 31); } }
__device__ __forceinline__ void p_mix3(const Ctx& C, int layer) {
    const int nu = (layer == 0) ? 816 : 768;
    int u0 = C.bx;
    if (u0 < nu) {
        RcLoads La, Lb; int bh0, c0, bh1, c1;
        rc_unit_of(layer, u0, bh0, c0); rc_load(C, bh0 / 6, bh0 % 6, c0, La);
        for (;;) {
            const int u1 = u0 + C.G; const bool h1 = u1 < nu;
            if (h1) { rc_unit_of(layer, u1, bh1, c1); rc_load(C, bh1 / 6, bh1 % 6, c1, Lb); }
            ret_c_unit(C, layer, bh0 / 6, bh0 % 6, c0, La);
            if (!h1) break;
            u0 = u1 + C.G; const bool h0 = u0 < nu;
            if (h0) { rc_unit_of(layer, u0, bh0, c0); rc_load(C, bh0 / 6, bh0 % 6, c0, La); }
            ret_c_unit(C, layer, bh1 / 6, bh1 % 6, c1, Lb);
            if (!h0) break;
        }
    }
    __syncthreads();
}
__device__ __forceinline__ void p_moe_lists(const Ctx& C) {
    LAS int* L = (LAS int*)(C.lds + RING_OFF);
    const int* CNT = WSP(int, WS_CNT);
    for (int blk = C.bx; blk < 256; blk += C.G) {
        __syncthreads();
        for (int i = C.tid; i < 2048; i += NTHR) L[i] = CNT[i];
        if (C.tid < 64) L[2080 + C.tid] = WSP(int, WS_TOKE)[64 * blk + C.tid];
        __syncthreads();
        {
            const int e = C.wave; int tot = 0, pre = 0;
#pragma unroll
            for (int q = 0; q < 4; ++q) { const int k = 4 * C.lane + q; const int cnt = L[k * 8 + e]; tot += cnt; pre += (k < blk) ? cnt : 0; }
#pragma unroll
            for (int o = 1; o < 64; o <<= 1) { tot += __shfl_xor(tot, o); pre += __shfl_xor(pre, o); }
            if (C.lane == 0) { L[2048 + e] = tot; L[2064 + e] = pre; }
        }
        __syncthreads();
        if (C.tid == 0) { int base = 0; for (int e = 0; e < 8; ++e) { L[2056 + e] = base; base += (L[2048 + e] + 255) & ~255; } }
        __syncthreads();
        {
            const int e = C.wave, ee = L[2080 + C.lane], e1 = ee & 255, e2 = ee >> 8;
            const bool hit = (e1 == e) || (e2 == e);
            const unsigned long long bal = __ballot(hit);
            const int rank = __popcll(bal & ((1ull << C.lane) - 1ull));
            if (hit) L[2144 + 2 * C.lane + ((e1 == e) ? 0 : 1)] = L[2056 + e] + L[2064 + e] + rank;
        }
        __syncthreads();
        if (C.tid < 128) { const int t = C.tid >> 1, k = C.tid & 1, m = 64 * blk + t, pos = L[2144 + C.tid];
            WSP(int, WS_TOKP)[2 * m + k] = pos; WSP(float, WS_ROWW)[pos] = WSP(float, WS_TOKW)[2 * m + k]; }
        for (int j = 0; j < 8; ++j) { const int t = 8 * C.wave + j, m = 64 * blk + t;
            const v4u* src = (const v4u*)(WSP(bf16, WS_A) + (size_t)m * D) + 2 * C.lane;
            const v4u x0 = src[0], x1 = src[1];
            v4u y; y.x = pg8::pk4_fp8(bflo(x0.x), bfhi(x0.x), bflo(x0.y), bfhi(x0.y)); y.y = pg8::pk4_fp8(bflo(x0.z), bfhi(x0.z), bflo(x0.w), bfhi(x0.w));
            y.z = pg8::pk4_fp8(bflo(x1.x), bfhi(x1.x), bflo(x1.y), bfhi(x1.y)); y.w = pg8::pk4_fp8(bflo(x1.z), bfhi(x1.z), bflo(x1.w), bfhi(x1.w));
#pragma unroll
            for (int k = 0; k < 2; ++k) { v4u* dst = (v4u*)(WSP(unsigned char, WS_SORT) + (size_t)L[2144 + 2 * t + k] * D) + C.lane; dst[0] = y; } }
        if (blk == 0 && C.tid == 0) { int T = 0; int* TE = WSP(int, WS_TILE);
            for (int e = 0; e < 8; ++e) { const int nt = (L[2048 + e] + 255) >> 8; for (int k = 0; k < nt; ++k) TE[T + k] = e; T += nt; }
            TE[255] = T; }
    }
    __syncthreads();
}
__device__ __forceinline__ void p_final(const Ctx& C, float* out) {
    const float* fg = C.in[20]; const float* mod = WSP(float, WS_MOD) + 30720; const bf16* SL = WSP(bf16, WS_SLOT);
    f32x4 fgv[4];
#pragma unroll
    for (int j = 0; j < 4; ++j) fgv[j] = *(const f32x4*)(fg + 4 * C.lane + 256 * j);
    for (int base = 8 * C.gw; base < RLAT; base += 8 * C.NGW) {
        f32x4 g2v[4];
        { const int b = base >> 12;
#pragma unroll
          for (int j = 0; j < 4; ++j) g2v[j] = *(const f32x4*)(mod + b * 6144 + 5 * D + 4 * C.lane + 256 * j); }
        for (int r2 = 0; r2 < 8; r2 += 2) {
            int mm[2], pp[2][2];
#pragma unroll
            for (int r = 0; r < 2; ++r) { mm[r] = base + r2 + r; pp[r][0] = WSP(int, WS_TOKP)[2 * mm[r]]; pp[r][1] = WSP(int, WS_TOKP)[2 * mm[r] + 1]; }
            f32x4 v[2][4]; float ss[2] = {0.f, 0.f};
#pragma unroll
            for (int r = 0; r < 2; ++r)
#pragma unroll
                for (int j = 0; j < 4; ++j) { const int c = 4 * C.lane + 256 * j;
                    const f32x4 hv = *(const f32x4*)(WSP(float, WS_H) + (size_t)mm[r] * D + c);
                    const v2u q1 = *(const v2u*)(SL + (size_t)pp[r][0] * D + c), q2 = *(const v2u*)(SL + (size_t)pp[r][1] * D + c);
                    const f32x4 s1 = {bflo(q1.x), bfhi(q1.x), bflo(q1.y), bfhi(q1.y)}, s2 = {bflo(q2.x), bfhi(q2.x), bflo(q2.y), bfhi(q2.y)};
                    v[r][j] = hv + g2v[j] * (s1 + s2); ss[r] += (v[r][j].x * v[r][j].x + v[r][j].y * v[r][j].y) + (v[r][j].z * v[r][j].z + v[r][j].w * v[r][j].w); }
#pragma unroll
            for (int r = 0; r < 2; ++r) {
                const float rstd = 1.0f / sqrtf(wave_sum(ss[r]) * (1.0f / D) + EPS);
#pragma unroll
                for (int j = 0; j < 4; ++j) { const int c = 4 * C.lane + 256 * j; __builtin_nontemporal_store(v[r][j] * rstd * fgv[j], (f32x4*)(out + (size_t)mm[r] * D + c)); }
            }
        }
    }
}

#ifndef MK_ONE_LAUNCH
#define MK_ONE_LAUNCH 1
#endif
constexpr int NPHASES = 21;
#ifndef PROBE_DUP
#define PROBE_DUP 0u
#endif
#define REPS(k) ((((PROBE_DUP) >> (k)) & 1u) ? 2 : 1)
struct Args { const float* in[21]; float* out; unsigned char* ws; int ph_lo, ph_hi; };
__global__ void __launch_bounds__(NTHR, 2) fwd(Args args) {
    extern __shared__ __attribute__((aligned(16))) unsigned char lds_raw[];
    Ctx C;
    C.lds = (LAS unsigned char*)lds_raw;
    C.tid = threadIdx.x; C.lane = C.tid & 63; C.wave = __builtin_amdgcn_readfirstlane(C.tid >> 6);
    C.G = gridDim.x; C.bx = blockIdx.x; C.gw = C.bx * NWAVES + C.wave; C.NGW = C.G * NWAVES; C.gtid = C.bx * NTHR + C.tid; C.NT = C.G * NTHR;
    C.ws = args.ws;
#pragma unroll
    for (int i = 0; i < 21; ++i) C.in[i] = args.in[i];
    volatile LAS unsigned* MISC = (volatile LAS unsigned*)(C.lds + MISC_OFF);
    for (int u = C.tid; u < (LDS_BYTES - LDSCTL_OFF) / 4; u += NTHR) ((LAS unsigned*)(C.lds + LDSCTL_OFF))[u] = 0u;
    __syncthreads();
    const int lo = args.ph_lo, hi = args.ph_hi;
    unsigned* barw = (unsigned*)(C.ws + WS_CTL) + CW_BAR;
    XcdBarrier bar; bar.bar = barw; bar.x = 0; bar.st = nullptr;
    if (hi - lo > 1) bar = xcd_barrier_post(barw, MISC + 8);
#define IN(k) (lo <= (k) && (k) < hi)
#define SEAM(k) do { if (IN(k) && IN((k) + 1)) xcd_barrier(bar); } while (0)
    LAS unsigned char* ring = C.lds + RING_OFF;
    const float* cosT = WSP(float, WS_ROPE); const float* sinT = cosT + 1024;

    if (IN(0)) for (int rep = 0; rep < REPS(0); ++rep) { p_prologue(C); } SEAM(0);
    if (IN(1)) for (int rep = 0; rep < REPS(1); ++rep) { p_norm<false, 0>(C, 0, 0, true, true, true, false); } SEAM(1);
    if (IN(2)) for (int rep = 0; rep < REPS(2); ++rep) { pg8::Gemm g{WSP(bf16, WS_A), WSP(bf16, WS_WIN), RALL, NPROJP, D, D}; pg8::StaticOrder S; S.init(RALL, NPROJP, C.G, C.bx);
        pg8::EpiInProj E{WSP(bf16, WS_PROJ), cosT, sinT};
        pg8::gemm_phase<pg8::EpiInProj, pg8::StaticOrder, true, true>(ring, g, S, E); } SEAM(2);
    if (IN(3)) for (int rep = 0; rep < REPS(3); ++rep) { p_mix1(C, 0); } SEAM(3);
    if (IN(4)) for (int rep = 0; rep < REPS(4); ++rep) { p_mix2(C, 0); } SEAM(4);
    if (IN(5)) for (int rep = 0; rep < REPS(5); ++rep) { p_mix3(C, 0); } SEAM(5);
    if (IN(6)) for (int rep = 0; rep < REPS(6); ++rep) { { pg8::Gemm g{WSP(bf16, WS_YMIX), WSP(bf16, WS_WOUT), RLAT, D, D, D}; pg8::StaticOrder S; S.init(RLAT, D, C.G, C.bx);
        pg8::EpiResid E{WSP(float, WS_H), C.in[0], C.in[2], WSP(float, WS_MOD), 2 * D};
        pg8::gemm_phase<pg8::EpiResid, pg8::StaticOrder, true, true>(ring, g, S, E); }
        { pg8::Gemm g{WSP(bf16, WS_YMIX) + (size_t)RLAT * D, WSP(bf16, WS_WOUT), RCTX, D, 256, D}; pg8::SplitOrder S; S.init(4, C.G, C.bx);
        pg8::EpiPartial E{WSP(float, WS_PART), WSP(float, WS_MOD), 2 * D};
        pg8::gemm_phase<pg8::EpiPartial, pg8::SplitOrder, false, true>(ring, g, S, E); } } SEAM(6);
    if (IN(7)) for (int rep = 0; rep < REPS(7); ++rep) { p_norm<false, 4>(C, 0, 1, true, false, true, true); } SEAM(7);
    if (IN(8)) for (int rep = 0; rep < REPS(8); ++rep) { pg8::Gemm g{WSP(bf16, WS_A), WSP(bf16, WS_FIN), RALL, 2 * DFF, D, D}; pg8::StaticOrder S; S.init(RALL, 2 * DFF, C.G, C.bx);
        pg8::EpiSwiglu E{WSP(bf16, WS_HID)};
        pg8::gemm_phase<pg8::EpiSwiglu, pg8::StaticOrder, true, true>(ring, g, S, E); } SEAM(8);
    if (IN(9)) for (int rep = 0; rep < REPS(9); ++rep) { { pg8::Gemm g{WSP(bf16, WS_HID), WSP(bf16, WS_FOUT), RLAT, D, DFF, DFF}; pg8::StaticOrder S; S.init(RLAT, D, C.G, C.bx);
        pg8::EpiResid E{WSP(float, WS_H), WSP(float, WS_H), WSP(float, WS_H) + (size_t)RLAT * D, WSP(float, WS_MOD), 5 * D};
        pg8::gemm_phase<pg8::EpiResid, pg8::StaticOrder, true, true>(ring, g, S, E); }
        { pg8::Gemm g{WSP(bf16, WS_HID) + (size_t)RLAT * DFF, WSP(bf16, WS_FOUT), RCTX, D, 256, DFF}; pg8::SplitOrder S; S.init(11, C.G, C.bx);
        pg8::EpiPartial E{WSP(float, WS_PART), WSP(float, WS_MOD), 5 * D};
        pg8::gemm_phase<pg8::EpiPartial, pg8::SplitOrder, false, true>(ring, g, S, E); } } SEAM(9);
    if (IN(10)) for (int rep = 0; rep < REPS(10); ++rep) { p_norm<false, 11>(C, 1, 0, true, false, false, false); } SEAM(10);
    if (IN(11)) for (int rep = 0; rep < REPS(11); ++rep) { pg8::Gemm g{WSP(bf16, WS_A), WSP(bf16, WS_WIN) + (size_t)NPROJP * D, RALL, NPROJP, D, D}; pg8::StaticOrder S; S.init(RALL, NPROJP, C.G, C.bx);
        pg8::EpiInProj E{WSP(bf16, WS_PROJ), cosT, sinT};
        pg8::gemm_phase<pg8::EpiInProj, pg8::StaticOrder, true, true>(ring, g, S, E); } SEAM(11);
    if (IN(12)) for (int rep = 0; rep < REPS(12); ++rep) { p_mix1(C, 1); } SEAM(12);
    if (IN(13)) for (int rep = 0; rep < REPS(13); ++rep) { p_mix2(C, 1); } SEAM(13);
    if (IN(14)) for (int rep = 0; rep < REPS(14); ++rep) { p_mix3(C, 1); } SEAM(14);
    if (IN(15)) for (int rep = 0; rep < REPS(15); ++rep) { pg8::Gemm g{WSP(bf16, WS_YMIX), WSP(bf16, WS_WOUT) + (size_t)D * D, RLAT, D, D, D}; pg8::StaticOrder S; S.init(RLAT, D, C.G, C.bx);
        pg8::EpiResid E{WSP(float, WS_H), WSP(float, WS_H), WSP(float, WS_H) + (size_t)RLAT * D, WSP(float, WS_MOD) + 30720, 2 * D};
        pg8::gemm_phase<pg8::EpiResid, pg8::StaticOrder, true, true>(ring, g, S, E); } SEAM(15);
    if (IN(16)) for (int rep = 0; rep < REPS(16); ++rep) { p_norm<true, 0>(C, 1, 1, false, false, false, false); } SEAM(16);
    if (IN(17)) for (int rep = 0; rep < REPS(17); ++rep) { p_moe_lists(C); } SEAM(17);
    if (IN(18)) for (int rep = 0; rep < REPS(18); ++rep) { const int T = __builtin_amdgcn_readfirstlane(WSP(int, WS_TILE)[255]);
        pg8::Gemm g{WSP(bf16, WS_SORT), WSP(bf16, WS_MIN), T * 256, 2 * DFF, D / 2, D / 2}; pg8::MoeOrder S; S.init(T, 2 * DFF, C.G, C.bx, WSP(int, WS_TILE), (size_t)2 * DFF * D / 2);
        pg8::EpiSwigluF8 E{WSP(unsigned char, WS_HID)};
        pg8::gemm_phase<pg8::EpiSwigluF8, pg8::MoeOrder, true, true, true>(ring, g, S, E); } SEAM(18);
    if (IN(19)) for (int rep = 0; rep < REPS(19); ++rep) { const int T = __builtin_amdgcn_readfirstlane(WSP(int, WS_TILE)[255]);
        pg8::Gemm g{WSP(bf16, WS_HID), WSP(bf16, WS_MOUT), T * 256, D, DFF / 2, DFF / 2}; pg8::MoeOrder S; S.init(T, D, C.G, C.bx, WSP(int, WS_TILE), (size_t)D * DFF / 2);
        pg8::EpiSlots E{WSP(bf16, WS_SLOT), WSP(float, WS_ROWW)};
        pg8::gemm_phase<pg8::EpiSlots, pg8::MoeOrder, true, true, true>(ring, g, S, E); } SEAM(19);
    if (IN(20)) for (int rep = 0; rep < REPS(20); ++rep) { p_final(C, args.out); }
#undef IN
#undef SEAM
}

extern "C" void kernel_launch(void* const* d_in, const int* in_sizes, int n_in, void* d_out, int out_size, void* d_ws, size_t ws_size, hipStream_t stream) {
    static int grid = 0;
    if (grid == 0) {
        if (n_in != 21 || ws_size < WS_END) { fprintf(stderr, "kernel_launch: unexpected n_in %d or ws_size %zu (need %zu)\n", n_in, ws_size, (size_t)WS_END); grid = -1; return; }
        int dev = 0, cus = 0, per_cu = 0;
        if (hipGetDevice(&dev) != hipSuccess || hipDeviceGetAttribute(&cus, hipDeviceAttributeMultiprocessorCount, dev) != hipSuccess) { grid = -1; return; }
        if (hipFuncSetAttribute((const void*)fwd, hipFuncAttributeMaxDynamicSharedMemorySize, LDS_BYTES) != hipSuccess) { fprintf(stderr, "kernel_launch: hipFuncSetAttribute failed\n"); grid = -1; return; }
        if (hipOccupancyMaxActiveBlocksPerMultiprocessor(&per_cu, (const void*)fwd, NTHR, LDS_BYTES) != hipSuccess || per_cu < 1) fprintf(stderr, "kernel_launch: occupancy query reports %d\n", per_cu);
        (void)hipGetLastError();
        grid = cus < 256 ? cus : 256;
    }
    if (grid < 0) return;
    (void)hipMemsetAsync((char*)d_ws + WS_CTL, 0, CTL_ZERO_BYTES, stream);
    Args a{};
    for (int i = 0; i < 21; ++i) a.in[i] = (const float*)d_in[i];
    a.out = (float*)d_out; a.ws = (unsigned char*)d_ws;
#if MK_ONE_LAUNCH
    a.ph_lo = 0; a.ph_hi = NPHASES;
    hipLaunchKernelGGL(fwd, dim3(grid), dim3(NTHR), LDS_BYTES, stream, a);
#else
    for (int p = 0; p < NPHASES; ++p) { a.ph_lo = p; a.ph_hi = p + 1; hipLaunchKernelGGL(fwd, dim3(grid), dim3(NTHR), LDS_BYTES, stream, a); }
#endif
}
```
